# Optimizing an MI355X kernel written in HIP

```python
import math
import jax, jax.numpy as jnp
from jax import lax
import numpy as np

D_MODEL = 1024
BATCH = 16
SEQ = 256
DEPTH = 4
DEC_BATCH = 4
DEC_SEQ = 1024
PAST_LEN = 256

GRID_W = 64
N_MIXERS = 2
N_DIFF_LAYERS = (DEPTH + 1) // 2
N_NA_LAYERS = DEPTH // 2
DIFF_DK = 64
DIFF_DV = 2 * DIFF_DK
DIFF_HEADS = D_MODEL // (2 * DIFF_DK)
NA_DH = 64
NA_HEADS = D_MODEL // NA_DH
NA_KH_MAX = 8
NA_KW = 16
NA_QB_W = 16
NA_KB_W = NA_QB_W + NA_KW
D_FF = 4 * D_MODEL
ROPE_BASE = 10000.0
EPS = 1e-6
NEG_INF = -1e30

kernel_name = "hybrid_diff_natten_prefix_dit_step"


def rms_norm(x, g):
    xf = x.astype(jnp.float32)
    y = xf * lax.rsqrt(jnp.mean(xf * xf, axis=-1, keepdims=True) + EPS)
    return (y * g.astype(jnp.float32)).astype(x.dtype)


def modulation(cond, w_ada_l, b_ada_l):
    m = (jax.nn.silu(cond) @ w_ada_l + b_ada_l)[:, None, :]
    return jnp.split(m, 6, axis=-1)


def mlp_residual(x, shift, scale, gate, g, w1, w2):
    h = rms_norm(x, g) * (1 + scale) + shift
    return x + gate * (jnp.square(jax.nn.relu(h @ w1)) @ w2)


def rope_half(x, ang):
    n = x.shape[-1] // 2
    cos = jnp.cos(ang).astype(x.dtype)
    sin = jnp.sin(ang).astype(x.dtype)
    x1, x2 = x[..., :n], x[..., n:]
    return jnp.concatenate([x1 * cos - x2 * sin, x2 * cos + x1 * sin], axis=-1)


def rope_2d(x, ang_row, ang_col):
    half = x.shape[-1] // 2
    return jnp.concatenate([rope_half(x[..., :half], ang_row), rope_half(x[..., half:], ang_col)], axis=-1)


def diff_qkv(h, w_qkv, q_g, k_g):
    B, T, _ = h.shape
    q, k, v = jnp.split(h @ w_qkv, 3, axis=-1)
    q = rms_norm(q.reshape(B, T, DIFF_HEADS, 2, DIFF_DK), q_g)
    k = rms_norm(k.reshape(B, T, DIFF_HEADS, 2, DIFF_DK), k_g)
    v = v.reshape(B, T, DIFF_HEADS, DIFF_DV)
    return q, k, v


def diff_lambda(lq1, lk1, lq2, lk2, lambda_init):
    e1 = jnp.exp(jnp.sum(lq1.astype(jnp.float32) * lk1.astype(jnp.float32)))
    e2 = jnp.exp(jnp.sum(lq2.astype(jnp.float32) * lk2.astype(jnp.float32)))
    return e1 - e2 + lambda_init


def diff_attend(q, k, v, lam, lambda_init, g_sub):
    B, Tq = q.shape[0], q.shape[1]
    s = jnp.einsum('bqhmd,bkhmd->bhmqk', q, k).astype(jnp.float32) * (DIFF_DK ** -0.5)
    p = jax.nn.softmax(s, axis=-1)
    a = p[:, :, 0] - lam * p[:, :, 1]
    o = jnp.einsum('bhqk,bkhe->bqhe', a.astype(v.dtype), v)
    o = rms_norm(o, g_sub) * (1.0 - lambda_init)
    return o.reshape(B, Tq, DIFF_HEADS * DIFF_DV)


def na_qkv(h, w_qkv, q_g, k_g):
    B, T, _ = h.shape
    q, k, v = jnp.split(h @ w_qkv, 3, axis=-1)
    q = rms_norm(q.reshape(B, T, NA_HEADS, NA_DH), q_g)
    k = rms_norm(k.reshape(B, T, NA_HEADS, NA_DH), k_g)
    v = v.reshape(B, T, NA_HEADS, NA_DH)
    return q, k, v


def dense_attend(q, k, v):
    B, Tq, H, Dh = q.shape
    s = jnp.einsum('bqhd,bkhd->bhqk', q, k).astype(jnp.float32) * (Dh ** -0.5)
    p = jax.nn.softmax(s, axis=-1)
    o = jnp.einsum('bhqk,bkhd->bqhd', p.astype(v.dtype), v)
    return o.reshape(B, Tq, H * Dh)


def na_latent_attend(q, k, v, kc, vc, rel_bias):
    B, T, H, Dh = q.shape
    rows = T // GRID_W
    kh = min(NA_KH_MAX, rows)
    ncb = GRID_W // NA_QB_W
    r = jnp.arange(rows)
    rs = jnp.clip(r - kh // 2, 0, rows - kh)
    row_idx = rs[:, None] + jnp.arange(kh)
    j = jnp.arange(ncb)
    kb = jnp.clip(j * NA_QB_W - NA_KW // 2, 0, GRID_W - NA_KB_W)
    col_idx = kb[:, None] + jnp.arange(NA_KB_W)
    qcol = j[:, None] * NA_QB_W + jnp.arange(NA_QB_W)
    cs = jnp.clip(qcol - NA_KW // 2, 0, GRID_W - NA_KW)
    kcol = col_idx[:, None, :]
    valid = (kcol >= cs[..., None]) & (kcol < cs[..., None] + NA_KW)
    nw = kh * NA_KB_W
    mask = jnp.broadcast_to(valid[:, :, None, :], (ncb, NA_QB_W, kh, NA_KB_W)).reshape(ncb, NA_QB_W, nw)
    dr = row_idx - r[:, None] + (NA_KH_MAX - 1)
    dc = jnp.clip(kcol - qcol[..., None], -(NA_KW - 1), NA_KW - 1) + (NA_KW - 1)
    bias = rel_bias[:, dr[:, None, None, :, None], dc[None, :, :, None, :]]
    bias = bias.reshape(H, rows, ncb, NA_QB_W, nw).astype(jnp.float32)
    qg = q.reshape(B, rows, ncb, NA_QB_W, H, Dh)
    ridx = row_idx[:, None, :, None]
    cidx = col_idx[None, :, None, :]
    kg = k.reshape(B, rows, GRID_W, H, Dh)[:, ridx, cidx].reshape(B, rows, ncb, nw, H, Dh)
    vg = v.reshape(B, rows, GRID_W, H, Dh)[:, ridx, cidx].reshape(B, rows, ncb, nw, H, Dh)
    scale = Dh ** -0.5
    s_win = jnp.einsum('brjqhd,brjkhd->bhrjqk', qg, kg).astype(jnp.float32) * scale + bias[None]
    s_win = jnp.where(mask[None, None, None], s_win, NEG_INF)
    s_ctx = jnp.einsum('brjqhd,bkhd->bhrjqk', qg, kc).astype(jnp.float32) * scale
    p = jax.nn.softmax(jnp.concatenate([s_win, s_ctx], axis=-1), axis=-1)
    o = (jnp.einsum('bhrjqk,brjkhd->brjqhd', p[..., :nw].astype(v.dtype), vg)
         + jnp.einsum('bhrjqk,bkhd->brjqhd', p[..., nw:].astype(v.dtype), vc))
    return o.reshape(B, T, H * Dh)


def setup_inputs(seed: int = 0) -> dict:
    key = jax.random.key(seed)
    ks = jax.random.split(key, 40)

    def nrm(k, shape, scale=1.0):
        return jax.random.normal(k, shape, jnp.float32) * scale

    D = D_MODEL
    return {
        "x_prompt": nrm(ks[0], (BATCH, SEQ, D)),
        "x_sample": nrm(ks[1], (DEC_BATCH, DEC_SEQ, D)),
        "cache_diff_k": nrm(ks[2], (DEC_BATCH, N_DIFF_LAYERS, PAST_LEN, DIFF_HEADS, 2 * DIFF_DK)),
        "cache_diff_v": nrm(ks[3], (DEC_BATCH, N_DIFF_LAYERS, PAST_LEN, DIFF_HEADS, DIFF_DV)),
        "cache_na_k": nrm(ks[4], (DEC_BATCH, N_NA_LAYERS, PAST_LEN, NA_HEADS, NA_DH)),
        "cache_na_v": nrm(ks[5], (DEC_BATCH, N_NA_LAYERS, PAST_LEN, NA_HEADS, NA_DH)),
        "c": nrm(ks[6], (DEC_BATCH, D)),
        "c_ctx": nrm(ks[7], (D,)),
        "w_ada": nrm(ks[8], (DEPTH, D, 6 * D), 0.5 * D ** -0.5),
        "b_ada": nrm(ks[9], (DEPTH, 6 * D), 0.01),
        "norm_mix_g": 1.0 + nrm(ks[10], (DEPTH, D), 0.02),
        "norm_mlp_g": 1.0 + nrm(ks[11], (DEPTH, D), 0.02),
        "w_fc1": nrm(ks[12], (DEPTH, D, D_FF), D ** -0.5),
        "w_fc2": nrm(ks[13], (DEPTH, D_FF, D), D_FF ** -0.5),
        "w_qkv_diff": nrm(ks[14], (N_DIFF_LAYERS, D, 3 * D), D ** -0.5),
        "w_o_diff": nrm(ks[15], (N_DIFF_LAYERS, DIFF_HEADS * DIFF_DV, D), (DIFF_HEADS * DIFF_DV) ** -0.5),
        "q_norm_diff_g": 1.0 + nrm(ks[16], (N_DIFF_LAYERS, DIFF_DK), 0.02),
        "k_norm_diff_g": 1.0 + nrm(ks[17], (N_DIFF_LAYERS, DIFF_DK), 0.02),
        "lambda_q1": nrm(ks[18], (N_DIFF_LAYERS, DIFF_DK), 0.1),
        "lambda_k1": nrm(ks[19], (N_DIFF_LAYERS, DIFF_DK), 0.1),
        "lambda_q2": nrm(ks[20], (N_DIFF_LAYERS, DIFF_DK), 0.1),
        "lambda_k2": nrm(ks[21], (N_DIFF_LAYERS, DIFF_DK), 0.1),
        "subln_g": 1.0 + nrm(ks[22], (N_DIFF_LAYERS, DIFF_DV), 0.02),
        "w_qkv_na": nrm(ks[23], (N_NA_LAYERS, D, 3 * D), D ** -0.5),
        "w_o_na": nrm(ks[24], (N_NA_LAYERS, NA_HEADS * NA_DH, D), (NA_HEADS * NA_DH) ** -0.5),
        "q_norm_na_g": 1.0 + nrm(ks[25], (N_NA_LAYERS, NA_DH), 0.02),
        "k_norm_na_g": 1.0 + nrm(ks[26], (N_NA_LAYERS, NA_DH), 0.02),
        "rel_bias_na": nrm(ks[27], (N_NA_LAYERS, NA_HEADS, 2 * NA_KH_MAX - 1, 2 * NA_KW - 1), 0.1),
    }


def reference(x_prompt, x_sample, cache_diff_k, cache_diff_v, cache_na_k, cache_na_v, c, c_ctx,
              w_ada, b_ada, norm_mix_g, norm_mlp_g, w_fc1, w_fc2,
              w_qkv_diff, w_o_diff, q_norm_diff_g, k_norm_diff_g,
              lambda_q1, lambda_k1, lambda_q2, lambda_k2, subln_g,
              w_qkv_na, w_o_na, q_norm_na_g, k_norm_na_g, rel_bias_na):
    Bd, T = x_sample.shape[0], x_sample.shape[1]
    L = cache_diff_k.shape[2]
    n_freq = DIFF_DK // 4
    freqs = ROPE_BASE ** (-jnp.arange(n_freq, dtype=jnp.float32) / n_freq)
    t = jnp.arange(T)
    ang_row = ((t // GRID_W).astype(jnp.float32)[:, None] * freqs).reshape(T, 1, 1, n_freq)
    ang_col = ((t % GRID_W).astype(jnp.float32)[:, None] * freqs).reshape(T, 1, 1, n_freq)
    cond_ctx = c_ctx[None, :]

    yp, ys = x_prompt, x_sample
    new_dk, new_dv, new_nk, new_nv = [], [], [], []
    for l in range(DEPTH):
        i = l // N_MIXERS
        mp = modulation(cond_ctx, w_ada[l], b_ada[l])
        ms = modulation(c, w_ada[l], b_ada[l])
        hp = rms_norm(yp, norm_mix_g[l]) * (1 + mp[1]) + mp[0]
        hs = rms_norm(ys, norm_mix_g[l]) * (1 + ms[1]) + ms[0]
        if l % N_MIXERS == 0:
            lambda_init = 0.8 - 0.6 * math.exp(-0.3 * l)
            lam = diff_lambda(lambda_q1[i], lambda_k1[i], lambda_q2[i], lambda_k2[i], lambda_init)
            qp, kp, vp = diff_qkv(hp, w_qkv_diff[i], q_norm_diff_g[i], k_norm_diff_g[i])
            op = diff_attend(qp, kp, vp, lam, lambda_init, subln_g[i])
            new_dk.append(kp.reshape(kp.shape[0], kp.shape[1], DIFF_HEADS, 2 * DIFF_DK))
            new_dv.append(vp)
            qs, kls, vls = diff_qkv(hs, w_qkv_diff[i], q_norm_diff_g[i], k_norm_diff_g[i])
            qs = rope_2d(qs, ang_row, ang_col)
            kls = rope_2d(kls, ang_row, ang_col)
            kc = cache_diff_k[:, i].reshape(Bd, L, DIFF_HEADS, 2, DIFF_DK)
            os_ = diff_attend(qs, jnp.concatenate([kls, kc], axis=1),
                              jnp.concatenate([vls, cache_diff_v[:, i]], axis=1),
                              lam, lambda_init, subln_g[i])
            yp = yp + mp[2] * (op @ w_o_diff[i])
            ys = ys + ms[2] * (os_ @ w_o_diff[i])
        else:
            qp, kp, vp = na_qkv(hp, w_qkv_na[i], q_norm_na_g[i], k_norm_na_g[i])
            op = dense_attend(qp, kp, vp)
            new_nk.append(kp)
            new_nv.append(vp)
            qs, kls, vls = na_qkv(hs, w_qkv_na[i], q_norm_na_g[i], k_norm_na_g[i])
            os_ = na_latent_attend(qs, kls, vls, cache_na_k[:, i], cache_na_v[:, i], rel_bias_na[i])
            yp = yp + mp[2] * (op @ w_o_na[i])
            ys = ys + ms[2] * (os_ @ w_o_na[i])
        yp = mlp_residual(yp, mp[3], mp[4], mp[5], norm_mlp_g[l], w_fc1[l], w_fc2[l])
        ys = mlp_residual(ys, ms[3], ms[4], ms[5], norm_mlp_g[l], w_fc1[l], w_fc2[l])

    return (yp, ys, jnp.stack(new_dk, axis=1), jnp.stack(new_dv, axis=1),
            jnp.stack(new_nk, axis=1), jnp.stack(new_nv, axis=1))
```

```cpp
#include <hip/hip_runtime.h>
#include <cstdio>
#include <cstdint>

#ifndef MK_SINGLE
#define MK_SINGLE 0
#endif

#ifndef EN_PRO
#define EN_PRO 1
#endif
#ifndef EN_NORM
#define EN_NORM 1
#endif
#ifndef EN_QKV
#define EN_QKV 1
#endif
#ifndef EN_ATT
#define EN_ATT 1
#endif
#ifndef EN_O
#define EN_O 1
#endif
#ifndef EN_FC1
#define EN_FC1 1
#endif
#ifndef EN_FC2
#define EN_FC2 1
#endif
#define LAS __attribute__((address_space(3)))
#define GAS __attribute__((address_space(1)))
typedef unsigned short bf16_t;
typedef short bf16x8 __attribute__((ext_vector_type(8)));
typedef short s16x4 __attribute__((ext_vector_type(4)));
typedef float f32x4 __attribute__((ext_vector_type(4)));
typedef float f32x2 __attribute__((ext_vector_type(2)));
typedef float f32x16 __attribute__((ext_vector_type(16)));
typedef unsigned u32x4 __attribute__((ext_vector_type(4)));
typedef unsigned u32x2 __attribute__((ext_vector_type(2)));
typedef __bf16 bf16x2_t __attribute__((ext_vector_type(2)));

constexpr int D = 1024, FF = 4096, DEPTH = 4;
constexpr int MP = 4096, M = 8192;
constexpr float EPS = 1e-6f;
constexpr float LOG2E = 1.4426950408889634f;
constexpr float C2 = 0.125f * LOG2E;
constexpr size_t OUT_Y = 0, OUT_DK = 8388608, OUT_DV = 16777216, OUT_NK = 25165824, OUT_NV = 33554432;

constexpr size_t MiB = 1u << 20;
constexpr size_t WS_CTL = 0, CTL_ZERO_BYTES = 64 * 1024;
constexpr size_t WS_MOD = 1 * MiB;
constexpr size_t WS_ROPE = WS_MOD + 512 * 1024;
constexpr size_t WS_LAM = WS_ROPE + 16 * 1024;
constexpr size_t WS_W = 2 * MiB;
constexpr size_t W_LAYER = 24 * MiB, W_QKV = 0, W_O = 6 * MiB, W_1 = 8 * MiB, W_2 = 16 * MiB;
constexpr size_t WS_CACHE = 98 * MiB;
constexpr size_t WS_XN = 114 * MiB, WS_Q = 130 * MiB, WS_K = 146 * MiB, WS_V = 162 * MiB, WS_O = 178 * MiB, WS_H = 194 * MiB, WS_END = 258 * MiB;
constexpr int CW_BAR = 1024;

constexpr int RING_BYTES = 131072;
constexpr int LDSCTL_OFF = RING_BYTES, MISC_OFF = LDSCTL_OFF + 320;
constexpr int LDS_BYTES = 147456;

__device__ __forceinline__ unsigned pk2(float lo, float hi) { f32x2 v = {lo, hi}; bf16x2_t b = __builtin_convertvector(v, bf16x2_t); return __builtin_bit_cast(unsigned, b); }
__device__ __forceinline__ float wave_sum(float v) {
#pragma unroll
    for (int o = 1; o < 64; o <<= 1) v += __shfl_xor(v, o);
    return v;
}
#define LDS_WAIT() asm volatile("s_waitcnt lgkmcnt(0)" ::: "memory")
#define VM_WAIT() asm volatile("s_waitcnt vmcnt(0)" ::: "memory")

namespace pg8 {
constexpr int BM = 256, BK = 64, HALF = 128, HTB = HALF * BK * 2, NXCD = 8, WGM = 8;
__host__ __device__ __forceinline__ int lds_byte(int r, int c) { const int st = (r >> 4) * 2 + (c >> 5), rr = r & 15, cc = c & 31, ob = rr * 64 + cc * 2; return st * 1024 + (ob ^ (((ob >> 9) & 1) << 5)); }
__host__ __device__ __forceinline__ void stage_rc(int b, int& R, int& C) { const int st = b / 1024, sb = b % 1024, swz = sb ^ (((sb >> 9) & 1) << 5); R = (st >> 1) * 16 + swz / 64; C = (st & 1) * 32 + (swz % 64) / 2; }
__host__ __device__ __forceinline__ int perm32(int rho) { const int n = rho >> 4, i = rho & 15; return 8 * (i >> 2) + 4 * n + (i & 3); }

struct Unit { int pm, pn; };
struct Gemm { const bf16_t* A; const bf16_t* Bt; int K; };

struct StaticOrder {
    int nM, nN, nwg, G, c;
    __device__ void init(int nM_, int nN_, int G_, int c_) { nM = nM_; nN = nN_; nwg = nM * nN; G = G_; c = c_; }
    __device__ bool next(int i, Unit& u) const {
        const long L = (long)i * G + c; if (L >= nwg) return false;
        int wgid = (int)L; { const int q = nwg / NXCD, r = nwg % NXCD, xcd = wgid % NXCD, off = wgid / NXCD; wgid = (xcd < r ? xcd * (q + 1) : r * (q + 1) + (xcd - r) * q) + off; }
        const int nig = WGM * nN, gid = wgid / nig, fm = gid * WGM, gsz = (nM - fm) < WGM ? (nM - fm) : WGM;
        u.pm = fm + ((wgid % nig) % gsz); u.pn = (wgid % nig) / gsz; return true;
    }
};

template <class Epi, int NB, bool ALIGN_EPI>
__device__ __forceinline__ void gemm_phase(LAS unsigned char* lds, const Gemm g, const StaticOrder& S, const Epi& E, const int tid) {
    const int wid = __builtin_amdgcn_readfirstlane(tid >> 6), lane = tid & 63, wr = wid >> 2, wc = wid & 3, fr = lane & 15, fq = lane >> 4;
    const int K = g.K, nt = K / BK;
    unsigned voffA[2], voffB[2];
#pragma unroll
    for (int i = 0; i < 2; ++i) { int R, C; stage_rc(tid * 16 + i * 8192, R, C); const int Rb = Epi::PERM ? ((R & ~31) + perm32(R & 31)) : R;
        voffA[i] = (unsigned)(R * K + C) * 2u; voffB[i] = (unsigned)(Rb * K + C) * 2u; }
    const size_t kstep = (size_t)(BK * 2);
    const size_t hstep = (size_t)HALF * K * 2;
    const size_t tstepA = 2 * hstep, tstepB = NB * hstep;
    const unsigned ldsw = (unsigned)wid * 1024u;
    const int aoff = lds_byte(wr * 64 + fr, fq * 8), boff = lds_byte(wc * 32 + fr, fq * 8);
#define PG8_SA(b, h) (((b) * 2 + (h)) * HTB)
#define PG8_SB(b, h) ((4 + (b) * 2 + (h)) * HTB)
#define PG8_STAGE(bufoff, gbase, voff) do { _Pragma("unroll") for (int _i = 0; _i < 2; ++_i) \
        __builtin_amdgcn_global_load_lds((const unsigned*)((const char*)(gbase) + (voff)[_i]), (LAS unsigned*)(lds + (bufoff) + ldsw + _i * 8192), 16, 0, 0); } while (0)
#define PG8_LDA(dst, b, h) do { _Pragma("unroll") for (int m = 0; m < 4; ++m) _Pragma("unroll") for (int k = 0; k < 2; ++k) dst[m][k] = *(const LAS bf16x8*)(lds + PG8_SA(b, h) + aoff + m * 2048 + k * 1024); } while (0)
#define PG8_LDB(dst, b, h) do { _Pragma("unroll") for (int n = 0; n < 2; ++n) _Pragma("unroll") for (int k = 0; k < 2; ++k) dst[n][k] = *(const LAS bf16x8*)(lds + PG8_SB(b, h) + boff + n * 2048 + k * 1024); } while (0)
#define PG8_MMA(ai, bj, At, Bt) do { __builtin_amdgcn_s_setprio(1); _Pragma("unroll") for (int m = 0; m < 4; ++m) _Pragma("unroll") for (int n = 0; n < 2; ++n) _Pragma("unroll") for (int k = 0; k < 2; ++k) \
        acc[ai][bj][m][n] = __builtin_amdgcn_mfma_f32_16x16x32_bf16(Bt[n][k], At[m][k], acc[ai][bj][m][n], 0, 0, 0); __builtin_amdgcn_s_setprio(0); } while (0)
#define PG8_WAIT_V(n) asm volatile("s_waitcnt vmcnt(" #n ")" ::: "memory")
#define PG8_WAIT_L(n) asm volatile("s_waitcnt lgkmcnt(" #n ")" ::: "memory")
#define PG8_BAR __builtin_amdgcn_s_barrier()
#define PG8_SCHED __builtin_amdgcn_sched_barrier(0)
    Unit cur, nxt; int ui = 0;
    if (!S.next(0, cur)) return;
    f32x4 acc[2][NB][4][2];
#pragma unroll
    for (int a = 0; a < 2; ++a)
#pragma unroll
        for (int b = 0; b < NB; ++b)
#pragma unroll
            for (int m = 0; m < 4; ++m)
#pragma unroll
                for (int n = 0; n < 2; ++n) acc[a][b][m][n] = (f32x4){0.f, 0.f, 0.f, 0.f};
    bf16x8 At[4][2], B0[2][2], B1[2][2];
    const char* cA = (const char*)g.A + (size_t)cur.pm * tstepA; const char* cB = (const char*)g.Bt + (size_t)cur.pn * tstepB;
    if constexpr (NB == 2) {
        PG8_STAGE(PG8_SB(0, 0), cB, voffB); PG8_STAGE(PG8_SB(0, 1), cB + hstep, voffB); PG8_STAGE(PG8_SA(0, 0), cA, voffA); PG8_STAGE(PG8_SA(0, 1), cA + hstep, voffA);
        if (wr == 1) PG8_BAR;
        PG8_WAIT_V(2); PG8_BAR;
        PG8_STAGE(PG8_SB(1, 0), cB + kstep, voffB); PG8_STAGE(PG8_SA(1, 0), cA + kstep, voffA); PG8_STAGE(PG8_SB(1, 1), cB + hstep + kstep, voffB);
        PG8_WAIT_V(6); PG8_BAR;
    } else {
        PG8_STAGE(PG8_SB(0, 0), cB, voffB); PG8_STAGE(PG8_SA(0, 0), cA, voffA); PG8_STAGE(PG8_SA(0, 1), cA + hstep, voffA);
        if (wr == 1) PG8_BAR;
        PG8_WAIT_V(2); PG8_BAR;
        PG8_STAGE(PG8_SB(1, 0), cB + kstep, voffB); PG8_STAGE(PG8_SA(1, 0), cA + kstep, voffA);
        PG8_WAIT_V(4); PG8_BAR;
    }
    for (;;) {
        const bool has_next = S.next(ui + 1, nxt);
        const char* nA = has_next ? (const char*)g.A + (size_t)nxt.pm * tstepA : cA; const char* nB = has_next ? (const char*)g.Bt + (size_t)nxt.pn * tstepB : cB;
        for (int t = 0; t < nt; t += 2) {
            const bool last = (t == nt - 2);
            const char* a1 = cA + (size_t)(t + 1) * kstep;
            const char* a2 = last ? nA : cA + (size_t)(t + 2) * kstep; const char* b2 = last ? nB : cB + (size_t)(t + 2) * kstep;
            const char* a3 = a2 + kstep; const char* b3 = b2 + kstep;
            if constexpr (NB == 2) {
            PG8_LDB(B0, 0, 0); PG8_LDB(B1, 0, 1); PG8_SCHED; PG8_LDA(At, 0, 0); PG8_STAGE(PG8_SA(1, 1), a1 + hstep, voffA);
            PG8_WAIT_V(8); PG8_WAIT_L(0); PG8_BAR; PG8_MMA(0, 0, At, B0); PG8_MMA(0, 1, At, B1); PG8_BAR; PG8_SCHED;
            PG8_LDA(At, 0, 1); PG8_STAGE(PG8_SB(0, 0), b2, voffB); PG8_STAGE(PG8_SB(0, 1), b2 + hstep, voffB); PG8_STAGE(PG8_SA(0, 0), a2, voffA);
            PG8_WAIT_V(8); PG8_WAIT_L(0); PG8_BAR; PG8_MMA(1, 0, At, B0); PG8_MMA(1, 1, At, B1); PG8_BAR; PG8_SCHED;
            PG8_LDB(B0, 1, 0); PG8_LDB(B1, 1, 1); PG8_SCHED; PG8_LDA(At, 1, 0); PG8_STAGE(PG8_SA(0, 1), a2 + hstep, voffA);
            PG8_WAIT_V(8); PG8_WAIT_L(0); PG8_BAR; PG8_MMA(0, 0, At, B0); PG8_MMA(0, 1, At, B1); PG8_BAR; PG8_SCHED;
            PG8_LDA(At, 1, 1); PG8_STAGE(PG8_SB(1, 0), b3, voffB); PG8_STAGE(PG8_SB(1, 1), b3 + hstep, voffB); PG8_STAGE(PG8_SA(1, 0), a3, voffA);
            PG8_WAIT_V(8); PG8_WAIT_L(0); PG8_BAR; PG8_MMA(1, 0, At, B0); PG8_MMA(1, 1, At, B1); PG8_BAR; PG8_SCHED;
            } else {
            PG8_LDB(B0, 0, 0); PG8_SCHED; PG8_LDA(At, 0, 0); PG8_STAGE(PG8_SA(1, 1), a1 + hstep, voffA);
            PG8_WAIT_V(6); PG8_WAIT_L(0); PG8_BAR; PG8_MMA(0, 0, At, B0); PG8_BAR; PG8_SCHED;
            PG8_LDA(At, 0, 1); PG8_STAGE(PG8_SB(0, 0), b2, voffB); PG8_STAGE(PG8_SA(0, 0), a2, voffA);
            PG8_WAIT_V(6); PG8_WAIT_L(0); PG8_BAR; PG8_MMA(1, 0, At, B0); PG8_BAR; PG8_SCHED;
            PG8_LDB(B0, 1, 0); PG8_SCHED; PG8_LDA(At, 1, 0); PG8_STAGE(PG8_SA(0, 1), a2 + hstep, voffA);
            PG8_WAIT_V(6); PG8_WAIT_L(0); PG8_BAR; PG8_MMA(0, 0, At, B0); PG8_BAR; PG8_SCHED;
            PG8_LDA(At, 1, 1); PG8_STAGE(PG8_SB(1, 0), b3, voffB); PG8_STAGE(PG8_SA(1, 0), a3, voffA);
            PG8_WAIT_V(6); PG8_WAIT_L(0); PG8_BAR; PG8_MMA(1, 0, At, B0); PG8_BAR; PG8_SCHED;
            }
        }
        if constexpr (ALIGN_EPI) { if (wr == 0) PG8_BAR; }
        E(acc, cur, wr, wc, fr, fq);
        if (!has_next) break;
#pragma unroll
        for (int a = 0; a < 2; ++a)
#pragma unroll
            for (int b = 0; b < NB; ++b)
#pragma unroll
                for (int m = 0; m < 4; ++m)
#pragma unroll
                    for (int n = 0; n < 2; ++n) acc[a][b][m][n] = (f32x4){0.f, 0.f, 0.f, 0.f};
        cur = nxt; cA = nA; cB = nB; ++ui;
        if constexpr (ALIGN_EPI) { if (wr == 1) PG8_BAR; }
    }
    PG8_WAIT_V(0);
    if constexpr (!ALIGN_EPI) { if (wr == 0) PG8_BAR; }
    PG8_BAR;
#undef PG8_SA
#undef PG8_SB
#undef PG8_STAGE
#undef PG8_LDA
#undef PG8_LDB
#undef PG8_MMA
#undef PG8_WAIT_V
#undef PG8_WAIT_L
#undef PG8_BAR
#undef PG8_SCHED
}

__device__ __forceinline__ int cond_of_pm(int pm) { return pm < 16 ? 0 : 1 + ((pm - 16) >> 2); }

struct EpiQK {
    static constexpr bool PERM = false;
    bf16_t* Q; bf16_t* Kb; const float* qg; const float* kg; const float* rope; float* outk;
    __device__ __forceinline__ void operator()(const f32x4 (&acc)[2][2][4][2], const Unit& u, int wr, int wc, int fr, int fq) const {
        const bool isk = u.pn >= 4; const int G = (u.pn & 3) * 4 + wc;
        const float* g = isk ? kg : qg; bf16_t* dst = isk ? Kb : Q; const float sc = isk ? 1.f : C2;
        const bool prompt = u.pm < 16; const bool do_rope = (rope != nullptr) && !prompt;
        f32x4 gv[2][2];
#pragma unroll
        for (int bj = 0; bj < 2; ++bj)
#pragma unroll
            for (int n = 0; n < 2; ++n) gv[bj][n] = *(const f32x4*)(g + 32 * bj + 16 * n + 4 * fq);
#pragma unroll
        for (int ai = 0; ai < 2; ++ai)
#pragma unroll
            for (int m = 0; m < 4; ++m) {
                const int row = u.pm * BM + ai * HALF + wr * 64 + m * 16 + fr;
                float ss = 0.f;
#pragma unroll
                for (int bj = 0; bj < 2; ++bj)
#pragma unroll
                    for (int n = 0; n < 2; ++n) { const f32x4 x = acc[ai][bj][m][n]; ss += (x[0] * x[0] + x[1] * x[1]) + (x[2] * x[2] + x[3] * x[3]); }
                ss += __shfl_xor(ss, 16); ss += __shfl_xor(ss, 32);
                const float rstd = rsqrtf(ss * (1.f / 64.f) + EPS);
                f32x4 x[2][2];
#pragma unroll
                for (int bj = 0; bj < 2; ++bj)
#pragma unroll
                    for (int n = 0; n < 2; ++n) x[bj][n] = acc[ai][bj][m][n] * rstd * gv[bj][n];
                if (isk && prompt) {
                    float* o = outk + (size_t)u.pm * (2 * 256 * 1024) + (size_t)(row & 255) * 1024 + 64 * G + 4 * fq;
#pragma unroll
                    for (int bj = 0; bj < 2; ++bj)
#pragma unroll
                        for (int n = 0; n < 2; ++n) *(f32x4*)(o + 32 * bj + 16 * n) = x[bj][n];
                }
                if (do_rope) {
                    const int t = (row - MP) & 1023;
#pragma unroll
                    for (int bj = 0; bj < 2; ++bj) {
                        const int pos = bj == 0 ? (t >> 6) : (t & 63);
                        const f32x4 cs01 = *(const f32x4*)(rope + (pos * 16 + 4 * fq) * 2), cs23 = *(const f32x4*)(rope + (pos * 16 + 4 * fq) * 2 + 4);
                        const float cc[4] = {cs01[0], cs01[2], cs23[0], cs23[2]}, sn[4] = {cs01[1], cs01[3], cs23[1], cs23[3]};
#pragma unroll
                        for (int e = 0; e < 4; ++e) { const float x0 = x[bj][0][e], x1 = x[bj][1][e]; x[bj][0][e] = x0 * cc[e] - x1 * sn[e]; x[bj][1][e] = x1 * cc[e] + x0 * sn[e]; }
                    }
                }
                bf16_t* rp = dst + (size_t)row * D + 64 * G + 8 * fq;
#pragma unroll
                for (int bj = 0; bj < 2; ++bj) { const f32x4 v0 = x[bj][0] * sc, v1 = x[bj][1] * sc;
                    u32x4 w; w.x = pk2(v0[0], v0[1]); w.y = pk2(v0[2], v0[3]); w.z = pk2(v1[0], v1[1]); w.w = pk2(v1[2], v1[3]);
                    *(u32x4*)(rp + 32 * bj) = w; }
            }
    }
};
struct EpiV {
    static constexpr bool PERM = true;
    bf16_t* V; float* outv;
    __device__ __forceinline__ void operator()(const f32x4 (&acc)[2][1][4][2], const Unit& u, int wr, int wc, int fr, int fq) const {
        const int col0 = u.pn * HALF + wc * 32 + 8 * fq; const bool prompt = u.pm < 16;
#pragma unroll
        for (int ai = 0; ai < 2; ++ai)
#pragma unroll
            for (int m = 0; m < 4; ++m) {
                const int row = u.pm * BM + ai * HALF + wr * 64 + m * 16 + fr;
                const f32x4 v0 = acc[ai][0][m][0], v1 = acc[ai][0][m][1];
                u32x4 w; w.x = pk2(v0[0], v0[1]); w.y = pk2(v0[2], v0[3]); w.z = pk2(v1[0], v1[1]); w.w = pk2(v1[2], v1[3]);
                *(u32x4*)(V + (size_t)row * D + col0) = w;
                if (prompt) { float* o = outv + (size_t)u.pm * (2 * 256 * 1024) + (size_t)(row & 255) * 1024 + col0; *(f32x4*)o = v0; *(f32x4*)(o + 4) = v1; }
            }
    }
};
struct EpiResid {
    static constexpr bool PERM = true;
    const float* resid_p; const float* resid_s; float* out; const float* gate;
    __device__ __forceinline__ void operator()(const f32x4 (&acc)[2][1][4][2], const Unit& u, int wr, int wc, int fr, int fq) const {
        const int col0 = u.pn * HALF + wc * 32 + 8 * fq;
        const float* gp = gate + cond_of_pm(u.pm) * 6144 + col0;
        const f32x4 g0 = *(const f32x4*)gp, g1 = *(const f32x4*)(gp + 4);
        const float* src = u.pm < 16 ? resid_p + (size_t)u.pm * BM * D : resid_s + (size_t)(u.pm - 16) * BM * D;
        float* dstb = out + (size_t)u.pm * BM * D;
#pragma unroll
        for (int ai = 0; ai < 2; ++ai)
#pragma unroll
            for (int m = 0; m < 4; ++m) {
                const size_t off = (size_t)(ai * HALF + wr * 64 + m * 16 + fr) * D + col0;
                const f32x4 r0 = *(const f32x4*)(src + off), r1 = *(const f32x4*)(src + off + 4);
                *(f32x4*)(dstb + off) = r0 + g0 * acc[ai][0][m][0]; *(f32x4*)(dstb + off + 4) = r1 + g1 * acc[ai][0][m][1];
            }
    }
};
struct EpiRelu2 {
    static constexpr bool PERM = true;
    bf16_t* H;
    __device__ __forceinline__ void operator()(const f32x4 (&acc)[2][2][4][2], const Unit& u, int wr, int wc, int fr, int fq) const {
        const int col0 = u.pn * BM + wc * 32 + 8 * fq;
#pragma unroll
        for (int ai = 0; ai < 2; ++ai)
#pragma unroll
            for (int m = 0; m < 4; ++m) {
                bf16_t* rp = H + (size_t)(u.pm * BM + ai * HALF + wr * 64 + m * 16 + fr) * FF + col0;
#pragma unroll
                for (int bj = 0; bj < 2; ++bj) {
                    f32x4 v0 = acc[ai][bj][m][0], v1 = acc[ai][bj][m][1];
#pragma unroll
                    for (int e = 0; e < 4; ++e) { const float a = fmaxf(v0[e], 0.f), b = fmaxf(v1[e], 0.f); v0[e] = a * a; v1[e] = b * b; }
                    u32x4 w; w.x = pk2(v0[0], v0[1]); w.y = pk2(v0[2], v0[3]); w.z = pk2(v1[0], v1[1]); w.w = pk2(v1[2], v1[3]);
                    *(u32x4*)(rp + bj * HALF) = w; }
            }
    }
};
}

namespace att {
constexpr float THR = 8.f, NEG = -1e30f;
__device__ __forceinline__ int crow(int r, int hi) { return (r & 3) + 8 * (r >> 2) + 4 * hi; }
__device__ __forceinline__ s16x4 vtr(const LAS char* p) { return __builtin_bit_cast(s16x4, __builtin_amdgcn_ds_read_tr16_b64_v4i16((LAS s16x4*)p)); }

struct Seg { const bf16_t* K1; const bf16_t* V1; int nt1; const bf16_t* K2; const bf16_t* V2; int nt2; };

template <bool DIFF, bool NA>
__device__ __forceinline__ void attn_unit(const int tid, LAS unsigned char* lds, const bf16_t* Qw  , const Seg sg, bf16_t* Ow  ,
                                          int kr_lo, int r_q, int jj, const float* relb  ,
                                          float lam, float post_scale, const float* subg) {
    constexpr int KW = DIFF ? 256 : 128, VW = DIFF ? 256 : 128, KS = KW + 16, VS = VW + 64, KBY = 64 * KS, VBY = 64 * VS, BUF = KBY + VBY;
    constexpr int DVB = DIFF ? 4 : 2, KC = DIFF ? 2 : 1;
    constexpr int WSF_OFF = 2 * BUF, BIAS_OFF = WSF_OFF + 2048, OST_OFF = BIAS_OFF + 2048;
    const int lane = tid & 63, l31 = lane & 31, hi = lane >> 5; const int wid = __builtin_amdgcn_readfirstlane(tid >> 6);
    const int mp = DIFF ? (wid >> 2) : 0;
    LAS float* wsf = (LAS float*)(lds + WSF_OFF) + wid * 64;
    LAS float* biasl = (LAS float*)(lds + BIAS_OFF);
    const int nt = sg.nt1 + sg.nt2;
    int srow[KC], sch[KC];
#pragma unroll
    for (int i = 0; i < KC; ++i) { const int ci = tid + 512 * i; srow[i] = ci / (KW / 16); sch[i] = ci % (KW / 16); }
    u32x4 kst[KC], vst[KC];
#define ATT_LOAD(t) do { const bf16_t* kb_ = (t) < sg.nt1 ? sg.K1 + (size_t)(t) * 64 * D : sg.K2 + (size_t)((t) - sg.nt1) * 64 * D; \
        const bf16_t* vb_ = (t) < sg.nt1 ? sg.V1 + (size_t)(t) * 64 * D : sg.V2 + (size_t)((t) - sg.nt1) * 64 * D; \
        _Pragma("unroll") for (int i = 0; i < KC; ++i) { kst[i] = *(const u32x4*)(kb_ + (size_t)srow[i] * D + sch[i] * 8); vst[i] = *(const u32x4*)(vb_ + (size_t)srow[i] * D + sch[i] * 8); } } while (0)
#define ATT_STORE(b) do { _Pragma("unroll") for (int i = 0; i < KC; ++i) { *(LAS u32x4*)(lds + (b) * BUF + srow[i] * KS + sch[i] * 16) = kst[i]; *(LAS u32x4*)(lds + (b) * BUF + KBY + srow[i] * VS + sch[i] * 16) = vst[i]; } } while (0)
    ATT_LOAD(0);
    if (NA) { for (int i = tid; i < 465; i += 512) biasl[i] = relb[i] * LOG2E; }
    bf16x8 qf[4];
#pragma unroll
    for (int d0 = 0; d0 < 4; ++d0) qf[d0] = *(const bf16x8*)(Qw + (size_t)l31 * D + d0 * 16 + hi * 8);
    f32x16 o[DVB];
#pragma unroll
    for (int i = 0; i < DVB; ++i) o[i] = f32x16{};
    float mrun = NEG, lsum = 0.f;
    ATT_STORE(0);
    __syncthreads();
    const int rs_q = NA ? min(max(r_q - 4, 0), 8) : 0;
    const int cq = 32 * jj + l31, cs = min(max(cq - 8, 0), 48);
    const int kvoff = KBY + (4 * hi + ((lane & 15) >> 2)) * VS + ((lane >> 4) & 1) * 32 + (lane & 3) * 8;
    for (int t = 0; t < nt; ++t) {
        const bool more = (t + 1 < nt);
        if (more) ATT_LOAD(t + 1);
        bool active = true; int kr = 0;
        if (NA && t < sg.nt1) { kr = kr_lo + t; active = (kr >= rs_q) && (kr < rs_q + 8); }
        if (active) {
            const LAS unsigned char* kb = lds + (t & 1) * BUF + mp * 128 + l31 * KS + hi * 16;
            f32x16 p0 = f32x16{}, p1 = f32x16{};
#pragma unroll
            for (int d0 = 0; d0 < 4; ++d0) {
                const bf16x8 a0 = *(const LAS bf16x8*)(kb + d0 * 32), a1 = *(const LAS bf16x8*)(kb + 32 * KS + d0 * 32);
                p0 = __builtin_amdgcn_mfma_f32_32x32x16_bf16(a0, qf[d0], p0, 0, 0, 0);
                p1 = __builtin_amdgcn_mfma_f32_32x32x16_bf16(a1, qf[d0], p1, 0, 0, 0);
            }
            if (NA && t < sg.nt1) {
                const LAS float* brow = biasl + (kr - r_q + 7) * 31 + 15 - cq;
#pragma unroll
                for (int r = 0; r < 16; ++r) {
                    const int k0 = crow(r, hi), k1 = k0 + 32;
                    const bool v0 = (k0 >= cs) && (k0 < cs + 16), v1 = (k1 >= cs) && (k1 < cs + 16);
                    const float b0 = brow[v0 ? k0 : cq], b1 = brow[v1 ? k1 : cq];
                    p0[r] = v0 ? p0[r] + b0 : NEG; p1[r] = v1 ? p1[r] + b1 : NEG;
                }
            }
            float tm = fmaxf(p0[0], p1[0]);
#pragma unroll
            for (int r = 1; r < 16; ++r) tm = fmaxf(tm, fmaxf(p0[r], p1[r]));
            tm = fmaxf(tm, __shfl_xor(tm, 32));
            if (__any(tm > mrun + THR)) {
                const float mn = fmaxf(mrun, tm), al = __builtin_amdgcn_exp2f(mrun - mn);
                lsum *= al; mrun = mn;
                if (hi == 0) wsf[l31] = al;
                LDS_WAIT();
#pragma unroll
                for (int r = 0; r < 16; ++r) { const float f = wsf[crow(r, hi)];
#pragma unroll
                    for (int i = 0; i < DVB; ++i) o[i][r] *= f; }
                LDS_WAIT();
            }
            float sacc = 0.f;
#pragma unroll
            for (int r = 0; r < 16; ++r) { p0[r] = __builtin_amdgcn_exp2f(p0[r] - mrun); p1[r] = __builtin_amdgcn_exp2f(p1[r] - mrun); sacc += p0[r] + p1[r]; }
            lsum += sacc;
            bf16x8 pa[2][2];
#pragma unroll
            for (int s = 0; s < 2; ++s) {
                u32x4 w0, w1;
                w0.x = pk2(p0[8 * s + 0], p0[8 * s + 1]); w0.y = pk2(p0[8 * s + 2], p0[8 * s + 3]); w0.z = pk2(p0[8 * s + 4], p0[8 * s + 5]); w0.w = pk2(p0[8 * s + 6], p0[8 * s + 7]);
                w1.x = pk2(p1[8 * s + 0], p1[8 * s + 1]); w1.y = pk2(p1[8 * s + 2], p1[8 * s + 3]); w1.z = pk2(p1[8 * s + 4], p1[8 * s + 5]); w1.w = pk2(p1[8 * s + 6], p1[8 * s + 7]);
                pa[0][s] = __builtin_bit_cast(bf16x8, w0); pa[1][s] = __builtin_bit_cast(bf16x8, w1);
            }
            const LAS char* vb = (const LAS char*)(lds + (t & 1) * BUF + kvoff);
#pragma unroll
            for (int d0 = 0; d0 < DVB; ++d0)
#pragma unroll
                for (int blk = 0; blk < 2; ++blk)
#pragma unroll
                    for (int s = 0; s < 2; ++s) {
                        const s16x4 lo = vtr(vb + (32 * blk + 16 * s) * VS + 64 * d0), hh = vtr(vb + (32 * blk + 16 * s + 8) * VS + 64 * d0);
                        const bf16x8 vf = (bf16x8){lo[0], lo[1], lo[2], lo[3], hh[0], hh[1], hh[2], hh[3]};
                        o[d0] = __builtin_amdgcn_mfma_f32_32x32x16_bf16(pa[blk][s], vf, o[d0], 0, 0, 0);
                    }
        }
        if (more) ATT_STORE((t + 1) & 1);
        __syncthreads();
    }
#undef ATT_LOAD
#undef ATT_STORE
    lsum += __shfl_xor(lsum, 32);
    if (hi == 0) wsf[l31] = 1.f / lsum;
    LDS_WAIT();
    float inv[16];
#pragma unroll
    for (int r = 0; r < 16; ++r) inv[r] = wsf[crow(r, hi)];
    LDS_WAIT();
    if constexpr (!DIFF) {
        LAS bf16_t* stg = (LAS bf16_t*)(lds + OST_OFF) + wid * 2048;
#pragma unroll
        for (int r = 0; r < 16; ++r) { const int q = crow(r, hi);
#pragma unroll
            for (int d0 = 0; d0 < 2; ++d0) { const unsigned w = pk2(o[d0][r] * inv[r], 0.f); stg[q * 64 + d0 * 32 + l31] = (bf16_t)(w & 0xffffu); } }
        LDS_WAIT();
#pragma unroll
        for (int i = 0; i < 4; ++i) { const int row = i * 8 + (lane >> 3), ch = lane & 7; const u32x4 v = *(const LAS u32x4*)(stg + row * 64 + ch * 8); *(u32x4*)(Ow + (size_t)row * D + ch * 8) = v; }
        LDS_WAIT();
        __syncthreads();
    } else {
        constexpr int RS = 132;
        LAS float* ex = (LAS float*)lds + (wid & 3) * 32 * RS;
        if (mp == 1) {
#pragma unroll
            for (int r = 0; r < 16; ++r) { const int q = crow(r, hi); const float f = inv[r] * lam;
#pragma unroll
                for (int d0 = 0; d0 < 4; ++d0) ex[q * RS + d0 * 32 + l31] = o[d0][r] * f; }
        }
        LDS_WAIT();
        __syncthreads();
        if (mp == 0) {
#pragma unroll
            for (int r = 0; r < 16; ++r) { const int q = crow(r, hi);
#pragma unroll
                for (int d0 = 0; d0 < 4; ++d0) { LAS float* p = ex + q * RS + d0 * 32 + l31; *p = o[d0][r] * inv[r] - *p; } }
            LDS_WAIT();
            const LAS float* rp = ex + l31 * RS + hi * 64;
            f32x4 v[16]; float ss = 0.f;
#pragma unroll
            for (int j = 0; j < 16; ++j) { v[j] = *(const LAS f32x4*)(rp + 4 * j); ss += (v[j][0] * v[j][0] + v[j][1] * v[j][1]) + (v[j][2] * v[j][2] + v[j][3] * v[j][3]); }
            ss += __shfl_xor(ss, 32);
            const float rstd = rsqrtf(ss * (1.f / 128.f) + EPS) * post_scale;
            bf16_t* orow = Ow + (size_t)l31 * D + hi * 64;
#pragma unroll
            for (int j = 0; j < 8; ++j) { const f32x4 g0 = *(const f32x4*)(subg + hi * 64 + 8 * j), g1 = *(const f32x4*)(subg + hi * 64 + 8 * j + 4);
                const f32x4 a = v[2 * j] * rstd * g0, b = v[2 * j + 1] * rstd * g1;
                u32x4 w; w.x = pk2(a[0], a[1]); w.y = pk2(a[2], a[3]); w.z = pk2(b[0], b[1]); w.w = pk2(b[2], b[3]);
                *(u32x4*)(orow + 8 * j) = w; }
        }
        LDS_WAIT();
        __syncthreads();
    }
}
}

#define XB_TMO      128
#define XB_XCNT(j)  (256  + 64 * (j))
#define XB_XSUB(j)  (1280 + 64 * (j))
#define XB_XGEN(j)  (2304 + 64 * (j))
#define XB_TOP      3328
#define XB_TOPGEN   3392
#define XCD_BAR_WORDS 3456
#define XB_SPIN_CAP (1u << 18)
__device__ __forceinline__ unsigned xb_ld(unsigned* p)              { return __hip_atomic_load(p, __ATOMIC_RELAXED, __HIP_MEMORY_SCOPE_AGENT); }
__device__ __forceinline__ unsigned xb_add(unsigned* p, unsigned v) { return __hip_atomic_fetch_add(p, v, __ATOMIC_RELAXED, __HIP_MEMORY_SCOPE_AGENT); }
__device__ __forceinline__ unsigned xb_xcc_id() { return (unsigned)__builtin_amdgcn_s_getreg((3 << 11) | 20) & 0xFu; }
#define XB_SPIN(cond, bar) do { unsigned _sp = 0; while (cond) { __builtin_amdgcn_s_sleep(1); \
    if ((++_sp & 255u) == 0u) { if (xb_ld(&(bar)[XB_TMO])) break; if (_sp > XB_SPIN_CAP) { atomicAdd(&(bar)[XB_TMO], 1u); break; } } } } while (0)
struct XcdBarrier { unsigned* bar; unsigned x; volatile LAS unsigned* st; };
__device__ __forceinline__ XcdBarrier xcd_barrier_post(unsigned* bar, volatile LAS unsigned* st) {
    XcdBarrier b; b.bar = bar; b.x = xb_xcc_id(); b.st = st;
    if (threadIdx.x == 0) (void)xb_add(&bar[XB_XCNT(b.x)], 1u);
    return b;
}
__device__ __forceinline__ void xcd_barrier_complete(unsigned* bar, unsigned x, unsigned& nloc, unsigned& nx) {
    const unsigned G = gridDim.x * gridDim.y * gridDim.z;
    unsigned sum, cnt, mine, sp = 0u;
    for (;;) {
        sum = 0u; cnt = 0u; mine = 0u;
#pragma unroll
        for (unsigned j = 0; j < 16; ++j) { const unsigned c = xb_ld(&bar[XB_XCNT(j)]); sum += c; cnt += (c > 0u) ? 1u : 0u; mine = (j == x) ? c : mine; }
        if (sum == G) break;
        __builtin_amdgcn_s_sleep(1);
        if ((++sp & 255u) == 0u) { if (xb_ld(&bar[XB_TMO])) break; if (sp > XB_SPIN_CAP) { atomicAdd(&bar[XB_TMO], 1u); break; } }
    }
    nloc = mine > 0u ? mine : 1u; nx = cnt > 0u ? cnt : 1u;
}
__device__ __forceinline__ void xcd_barrier(const XcdBarrier& b) {
    asm volatile("s_waitcnt vmcnt(0)" ::: "memory");
    __syncthreads();
    if (threadIdx.x == 0) {
        unsigned* bar = b.bar;
        __builtin_amdgcn_s_waitcnt(0);
        unsigned nloc = b.st[0], nx = b.st[1];
        if (nloc == 0u) { xcd_barrier_complete(bar, b.x, nloc, nx); b.st[0] = nloc; b.st[1] = nx; }
        const unsigned old = xb_add(&bar[XB_XSUB(b.x)], 1u);
        const unsigned gen = old / nloc;
        if (old + 1u == (gen + 1u) * nloc) {
            __builtin_amdgcn_fence(__ATOMIC_RELEASE, "agent");
            asm volatile("s_waitcnt vmcnt(0)" ::: "memory");
            const unsigned og = xb_add(&bar[XB_TOP], 1u);
            const unsigned tg = og / nx;
            if (og + 1u == (tg + 1u) * nx) xb_add(&bar[XB_TOPGEN], 1u);
            else XB_SPIN(xb_ld(&bar[XB_TOPGEN]) == tg, bar);
            __builtin_amdgcn_fence(__ATOMIC_ACQUIRE, "agent");
            xb_add(&bar[XB_XGEN(b.x)], 1u);
            asm volatile("s_waitcnt vmcnt(0)" ::: "memory");
        } else {
            XB_SPIN(xb_ld(&bar[XB_XGEN(b.x)]) == gen, bar);
            __builtin_amdgcn_fence(__ATOMIC_ACQUIRE, "agent");
            asm volatile("s_waitcnt vmcnt(0)" ::: "memory");
        }
    }
    __syncthreads();
}

struct Args { const float* in[28]; float* out; unsigned char* ws; int ph_lo, ph_hi; };
typedef const __attribute__((address_space(4))) Args* CArgs;
__device__ __forceinline__ CArgs args_ptr() { unsigned long long p = (unsigned long long)__builtin_amdgcn_kernarg_segment_ptr(); asm volatile("" : "+s"(p)); return (CArgs)p; }

template <bool QKVMAP>
__device__ __forceinline__ void transpose_item(const float* W, int K, int N, bf16_t* WT, int item, int lane) {
    const int nblk = N / 64, kb = item / nblk, nb = item % nblk, k0 = 64 * kb, n = 64 * nb + lane;
    int nr = n;
    if (QKVMAP && n < 2048) { const int c = n & 255; nr = (n - c) + ((c & 63) >> 5) * 128 + (c >> 6) * 32 + (c & 31); }
    const float* src = W + (size_t)k0 * N + n;
    bf16_t* dst = WT + (size_t)nr * K + k0;
#pragma unroll
    for (int half = 0; half < 2; ++half) {
        float v[32];
#pragma unroll
        for (int j = 0; j < 32; ++j) v[j] = src[(size_t)(32 * half + j) * N];
#pragma unroll
        for (int c = 0; c < 4; ++c) { u32x4 w; w.x = pk2(v[8 * c], v[8 * c + 1]); w.y = pk2(v[8 * c + 2], v[8 * c + 3]); w.z = pk2(v[8 * c + 4], v[8 * c + 5]); w.w = pk2(v[8 * c + 6], v[8 * c + 7]);
            *(u32x4*)(dst + 32 * half + 8 * c) = w; }
    }
}

__global__ void __launch_bounds__(512, 2) fwd_kernel(Args args_by_value_unused) {
    extern __shared__ __attribute__((aligned(16))) unsigned char lds_raw[];
    LAS unsigned char* lds = (LAS unsigned char*)lds_raw;
    const int tid = threadIdx.x, lane = tid & 63; const int wave = __builtin_amdgcn_readfirstlane(tid >> 6);
    const int G = gridDim.x; const int bx = blockIdx.x; const int vcu = (G % 8 == 0) ? (bx % 8) * (G / 8) + bx / 8 : bx;
    int lo, hi;
    volatile LAS unsigned* MISC = (volatile LAS unsigned*)(lds + MISC_OFF);
    for (int u = tid; u < (LDS_BYTES - LDSCTL_OFF) / 4; u += 512) ((LAS unsigned*)(lds + LDSCTL_OFF))[u] = 0u;
    __syncthreads();
    XcdBarrier bar;
    { CArgs A = args_ptr(); lo = A->ph_lo; hi = A->ph_hi; unsigned* ctl = (unsigned*)(A->ws + WS_CTL);
      bar.bar = ctl + CW_BAR; bar.x = 0; bar.st = nullptr;
      if (MK_SINGLE) bar = xcd_barrier_post(ctl + CW_BAR, MISC + 8); }
#define IN(k) (lo <= (k) && (k) < hi)
#define SEAM(k) do { if (IN(k) && IN((k) + 1)) xcd_barrier(bar); } while (0)
    const int gw = vcu * 8 + wave, NGW = G * 8;

    if (EN_PRO && IN(0)) {
        {
            CArgs A = args_ptr();
            LAS float* sl = (LAS float*)lds;
            LAS f32x4* red = (LAS f32x4*)(lds + 20480);
            const float* c = A->in[6]; const float* cctx = A->in[7]; float* mod = (float*)(A->ws + WS_MOD);
            for (int idx = tid; idx < 5120; idx += 512) { const int n = idx >> 10, k = idx & 1023; const float x = n == 0 ? cctx[k] : c[(n - 1) * 1024 + k]; sl[idx] = x / (1.f + __expf(-x)); }
            __syncthreads();
            for (int wq = bx; wq < 256; wq += G) {
                const int l = wq >> 6, cb = (wq & 63) * 96;
                if (tid < 384) {
                    const int cg = tid % 24, ks = tid / 24;
                    const float* wp = A->in[8] + ((size_t)l * 1024 + ks * 64) * 6144 + cb + 4 * cg;
                    f32x4 a[5];
#pragma unroll
                    for (int n = 0; n < 5; ++n) a[n] = (f32x4){0.f, 0.f, 0.f, 0.f};
#pragma unroll 8
                    for (int k = 0; k < 64; ++k) { const f32x4 w4 = *(const f32x4*)(wp + (size_t)k * 6144);
#pragma unroll
                        for (int n = 0; n < 5; ++n) a[n] += sl[n * 1024 + ks * 64 + k] * w4; }
#pragma unroll
                    for (int n = 0; n < 5; ++n) red[(ks * 24 + cg) * 5 + n] = a[n];
                }
                __syncthreads();
                if (tid < 120) { const int cg = tid / 5, n = tid % 5; f32x4 s = *(const f32x4*)(A->in[9] + l * 6144 + cb + 4 * cg);
                    for (int ks = 0; ks < 16; ++ks) s += red[(ks * 24 + cg) * 5 + n];
                    *(f32x4*)(mod + ((size_t)l * 5 + n) * 6144 + cb + 4 * cg) = s; }
                __syncthreads();
            }
        }
        if (bx == 0) {
            CArgs A = args_ptr(); float* ropet = (float*)(A->ws + WS_ROPE);
            for (int idx = tid; idx < 1024; idx += 512) { const int pos = idx >> 4, j = idx & 15; const float fr = powf(10000.f, -(float)j / 16.f); const float ang = (float)pos * fr; ropet[2 * idx] = cosf(ang); ropet[2 * idx + 1] = sinf(ang); }
        }
        if (bx == 1 % G && wave < 2) {
            CArgs A = args_ptr(); float* lamv = (float*)(A->ws + WS_LAM);
            const int i = wave; const float a1 = A->in[18][i * 64 + lane] * A->in[19][i * 64 + lane], a2 = A->in[20][i * 64 + lane] * A->in[21][i * 64 + lane];
            const float s1 = wave_sum(a1), s2 = wave_sum(a2); const float linit = 0.8f - 0.6f * expf(-0.3f * (float)(2 * i));
            if (lane == 0) lamv[i] = expf(s1) - expf(s2) + linit;
        }
        {
            CArgs A = args_ptr(); bf16_t* cache = (bf16_t*)(A->ws + WS_CACHE);
            for (int ch = gw * 64 + lane; ch < 4 * 2 * 4 * 256 * 128; ch += NGW * 64) {
                const int c8 = ch & 127, t = (ch >> 7) & 255, b = (ch >> 15) & 3, i = (ch >> 17) & 1, kind = ch >> 18;
                const float* src = A->in[2 + kind] + (((size_t)(b * 2 + i) * 256 + t) * 1024);
                f32x4 v0, v1;
                if ((kind & 1) == 0) { const int Gh = c8 >> 3, p8 = c8 & 7, bj = p8 >> 2, fq = p8 & 3; const float* sp = src + 64 * Gh + 32 * bj + 4 * fq; v0 = *(const f32x4*)sp; v1 = *(const f32x4*)(sp + 16); }
                else { v0 = *(const f32x4*)(src + 8 * c8); v1 = *(const f32x4*)(src + 8 * c8 + 4); }
                u32x4 w; w.x = pk2(v0[0], v0[1]); w.y = pk2(v0[2], v0[3]); w.z = pk2(v1[0], v1[1]); w.w = pk2(v1[2], v1[3]);
                *(u32x4*)(cache + (size_t)ch * 8) = w;
            }
        }
        {
            constexpr int I_QKV = 16 * 48, I_O = 16 * 16, I_1 = 16 * 64, I_2 = 64 * 16, I_L = I_QKV + I_O + I_1 + I_2;
            for (int it = gw; it < DEPTH * I_L; it += NGW) {
                CArgs A = args_ptr();
                const int l = it / I_L, i = l >> 1; int r = it % I_L;
                unsigned char* wl = A->ws + WS_W + (size_t)l * W_LAYER;
                if (r < I_QKV) { transpose_item<true>(A->in[(l & 1) ? 23 : 14] + (size_t)i * 1024 * 3072, 1024, 3072, (bf16_t*)(wl + W_QKV), r, lane); continue; } r -= I_QKV;
                if (r < I_O) { transpose_item<false>(A->in[(l & 1) ? 24 : 15] + (size_t)i * 1024 * 1024, 1024, 1024, (bf16_t*)(wl + W_O), r, lane); continue; } r -= I_O;
                if (r < I_1) { transpose_item<false>(A->in[12] + (size_t)l * 1024 * 4096, 1024, 4096, (bf16_t*)(wl + W_1), r, lane); continue; } r -= I_1;
                transpose_item<false>(A->in[13] + (size_t)l * 4096 * 1024, 4096, 1024, (bf16_t*)(wl + W_2), r, lane);
            }
        }
    }
    SEAM(0);

    for (int l = 0; l < DEPTH; ++l) {
        const int pb = 1 + 7 * l, i = l >> 1; const bool diff = (l & 1) == 0;
#define NORM_PHASE(FIRST, GIDX, SHC) do { CArgs A = args_ptr(); int ptid = threadIdx.x; asm volatile("" : "+v"(ptid)); const int lane = ptid & 63; const int gw = vcu * 8 + __builtin_amdgcn_readfirstlane(ptid >> 6); \
            const float* rp_ = (FIRST) ? A->in[0] : A->out + OUT_Y; const float* rs_ = (FIRST) ? A->in[1] : A->out + OUT_Y + (size_t)MP * D; \
            const float* gam_ = A->in[GIDX] + l * 1024; const float* modl_ = (const float*)(A->ws + WS_MOD) + (size_t)l * 5 * 6144; bf16_t* XN_ = (bf16_t*)(A->ws + WS_XN); \
            for (int row = gw; row < M; row += NGW) { \
                const float* xr = row < MP ? rp_ + (size_t)row * D : rs_ + (size_t)(row - MP) * D; \
                const float* mrow = modl_ + (row < MP ? 0 : 1 + ((row - MP) >> 10)) * 6144 + (SHC) * 1024; \
                f32x4 v[4]; float ss = 0.f; \
                _Pragma("unroll") for (int j = 0; j < 4; ++j) { v[j] = *(const f32x4*)(xr + 4 * lane + 256 * j); ss += (v[j][0] * v[j][0] + v[j][1] * v[j][1]) + (v[j][2] * v[j][2] + v[j][3] * v[j][3]); } \
                const float rstd = rsqrtf(wave_sum(ss) * (1.f / D) + EPS); \
                _Pragma("unroll") for (int j = 0; j < 4; ++j) { const int c = 4 * lane + 256 * j; const f32x4 g = *(const f32x4*)(gam_ + c), sh = *(const f32x4*)(mrow + c), sc = *(const f32x4*)(mrow + 1024 + c); \
                    const f32x4 h = v[j] * rstd * g * (1.f + sc) + sh; u32x2 w; w.x = pk2(h[0], h[1]); w.y = pk2(h[2], h[3]); *(u32x2*)(XN_ + (size_t)row * D + c) = w; } \
            } } while (0)
        if (EN_NORM && IN(pb + 0)) NORM_PHASE(l == 0, 10, 0);
        SEAM(pb + 0);
        if (EN_QKV && IN(pb + 1)) {
            {
                CArgs A = args_ptr(); unsigned char* ws = A->ws; int ptid = threadIdx.x; asm volatile("" : "+v"(ptid)); const bf16_t* wq = (const bf16_t*)(ws + WS_W + (size_t)l * W_LAYER + W_QKV);
                pg8::Gemm g{(const bf16_t*)(ws + WS_XN), wq, 1024}; pg8::StaticOrder S; S.init(32, 8, G, bx);
                pg8::EpiQK E{(bf16_t*)(ws + WS_Q), (bf16_t*)(ws + WS_K), A->in[diff ? 16 : 25] + i * 64, A->in[diff ? 17 : 26] + i * 64, diff ? (const float*)(ws + WS_ROPE) : nullptr,
                             A->out + (diff ? OUT_DK : OUT_NK) + (size_t)i * 256 * 1024};
                pg8::gemm_phase<pg8::EpiQK, 2, true>(lds, g, S, E, ptid);
            }
            {
                CArgs A = args_ptr(); unsigned char* ws = A->ws; int ptid = threadIdx.x; asm volatile("" : "+v"(ptid)); const bf16_t* wq = (const bf16_t*)(ws + WS_W + (size_t)l * W_LAYER + W_QKV);
                pg8::Gemm g{(const bf16_t*)(ws + WS_XN), wq + (size_t)2048 * 1024, 1024}; pg8::StaticOrder S; S.init(32, 8, G, bx);
                pg8::EpiV E{(bf16_t*)(ws + WS_V), A->out + (diff ? OUT_DV : OUT_NV) + (size_t)i * 256 * 1024};
                pg8::gemm_phase<pg8::EpiV, 1, true>(lds, g, S, E, ptid);
            }
        }
        SEAM(pb + 1);
        if (EN_ATT && IN(pb + 2)) {
            for (int v = vcu; v < 256; v += G) {
                if (diff) {
                    const float linit = 0.8f - 0.6f * expf(-0.3f * (float)l);
                    {
                        CArgs A = args_ptr(); unsigned char* ws = A->ws; int ptid = threadIdx.x; asm volatile("" : "+v"(ptid)); const bf16_t* Qb = (const bf16_t*)(ws + WS_Q); const bf16_t* Kb = (const bf16_t*)(ws + WS_K); const bf16_t* Vb = (const bf16_t*)(ws + WS_V); bf16_t* Ob = (bf16_t*)(ws + WS_O);
                        const float lam = ((const float*)(ws + WS_LAM))[i]; const float* subg = A->in[22] + i * 128;
                        const int pw = __builtin_amdgcn_readfirstlane(ptid >> 6), rg = pw & 3, mp = pw >> 2; const int b = v >> 4, h = (v >> 1) & 7, qb = v & 1; const int q0 = b * 256 + qb * 128 + rg * 32;
                        att::Seg sg{Kb + (size_t)(b * 256) * D + h * 128, Vb + (size_t)(b * 256) * D + h * 128, 4, nullptr, nullptr, 0};
                        att::attn_unit<true, false>(ptid, lds, Qb + (size_t)q0 * D + h * 128 + mp * 64, sg, Ob + (size_t)q0 * D + h * 128, 0, 0, 0, nullptr, lam, 1.f - linit, subg);
                    }
                    {
                        CArgs A = args_ptr(); unsigned char* ws = A->ws; int ptid = threadIdx.x; asm volatile("" : "+v"(ptid)); const bf16_t* Qb = (const bf16_t*)(ws + WS_Q); const bf16_t* Kb = (const bf16_t*)(ws + WS_K); const bf16_t* Vb = (const bf16_t*)(ws + WS_V); bf16_t* Ob = (bf16_t*)(ws + WS_O);
                        const bf16_t* cache = (const bf16_t*)(ws + WS_CACHE);
                        const float lam = ((const float*)(ws + WS_LAM))[i]; const float* subg = A->in[22] + i * 128;
                        const int pw = __builtin_amdgcn_readfirstlane(ptid >> 6), rg = pw & 3, mp = pw >> 2; const int b = v >> 6, h = (v >> 3) & 7, qb = v & 7; const int q0 = MP + b * 1024 + qb * 128 + rg * 32;
                        const bf16_t* ck = cache + ((size_t)(0 * 2 + i) * 4 + b) * 256 * 1024 + h * 128; const bf16_t* cv = cache + ((size_t)(1 * 2 + i) * 4 + b) * 256 * 1024 + h * 128;
                        att::Seg sg{Kb + (size_t)(MP + b * 1024) * D + h * 128, Vb + (size_t)(MP + b * 1024) * D + h * 128, 16, ck, cv, 4};
                        att::attn_unit<true, false>(ptid, lds, Qb + (size_t)q0 * D + h * 128 + mp * 64, sg, Ob + (size_t)q0 * D + h * 128, 0, 0, 0, nullptr, lam, 1.f - linit, subg);
                    }
                } else {
                    {
                        CArgs A = args_ptr(); unsigned char* ws = A->ws; int ptid = threadIdx.x; asm volatile("" : "+v"(ptid)); const bf16_t* Qb = (const bf16_t*)(ws + WS_Q); const bf16_t* Kb = (const bf16_t*)(ws + WS_K); const bf16_t* Vb = (const bf16_t*)(ws + WS_V); bf16_t* Ob = (bf16_t*)(ws + WS_O);
                        const int pw = __builtin_amdgcn_readfirstlane(ptid >> 6); const int b = v >> 4, h = v & 15; const int q0 = b * 256 + pw * 32;
                        att::Seg sg{Kb + (size_t)(b * 256) * D + h * 64, Vb + (size_t)(b * 256) * D + h * 64, 4, nullptr, nullptr, 0};
                        att::attn_unit<false, false>(ptid, lds, Qb + (size_t)q0 * D + h * 64, sg, Ob + (size_t)q0 * D + h * 64, 0, 0, 0, nullptr, 0.f, 0.f, nullptr);
                    }
                    {
                        CArgs A = args_ptr(); unsigned char* ws = A->ws; int ptid = threadIdx.x; asm volatile("" : "+v"(ptid)); const bf16_t* Qb = (const bf16_t*)(ws + WS_Q); const bf16_t* Kb = (const bf16_t*)(ws + WS_K); const bf16_t* Vb = (const bf16_t*)(ws + WS_V); bf16_t* Ob = (bf16_t*)(ws + WS_O);
                        const bf16_t* cache = (const bf16_t*)(ws + WS_CACHE);
                        const int b = v >> 6, h = (v >> 2) & 15, R = v & 3; const int pw = __builtin_amdgcn_readfirstlane(ptid >> 6); const int r_q = 4 * R + (pw >> 1), jj = pw & 1; const int q0 = MP + b * 1024 + r_q * 64 + jj * 32;
                        const int kr_lo = min(max(4 * R - 4, 0), 8), kr_hi = min(max(4 * R + 3 - 4, 0), 8) + 8;
                        const bf16_t* ck = cache + ((size_t)(2 * 2 + i) * 4 + b) * 256 * 1024 + h * 64; const bf16_t* cv = cache + ((size_t)(3 * 2 + i) * 4 + b) * 256 * 1024 + h * 64;
                        att::Seg sg{Kb + (size_t)(MP + b * 1024 + kr_lo * 64) * D + h * 64, Vb + (size_t)(MP + b * 1024 + kr_lo * 64) * D + h * 64, kr_hi - kr_lo, ck, cv, 4};
                        att::attn_unit<false, true>(ptid, lds, Qb + (size_t)q0 * D + h * 64, sg, Ob + (size_t)q0 * D + h * 64, kr_lo, r_q, jj, A->in[27] + ((size_t)i * 16 + h) * 465, 0.f, 0.f, nullptr);
                    }
                }
            }
        }
        SEAM(pb + 2);
        if (EN_O && IN(pb + 3)) {
            CArgs A = args_ptr(); unsigned char* ws = A->ws; int ptid = threadIdx.x; asm volatile("" : "+v"(ptid)); float* out = A->out;
            pg8::Gemm g{(const bf16_t*)(ws + WS_O), (const bf16_t*)(ws + WS_W + (size_t)l * W_LAYER + W_O), 1024}; pg8::StaticOrder S; S.init(32, 8, G, bx);
            pg8::EpiResid E{l == 0 ? A->in[0] : out + OUT_Y, l == 0 ? A->in[1] : out + OUT_Y + (size_t)MP * D, out + OUT_Y, (const float*)(ws + WS_MOD) + (size_t)l * 5 * 6144 + 2 * 1024};
            pg8::gemm_phase<pg8::EpiResid, 1, true>(lds, g, S, E, ptid);
        }
        SEAM(pb + 3);
        if (EN_NORM && IN(pb + 4)) NORM_PHASE(false, 11, 3);
        SEAM(pb + 4);
        if (EN_FC1 && IN(pb + 5)) {
            CArgs A = args_ptr(); unsigned char* ws = A->ws; int ptid = threadIdx.x; asm volatile("" : "+v"(ptid));
            pg8::Gemm g{(const bf16_t*)(ws + WS_XN), (const bf16_t*)(ws + WS_W + (size_t)l * W_LAYER + W_1), 1024}; pg8::StaticOrder S; S.init(32, 16, G, bx);
            pg8::EpiRelu2 E{(bf16_t*)(ws + WS_H)};
            pg8::gemm_phase<pg8::EpiRelu2, 2, true>(lds, g, S, E, ptid);
        }
        SEAM(pb + 5);
        if (EN_FC2 && IN(pb + 6)) {
            CArgs A = args_ptr(); unsigned char* ws = A->ws; int ptid = threadIdx.x; asm volatile("" : "+v"(ptid)); float* out = A->out;
            pg8::Gemm g{(const bf16_t*)(ws + WS_H), (const bf16_t*)(ws + WS_W + (size_t)l * W_LAYER + W_2), 4096}; pg8::StaticOrder S; S.init(32, 8, G, bx);
            pg8::EpiResid E{out + OUT_Y, out + OUT_Y + (size_t)MP * D, out + OUT_Y, (const float*)(ws + WS_MOD) + (size_t)l * 5 * 6144 + 5 * 1024};
            pg8::gemm_phase<pg8::EpiResid, 1, true>(lds, g, S, E, ptid);
        }
        SEAM(pb + 6);
    }
#undef IN
#undef SEAM
#undef NORM_PHASE
}

extern "C" void kernel_launch(void* const* d_in, const int* in_sizes, int n_in, void* d_out, int out_size, void* d_ws, size_t ws_size, hipStream_t stream) {
    static int grid = 0;
    if (grid == 0) {
        if (n_in != 28 || out_size != 41943040 || ws_size < WS_END) { fprintf(stderr, "kernel_launch: unexpected shapes (n_in %d, out %d, ws %zu); nothing launched\n", n_in, out_size, ws_size); grid = -1; return; }
        int dev = 0, cus = 0;
        if (hipGetDevice(&dev) != hipSuccess || hipDeviceGetAttribute(&cus, hipDeviceAttributeMultiprocessorCount, dev) != hipSuccess) { grid = -1; return; }
        if (hipFuncSetAttribute((const void*)fwd_kernel, hipFuncAttributeMaxDynamicSharedMemorySize, LDS_BYTES) != hipSuccess) { fprintf(stderr, "kernel_launch: hipFuncSetAttribute failed\n"); grid = -1; return; }
        int per_cu = 0;
        if (hipOccupancyMaxActiveBlocksPerMultiprocessor(&per_cu, (const void*)fwd_kernel, 512, LDS_BYTES) != hipSuccess || per_cu < 1) fprintf(stderr, "kernel_launch: occupancy query reports %d\n", per_cu);
        (void)hipGetLastError();
        grid = cus;
    }
    if (grid < 0) return;
    (void)hipMemsetAsync((char*)d_ws + WS_CTL, 0, CTL_ZERO_BYTES, stream);
    Args a{};
    for (int i = 0; i < 28; ++i) a.in[i] = (const float*)d_in[i];
    a.out = (float*)d_out; a.ws = (unsigned char*)d_ws;
    constexpr int NPH = 1 + 7 * DEPTH;
#if MK_SINGLE
    a.ph_lo = 0; a.ph_hi = NPH;
    hipLaunchKernelGGL(fwd_kernel, dim3(grid), dim3(512), LDS_BYTES, stream, a);
#else
    for (int p = 0; p < NPH; ++p) { a.ph_lo = p; a.ph_hi = p + 1; hipLaunchKernelGGL(fwd_kernel, dim3(grid), dim3(512), LDS_BYTES, stream, a); }
#endif
}
```

```cpp
#include <hip/hip_runtime.h>
#include <cstdio>
#include <cstdint>

#ifndef MK_SINGLE
#define MK_SINGLE 1
#endif

#ifndef DUP_PRO
#define DUP_PRO 1
#endif
#ifndef DUP_NORM
#define DUP_NORM 1
#endif
#ifndef DUP_QKV
#define DUP_QKV 1
#endif
#ifndef DUP_ADP
#define DUP_ADP 1
#endif
#ifndef DUP_ADL
#define DUP_ADL 1
#endif
#ifndef DUP_ANP
#define DUP_ANP 1
#endif
#ifndef DUP_ANL
#define DUP_ANL 1
#endif
#ifndef DUP_FC1
#define DUP_FC1 1
#endif
#ifndef DUP_O
#define DUP_O 2
#endif
#ifndef DUP_FC2
#define DUP_FC2 1
#endif
#ifndef DUP_BAR
#define DUP_BAR 1
#endif
#ifndef EN_PRO
#define EN_PRO 1
#endif
#ifndef EN_NORM
#define EN_NORM 1
#endif
#ifndef EN_QKV
#define EN_QKV 1
#endif
#ifndef EN_ATT
#define EN_ATT 1
#endif
#ifndef EN_O
#define EN_O 1
#endif
#ifndef EN_FC1
#define EN_FC1 1
#endif
#ifndef EN_FC2
#define EN_FC2 1
#endif
#define LAS __attribute__((address_space(3)))
#define GAS __attribute__((address_space(1)))
typedef unsigned short bf16_t;
typedef short bf16x8 __attribute__((ext_vector_type(8)));
typedef short s16x4 __attribute__((ext_vector_type(4)));
typedef float f32x4 __attribute__((ext_vector_type(4)));
typedef float f32x2 __attribute__((ext_vector_type(2)));
typedef float f32x16 __attribute__((ext_vector_type(16)));
typedef unsigned u32x4 __attribute__((ext_vector_type(4)));
typedef unsigned u32x2 __attribute__((ext_vector_type(2)));
typedef __bf16 bf16x2_t __attribute__((ext_vector_type(2)));

constexpr int D = 1024, FF = 4096, DEPTH = 4;
constexpr int MP = 4096, M = 8192;
constexpr float EPS = 1e-6f;
constexpr float LOG2E = 1.4426950408889634f;
constexpr float C2 = 0.125f * LOG2E;
constexpr size_t OUT_Y = 0, OUT_DK = 8388608, OUT_DV = 16777216, OUT_NK = 25165824, OUT_NV = 33554432;

constexpr size_t MiB = 1u << 20;
constexpr size_t WS_CTL = 0, CTL_ZERO_BYTES = 64 * 1024;
constexpr size_t WS_MOD = 1 * MiB;
constexpr size_t WS_ROPE = WS_MOD + 512 * 1024;
constexpr size_t WS_LAM = WS_ROPE + 16 * 1024;
constexpr size_t WS_W = 2 * MiB;
constexpr size_t W_LAYER = 24 * MiB, W_QKV = 0, W_O = 6 * MiB, W_1 = 8 * MiB, W_2 = 16 * MiB;
constexpr size_t WS_CACHE = 98 * MiB;
constexpr size_t WS_XN = 114 * MiB, WS_Q = 130 * MiB, WS_K = 146 * MiB, WS_V = 162 * MiB, WS_O = 178 * MiB, WS_H = 194 * MiB, WS_END = 258 * MiB;
constexpr int CW_BAR = 1024;

constexpr int RING_BYTES = 147456;
constexpr int LDSCTL_OFF = RING_BYTES, MISC_OFF = LDSCTL_OFF + 320;
constexpr int LDS_BYTES = 148480;

__device__ __forceinline__ unsigned pk2(float lo, float hi) { f32x2 v = {lo, hi}; bf16x2_t b = __builtin_convertvector(v, bf16x2_t); return __builtin_bit_cast(unsigned, b); }
__device__ __forceinline__ float wave_sum(float v) {
#pragma unroll
    for (int o = 1; o < 64; o <<= 1) v += __shfl_xor(v, o);
    return v;
}
#define LDS_WAIT() asm volatile("s_waitcnt lgkmcnt(0)" ::: "memory")
#define VM_WAIT() asm volatile("s_waitcnt vmcnt(0)" ::: "memory")

namespace pg8 {
constexpr int BM = 256, BK = 64, HALF = 128, HTB = HALF * BK * 2, NXCD = 8, WGM = 8;
__host__ __device__ __forceinline__ int lds_byte(int r, int c) { const int st = (r >> 4) * 2 + (c >> 5), rr = r & 15, cc = c & 31, ob = rr * 64 + cc * 2; return st * 1024 + (ob ^ (((ob >> 9) & 1) << 5)); }
__host__ __device__ __forceinline__ void stage_rc(int b, int& R, int& C) { const int st = b / 1024, sb = b % 1024, swz = sb ^ (((sb >> 9) & 1) << 5); R = (st >> 1) * 16 + swz / 64; C = (st & 1) * 32 + (swz % 64) / 2; }
__host__ __device__ __forceinline__ int perm32(int rho) { const int n = rho >> 4, i = rho & 15; return 8 * (i >> 2) + 4 * n + (i & 3); }

struct Unit { int pm, pn; };
struct Gemm { const bf16_t* A; const bf16_t* Bt; int K; };

struct StaticOrder {
    int nM, nN, nwg, G, c;
    __device__ void init(int nM_, int nN_, int G_, int c_) { nM = nM_; nN = nN_; nwg = nM * nN; G = G_; c = c_; }
    __device__ bool next(int i, Unit& u) const {
        const long L = (long)i * G + c; if (L >= nwg) return false;
        int wgid = (int)L; { const int q = nwg / NXCD, r = nwg % NXCD, xcd = wgid % NXCD, off = wgid / NXCD; wgid = (xcd < r ? xcd * (q + 1) : r * (q + 1) + (xcd - r) * q) + off; }
        const int nig = WGM * nN, gid = wgid / nig, fm = gid * WGM, gsz = (nM - fm) < WGM ? (nM - fm) : WGM;
        u.pm = fm + ((wgid % nig) % gsz); u.pn = (wgid % nig) / gsz; return true;
    }
};

template <class Epi, int NB, bool ALIGN_EPI>
__device__ __forceinline__ void gemm_phase(LAS unsigned char* lds, const Gemm g, const StaticOrder& S, const Epi& E, const int tid) {
    const int wid = __builtin_amdgcn_readfirstlane(tid >> 6), lane = tid & 63, wr = wid >> 2, wc = wid & 3, fr = lane & 15, fq = lane >> 4;
    const int K = g.K, nt = K / BK;
    unsigned voffA[2], voffB[2];
#pragma unroll
    for (int i = 0; i < 2; ++i) { int R, C; stage_rc(tid * 16 + i * 8192, R, C); const int Rb = Epi::PERM ? ((R & ~31) + perm32(R & 31)) : R;
        voffA[i] = (unsigned)(R * K + C) * 2u; voffB[i] = (unsigned)(Rb * K + C) * 2u; }
    const size_t kstep = (size_t)(BK * 2);
    const size_t hstep = (size_t)HALF * K * 2;
    const size_t tstepA = 2 * hstep, tstepB = NB * hstep;
    const unsigned ldsw = (unsigned)wid * 1024u;
    const int aoff = lds_byte(wr * 64 + fr, fq * 8), boff = lds_byte(wc * 32 + fr, fq * 8);
#define PG8_SA(b, h) (((b) * 2 + (h)) * HTB)
#define PG8_SB(b, h) ((4 + (b) * 2 + (h)) * HTB)
#define PG8_STAGE(bufoff, gbase, voff) do { _Pragma("unroll") for (int _i = 0; _i < 2; ++_i) \
        __builtin_amdgcn_global_load_lds((const unsigned*)((const char*)(gbase) + (voff)[_i]), (LAS unsigned*)(lds + (bufoff) + ldsw + _i * 8192), 16, 0, 0); } while (0)
#define PG8_LDA(dst, b, h) do { _Pragma("unroll") for (int m = 0; m < 4; ++m) _Pragma("unroll") for (int k = 0; k < 2; ++k) dst[m][k] = *(const LAS bf16x8*)(lds + PG8_SA(b, h) + aoff + m * 2048 + k * 1024); } while (0)
#define PG8_LDB(dst, b, h) do { _Pragma("unroll") for (int n = 0; n < 2; ++n) _Pragma("unroll") for (int k = 0; k < 2; ++k) dst[n][k] = *(const LAS bf16x8*)(lds + PG8_SB(b, h) + boff + n * 2048 + k * 1024); } while (0)
#define PG8_MMA(ai, bj, At, Bt) do { __builtin_amdgcn_s_setprio(1); _Pragma("unroll") for (int m = 0; m < 4; ++m) _Pragma("unroll") for (int n = 0; n < 2; ++n) _Pragma("unroll") for (int k = 0; k < 2; ++k) \
        acc[ai][bj][m][n] = __builtin_amdgcn_mfma_f32_16x16x32_bf16(Bt[n][k], At[m][k], acc[ai][bj][m][n], 0, 0, 0); __builtin_amdgcn_s_setprio(0); } while (0)
#define PG8_WAIT_V(n) asm volatile("s_waitcnt vmcnt(" #n ")" ::: "memory")
#define PG8_WAIT_L(n) asm volatile("s_waitcnt lgkmcnt(" #n ")" ::: "memory")
#define PG8_BAR __builtin_amdgcn_s_barrier()
#define PG8_SCHED __builtin_amdgcn_sched_barrier(0)
    Unit cur, nxt; int ui = 0;
    if (!S.next(0, cur)) return;
    f32x4 acc[2][NB][4][2];
#pragma unroll
    for (int a = 0; a < 2; ++a)
#pragma unroll
        for (int b = 0; b < NB; ++b)
#pragma unroll
            for (int m = 0; m < 4; ++m)
#pragma unroll
                for (int n = 0; n < 2; ++n) acc[a][b][m][n] = (f32x4){0.f, 0.f, 0.f, 0.f};
    bf16x8 At[4][2], B0[2][2], B1[2][2];
    const char* cA = (const char*)g.A + (size_t)cur.pm * tstepA; const char* cB = (const char*)g.Bt + (size_t)cur.pn * tstepB;
    if constexpr (NB == 2) {
        PG8_STAGE(PG8_SB(0, 0), cB, voffB); PG8_STAGE(PG8_SB(0, 1), cB + hstep, voffB); PG8_STAGE(PG8_SA(0, 0), cA, voffA); PG8_STAGE(PG8_SA(0, 1), cA + hstep, voffA);
        if (wr == 1) PG8_BAR;
        PG8_WAIT_V(2); PG8_BAR;
        PG8_STAGE(PG8_SB(1, 0), cB + kstep, voffB); PG8_STAGE(PG8_SA(1, 0), cA + kstep, voffA); PG8_STAGE(PG8_SB(1, 1), cB + hstep + kstep, voffB);
        PG8_WAIT_V(6); PG8_BAR;
    } else {
        PG8_STAGE(PG8_SB(0, 0), cB, voffB); PG8_STAGE(PG8_SA(0, 0), cA, voffA); PG8_STAGE(PG8_SA(0, 1), cA + hstep, voffA);
        if (wr == 1) PG8_BAR;
        PG8_WAIT_V(2); PG8_BAR;
        PG8_STAGE(PG8_SB(1, 0), cB + kstep, voffB); PG8_STAGE(PG8_SA(1, 0), cA + kstep, voffA);
        PG8_WAIT_V(4); PG8_BAR;
    }
    for (;;) {
        const bool has_next = S.next(ui + 1, nxt);
        const char* nA = has_next ? (const char*)g.A + (size_t)nxt.pm * tstepA : cA; const char* nB = has_next ? (const char*)g.Bt + (size_t)nxt.pn * tstepB : cB;
        for (int t = 0; t < nt; t += 2) {
            const bool last = (t == nt - 2);
            const char* a1 = cA + (size_t)(t + 1) * kstep;
            const char* a2 = last ? nA : cA + (size_t)(t + 2) * kstep; const char* b2 = last ? nB : cB + (size_t)(t + 2) * kstep;
            const char* a3 = a2 + kstep; const char* b3 = b2 + kstep;
            if constexpr (NB == 2) {
            PG8_LDB(B0, 0, 0); PG8_LDB(B1, 0, 1); PG8_SCHED; PG8_LDA(At, 0, 0); PG8_STAGE(PG8_SA(1, 1), a1 + hstep, voffA);
            PG8_WAIT_V(8); PG8_WAIT_L(0); PG8_BAR; PG8_MMA(0, 0, At, B0); PG8_MMA(0, 1, At, B1); PG8_BAR; PG8_SCHED;
            PG8_LDA(At, 0, 1); PG8_STAGE(PG8_SB(0, 0), b2, voffB); PG8_STAGE(PG8_SB(0, 1), b2 + hstep, voffB); PG8_STAGE(PG8_SA(0, 0), a2, voffA);
            PG8_WAIT_V(8); PG8_WAIT_L(0); PG8_BAR; PG8_MMA(1, 0, At, B0); PG8_MMA(1, 1, At, B1); PG8_BAR; PG8_SCHED;
            PG8_LDB(B0, 1, 0); PG8_LDB(B1, 1, 1); PG8_SCHED; PG8_LDA(At, 1, 0); PG8_STAGE(PG8_SA(0, 1), a2 + hstep, voffA);
            PG8_WAIT_V(8); PG8_WAIT_L(0); PG8_BAR; PG8_MMA(0, 0, At, B0); PG8_MMA(0, 1, At, B1); PG8_BAR; PG8_SCHED;
            PG8_LDA(At, 1, 1); PG8_STAGE(PG8_SB(1, 0), b3, voffB); PG8_STAGE(PG8_SB(1, 1), b3 + hstep, voffB); PG8_STAGE(PG8_SA(1, 0), a3, voffA);
            PG8_WAIT_V(8); PG8_WAIT_L(0); PG8_BAR; PG8_MMA(1, 0, At, B0); PG8_MMA(1, 1, At, B1); PG8_BAR; PG8_SCHED;
            } else {
            PG8_LDB(B0, 0, 0); PG8_SCHED; PG8_LDA(At, 0, 0); PG8_STAGE(PG8_SA(1, 1), a1 + hstep, voffA);
            PG8_WAIT_V(6); PG8_WAIT_L(0); PG8_BAR; PG8_MMA(0, 0, At, B0); PG8_BAR; PG8_SCHED;
            PG8_LDA(At, 0, 1); PG8_STAGE(PG8_SB(0, 0), b2, voffB); PG8_STAGE(PG8_SA(0, 0), a2, voffA);
            PG8_WAIT_V(6); PG8_WAIT_L(0); PG8_BAR; PG8_MMA(1, 0, At, B0); PG8_BAR; PG8_SCHED;
            PG8_LDB(B0, 1, 0); PG8_SCHED; PG8_LDA(At, 1, 0); PG8_STAGE(PG8_SA(0, 1), a2 + hstep, voffA);
            PG8_WAIT_V(6); PG8_WAIT_L(0); PG8_BAR; PG8_MMA(0, 0, At, B0); PG8_BAR; PG8_SCHED;
            PG8_LDA(At, 1, 1); PG8_STAGE(PG8_SB(1, 0), b3, voffB); PG8_STAGE(PG8_SA(1, 0), a3, voffA);
            PG8_WAIT_V(6); PG8_WAIT_L(0); PG8_BAR; PG8_MMA(1, 0, At, B0); PG8_BAR; PG8_SCHED;
            }
        }
        if constexpr (ALIGN_EPI) { if (wr == 0) PG8_BAR; }
        E(acc, cur, wr, wc, fr, fq);
        if (!has_next) break;
#pragma unroll
        for (int a = 0; a < 2; ++a)
#pragma unroll
            for (int b = 0; b < NB; ++b)
#pragma unroll
                for (int m = 0; m < 4; ++m)
#pragma unroll
                    for (int n = 0; n < 2; ++n) acc[a][b][m][n] = (f32x4){0.f, 0.f, 0.f, 0.f};
        cur = nxt; cA = nA; cB = nB; ++ui;
        if constexpr (ALIGN_EPI) { if (wr == 1) PG8_BAR; }
    }
    PG8_WAIT_V(0);
    if constexpr (!ALIGN_EPI) { if (wr == 0) PG8_BAR; }
    PG8_BAR;
#undef PG8_SA
#undef PG8_SB
#undef PG8_STAGE
#undef PG8_LDA
#undef PG8_LDB
#undef PG8_MMA
#undef PG8_WAIT_V
#undef PG8_WAIT_L
#undef PG8_BAR
#undef PG8_SCHED
}

template <class Epi, bool ALIGN_EPI>
__device__ __forceinline__ void gemm_phase_n1(LAS unsigned char* lds, const Gemm g, const StaticOrder& S, const Epi& E, const int tid) {
    const int wid = __builtin_amdgcn_readfirstlane(tid >> 6), lane = tid & 63, wr = wid >> 2, wc = wid & 3, fr = lane & 15, fq = lane >> 4;
    const int K = g.K, nt = K / BK;
    unsigned voffA[2], voffB[2];
#pragma unroll
    for (int i = 0; i < 2; ++i) { int R, C; stage_rc(tid * 16 + i * 8192, R, C); const int Rb = Epi::PERM ? ((R & ~31) + perm32(R & 31)) : R;
        voffA[i] = (unsigned)(R * K + C) * 2u; voffB[i] = (unsigned)(Rb * K + C) * 2u; }
    const size_t kstep = (size_t)(BK * 2);
    const size_t hstep = (size_t)HALF * K * 2;
    const size_t tstepA = 2 * hstep, tstepB = hstep;
    const unsigned ldsw = (unsigned)wid * 1024u;
    const int aoff = lds_byte(wr * 64 + fr, fq * 8), boff = lds_byte(wc * 32 + fr, fq * 8);
    constexpr int BUF3 = 3 * HTB;
#define N1_STAGE1(bufoff, gbase, voff) do { _Pragma("unroll") for (int _i = 0; _i < 2; ++_i) \
        __builtin_amdgcn_global_load_lds((const unsigned*)((const char*)(gbase) + (voff)[_i]), (LAS unsigned*)(lds + (bufoff) + ldsw + _i * 8192), 16, 0, 0); } while (0)
#define N1_STAGE3(c, pa, pb) do { N1_STAGE1((c) * BUF3, pb, voffB); N1_STAGE1((c) * BUF3 + HTB, pa, voffA); N1_STAGE1((c) * BUF3 + 2 * HTB, (pa) + hstep, voffA); } while (0)
#define N1_LDA(dst, c, h) do { _Pragma("unroll") for (int m = 0; m < 4; ++m) _Pragma("unroll") for (int k = 0; k < 2; ++k) dst[m][k] = *(const LAS bf16x8*)(lds + (c) * BUF3 + (1 + (h)) * HTB + aoff + m * 2048 + k * 1024); } while (0)
#define N1_LDB(dst, c) do { _Pragma("unroll") for (int n = 0; n < 2; ++n) _Pragma("unroll") for (int k = 0; k < 2; ++k) dst[n][k] = *(const LAS bf16x8*)(lds + (c) * BUF3 + boff + n * 2048 + k * 1024); } while (0)
#define N1_MMA(ai, At, Bt) do { _Pragma("unroll") for (int m = 0; m < 4; ++m) _Pragma("unroll") for (int n = 0; n < 2; ++n) _Pragma("unroll") for (int k = 0; k < 2; ++k) \
        acc[ai][0][m][n] = __builtin_amdgcn_mfma_f32_16x16x32_bf16(Bt[n][k], At[m][k], acc[ai][0][m][n], 0, 0, 0); } while (0)
#define N1_WAIT_V(n) asm volatile("s_waitcnt vmcnt(" #n ")" ::: "memory")
#define N1_WAIT_L(n) asm volatile("s_waitcnt lgkmcnt(" #n ")" ::: "memory")
#define N1_BAR __builtin_amdgcn_s_barrier()
#define N1_SCHED __builtin_amdgcn_sched_barrier(0)
    Unit cur, nxt; int ui = 0;
    if (!S.next(0, cur)) return;
    f32x4 acc[2][1][4][2];
#pragma unroll
    for (int a = 0; a < 2; ++a)
#pragma unroll
        for (int m = 0; m < 4; ++m)
#pragma unroll
            for (int n = 0; n < 2; ++n) acc[a][0][m][n] = (f32x4){0.f, 0.f, 0.f, 0.f};
    bf16x8 At0[4][2], At1[4][2], B0[2][2];
    const char* cA = (const char*)g.A + (size_t)cur.pm * tstepA; const char* cB = (const char*)g.Bt + (size_t)cur.pn * tstepB;
    N1_STAGE3(0, cA, cB); N1_STAGE3(1, cA + kstep, cB + kstep);
    if (wr == 1) N1_BAR;
    N1_WAIT_V(6); N1_BAR;
    N1_BAR;
    int c0 = 0;
    for (;;) {
        const bool has_next = S.next(ui + 1, nxt);
        const char* nA = has_next ? (const char*)g.A + (size_t)nxt.pm * tstepA : cA; const char* nB = has_next ? (const char*)g.Bt + (size_t)nxt.pn * tstepB : cB;
        for (int t = 0; t < nt; ++t) {
            const bool tail = (t + 2 >= nt);
            const char* sa = tail ? nA + (size_t)(t + 2 - nt) * kstep : cA + (size_t)(t + 2) * kstep;
            const char* sb = tail ? nB + (size_t)(t + 2 - nt) * kstep : cB + (size_t)(t + 2) * kstep;
            const int c2 = (c0 == 0) ? 2 : c0 - 1;
            N1_LDB(B0, c0); N1_SCHED; N1_LDA(At0, c0, 0); N1_LDA(At1, c0, 1); N1_STAGE3(c2, sa, sb);
            N1_WAIT_V(6); N1_WAIT_L(0); N1_BAR;
            __builtin_amdgcn_s_setprio(1); N1_MMA(0, At0, B0); N1_MMA(1, At1, B0); __builtin_amdgcn_s_setprio(0);
            N1_BAR; N1_SCHED;
            c0 = (c0 == 2) ? 0 : c0 + 1;
        }
        if constexpr (ALIGN_EPI) { if (wr == 0) N1_BAR; }
        E(acc, cur, wr, wc, fr, fq);
        if (!has_next) break;
#pragma unroll
        for (int a = 0; a < 2; ++a)
#pragma unroll
            for (int m = 0; m < 4; ++m)
#pragma unroll
                for (int n = 0; n < 2; ++n) acc[a][0][m][n] = (f32x4){0.f, 0.f, 0.f, 0.f};
        cur = nxt; cA = nA; cB = nB; ++ui;
        if constexpr (ALIGN_EPI) { if (wr == 1) N1_BAR; }
    }
    N1_WAIT_V(0);
    if constexpr (!ALIGN_EPI) { if (wr == 0) N1_BAR; }
    N1_BAR;
#undef N1_STAGE1
#undef N1_STAGE3
#undef N1_LDA
#undef N1_LDB
#undef N1_MMA
#undef N1_WAIT_V
#undef N1_WAIT_L
#undef N1_BAR
#undef N1_SCHED
}

__device__ __forceinline__ int cond_of_pm(int pm) { return pm < 16 ? 0 : 1 + ((pm - 16) >> 2); }

struct EpiQK {
    static constexpr bool PERM = false;
    bf16_t* Q; bf16_t* Kb; const float* qg; const float* kg; const float* rope; float* outk;
    __device__ __forceinline__ void operator()(const f32x4 (&acc)[2][2][4][2], const Unit& u, int wr, int wc, int fr, int fq) const {
        const bool isk = u.pn >= 4; const int G = (u.pn & 3) * 4 + wc;
        const float* g = isk ? kg : qg; bf16_t* dst = isk ? Kb : Q; const float sc = isk ? 1.f : C2;
        const bool prompt = u.pm < 16; const bool do_rope = (rope != nullptr) && !prompt;
        f32x4 gv[2][2];
#pragma unroll
        for (int bj = 0; bj < 2; ++bj)
#pragma unroll
            for (int n = 0; n < 2; ++n) gv[bj][n] = *(const f32x4*)(g + 32 * bj + 16 * n + 4 * fq);
#pragma unroll
        for (int ai = 0; ai < 2; ++ai)
#pragma unroll
            for (int m = 0; m < 4; ++m) {
                const int row = u.pm * BM + ai * HALF + wr * 64 + m * 16 + fr;
                float ss = 0.f;
#pragma unroll
                for (int bj = 0; bj < 2; ++bj)
#pragma unroll
                    for (int n = 0; n < 2; ++n) { const f32x4 x = acc[ai][bj][m][n]; ss += (x[0] * x[0] + x[1] * x[1]) + (x[2] * x[2] + x[3] * x[3]); }
                ss += __shfl_xor(ss, 16); ss += __shfl_xor(ss, 32);
                const float rstd = rsqrtf(ss * (1.f / 64.f) + EPS);
                f32x4 x[2][2];
#pragma unroll
                for (int bj = 0; bj < 2; ++bj)
#pragma unroll
                    for (int n = 0; n < 2; ++n) x[bj][n] = acc[ai][bj][m][n] * rstd * gv[bj][n];
                if (isk && prompt) {
                    float* o = outk + (size_t)u.pm * (2 * 256 * 1024) + (size_t)(row & 255) * 1024 + 64 * G + 4 * fq;
#pragma unroll
                    for (int bj = 0; bj < 2; ++bj)
#pragma unroll
                        for (int n = 0; n < 2; ++n) *(f32x4*)(o + 32 * bj + 16 * n) = x[bj][n];
                }
                if (do_rope) {
                    const int t = (row - MP) & 1023;
#pragma unroll
                    for (int bj = 0; bj < 2; ++bj) {
                        const int pos = bj == 0 ? (t >> 6) : (t & 63);
                        const f32x4 cs01 = *(const f32x4*)(rope + (pos * 16 + 4 * fq) * 2), cs23 = *(const f32x4*)(rope + (pos * 16 + 4 * fq) * 2 + 4);
                        const float cc[4] = {cs01[0], cs01[2], cs23[0], cs23[2]}, sn[4] = {cs01[1], cs01[3], cs23[1], cs23[3]};
#pragma unroll
                        for (int e = 0; e < 4; ++e) { const float x0 = x[bj][0][e], x1 = x[bj][1][e]; x[bj][0][e] = x0 * cc[e] - x1 * sn[e]; x[bj][1][e] = x1 * cc[e] + x0 * sn[e]; }
                    }
                }
                bf16_t* rp = dst + (size_t)row * D + 64 * G + 8 * fq;
#pragma unroll
                for (int bj = 0; bj < 2; ++bj) { const f32x4 v0 = x[bj][0] * sc, v1 = x[bj][1] * sc;
                    u32x4 w; w.x = pk2(v0[0], v0[1]); w.y = pk2(v0[2], v0[3]); w.z = pk2(v1[0], v1[1]); w.w = pk2(v1[2], v1[3]);
                    *(u32x4*)(rp + 32 * bj) = w; }
            }
    }
};
struct EpiV {
    static constexpr bool PERM = true;
    bf16_t* V; float* outv;
    __device__ __forceinline__ void operator()(const f32x4 (&acc)[2][1][4][2], const Unit& u, int wr, int wc, int fr, int fq) const {
        const int col0 = u.pn * HALF + wc * 32 + 8 * fq; const bool prompt = u.pm < 16;
#pragma unroll
        for (int ai = 0; ai < 2; ++ai)
#pragma unroll
            for (int m = 0; m < 4; ++m) {
                const int row = u.pm * BM + ai * HALF + wr * 64 + m * 16 + fr;
                const f32x4 v0 = acc[ai][0][m][0], v1 = acc[ai][0][m][1];
                u32x4 w; w.x = pk2(v0[0], v0[1]); w.y = pk2(v0[2], v0[3]); w.z = pk2(v1[0], v1[1]); w.w = pk2(v1[2], v1[3]);
                *(u32x4*)(V + (size_t)row * D + col0) = w;
                if (prompt) { float* o = outv + (size_t)u.pm * (2 * 256 * 1024) + (size_t)(row & 255) * 1024 + col0; *(f32x4*)o = v0; *(f32x4*)(o + 4) = v1; }
            }
    }
};
struct EpiResid {
    static constexpr bool PERM = true;
    const float* resid_p; const float* resid_s; float* out; const float* gate;
    __device__ __forceinline__ void operator()(const f32x4 (&acc)[2][1][4][2], const Unit& u, int wr, int wc, int fr, int fq) const {
        const int col0 = u.pn * HALF + wc * 32 + 8 * fq;
        const float* gp = gate + cond_of_pm(u.pm) * 6144 + col0;
        const f32x4 g0 = *(const f32x4*)gp, g1 = *(const f32x4*)(gp + 4);
        const float* src = u.pm < 16 ? resid_p + (size_t)u.pm * BM * D : resid_s + (size_t)(u.pm - 16) * BM * D;
        float* dstb = out + (size_t)u.pm * BM * D;
#pragma unroll
        for (int ai = 0; ai < 2; ++ai)
#pragma unroll
            for (int m = 0; m < 4; ++m) {
                const size_t off = (size_t)(ai * HALF + wr * 64 + m * 16 + fr) * D + col0;
                const f32x4 r0 = *(const f32x4*)(src + off), r1 = *(const f32x4*)(src + off + 4);
                *(f32x4*)(dstb + off) = r0 + g0 * acc[ai][0][m][0]; *(f32x4*)(dstb + off + 4) = r1 + g1 * acc[ai][0][m][1];
            }
    }
};
struct EpiRelu2 {
    static constexpr bool PERM = true;
    bf16_t* H;
    __device__ __forceinline__ void operator()(const f32x4 (&acc)[2][2][4][2], const Unit& u, int wr, int wc, int fr, int fq) const {
        const int col0 = u.pn * BM + wc * 32 + 8 * fq;
#pragma unroll
        for (int ai = 0; ai < 2; ++ai)
#pragma unroll
            for (int m = 0; m < 4; ++m) {
                bf16_t* rp = H + (size_t)(u.pm * BM + ai * HALF + wr * 64 + m * 16 + fr) * FF + col0;
#pragma unroll
                for (int bj = 0; bj < 2; ++bj) {
                    f32x4 v0 = acc[ai][bj][m][0], v1 = acc[ai][bj][m][1];
#pragma unroll
                    for (int e = 0; e < 4; ++e) { const float a = fmaxf(v0[e], 0.f), b = fmaxf(v1[e], 0.f); v0[e] = a * a; v1[e] = b * b; }
                    u32x4 w; w.x = pk2(v0[0], v0[1]); w.y = pk2(v0[2], v0[3]); w.z = pk2(v1[0], v1[1]); w.w = pk2(v1[2], v1[3]);
                    *(u32x4*)(rp + bj * HALF) = w; }
            }
    }
};
}

namespace att {
constexpr float THR = 8.f, NEG = -1e30f;
__device__ __forceinline__ int crow(int r, int hi) { return (r & 3) + 8 * (r >> 2) + 4 * hi; }
__device__ __forceinline__ s16x4 vtr(const LAS char* p) { return __builtin_bit_cast(s16x4, __builtin_amdgcn_ds_read_tr16_b64_v4i16((LAS s16x4*)p)); }

struct Seg { const bf16_t* K1; const bf16_t* V1; int nt1; const bf16_t* K2; const bf16_t* V2; int nt2; };

template <bool DIFF, bool NA>
__device__ __forceinline__ void attn_unit(const int tid, LAS unsigned char* lds, const bf16_t* Qw  , const Seg sg, bf16_t* Ow  ,
                                          int kr_lo, int r_q, int jj, const float* relb  ,
                                          float lam, float post_scale, const float* subg) {
    constexpr int KW = DIFF ? 256 : 128, VW = DIFF ? 256 : 128, KS = KW + 16, VS = VW + 64, KBY = 64 * KS, VBY = 64 * VS, BUF = KBY + VBY;
    constexpr int DVB = DIFF ? 4 : 2, KC = DIFF ? 2 : 1;
    constexpr int WSF_OFF = 2 * BUF, BIAS_OFF = WSF_OFF + 2048, OST_OFF = BIAS_OFF + 2048;
    const int lane = tid & 63, l31 = lane & 31, hi = lane >> 5; const int wid = __builtin_amdgcn_readfirstlane(tid >> 6);
    const int mp = DIFF ? (wid >> 2) : 0;
    LAS float* wsf = (LAS float*)(lds + WSF_OFF) + wid * 64;
    LAS float* biasl = (LAS float*)(lds + BIAS_OFF);
    const int nt = sg.nt1 + sg.nt2;
    int srow[KC], sch[KC];
#pragma unroll
    for (int i = 0; i < KC; ++i) { const int ci = tid + 512 * i; srow[i] = ci / (KW / 16); sch[i] = ci % (KW / 16); }
    u32x4 kst[KC], vst[KC];
#define ATT_LOAD(t) do { const bf16_t* kb_ = (t) < sg.nt1 ? sg.K1 + (size_t)(t) * 64 * D : sg.K2 + (size_t)((t) - sg.nt1) * 64 * D; \
        const bf16_t* vb_ = (t) < sg.nt1 ? sg.V1 + (size_t)(t) * 64 * D : sg.V2 + (size_t)((t) - sg.nt1) * 64 * D; \
        _Pragma("unroll") for (int i = 0; i < KC; ++i) { kst[i] = *(const u32x4*)(kb_ + (size_t)srow[i] * D + sch[i] * 8); vst[i] = *(const u32x4*)(vb_ + (size_t)srow[i] * D + sch[i] * 8); } } while (0)
#define ATT_STORE(b) do { _Pragma("unroll") for (int i = 0; i < KC; ++i) { *(LAS u32x4*)(lds + (b) * BUF + srow[i] * KS + sch[i] * 16) = kst[i]; *(LAS u32x4*)(lds + (b) * BUF + KBY + srow[i] * VS + sch[i] * 16) = vst[i]; } } while (0)
    ATT_LOAD(0);
    if (NA) { for (int i = tid; i < 465; i += 512) biasl[i] = relb[i] * LOG2E; }
    bf16x8 qf[4];
#pragma unroll
    for (int d0 = 0; d0 < 4; ++d0) qf[d0] = *(const bf16x8*)(Qw + (size_t)l31 * D + d0 * 16 + hi * 8);
    f32x16 o[DVB];
#pragma unroll
    for (int i = 0; i < DVB; ++i) o[i] = f32x16{};
    float mrun = NEG, lsum = 0.f;
    ATT_STORE(0);
    __syncthreads();
    const int rs_q = NA ? min(max(r_q - 4, 0), 8) : 0;
    const int cq = 32 * jj + l31, cs = min(max(cq - 8, 0), 48);
    const int kvoff = KBY + (4 * hi + ((lane & 15) >> 2)) * VS + ((lane >> 4) & 1) * 32 + (lane & 3) * 8;
    for (int t = 0; t < nt; ++t) {
        const bool more = (t + 1 < nt);
        if (more) ATT_LOAD(t + 1);
        bool active = true; int kr = 0;
        if (NA && t < sg.nt1) { kr = kr_lo + t; active = (kr >= rs_q) && (kr < rs_q + 8); }
        if (active) {
            const LAS unsigned char* kb = lds + (t & 1) * BUF + mp * 128 + l31 * KS + hi * 16;
            f32x16 p0 = f32x16{}, p1 = f32x16{};
#pragma unroll
            for (int d0 = 0; d0 < 4; ++d0) {
                const bf16x8 a0 = *(const LAS bf16x8*)(kb + d0 * 32), a1 = *(const LAS bf16x8*)(kb + 32 * KS + d0 * 32);
                p0 = __builtin_amdgcn_mfma_f32_32x32x16_bf16(a0, qf[d0], p0, 0, 0, 0);
                p1 = __builtin_amdgcn_mfma_f32_32x32x16_bf16(a1, qf[d0], p1, 0, 0, 0);
            }
            if (NA && t < sg.nt1) {
                const LAS float* brow = biasl + (kr - r_q + 7) * 31 + 15 - cq;
#pragma unroll
                for (int r = 0; r < 16; ++r) {
                    const int k0 = crow(r, hi), k1 = k0 + 32;
                    const bool v0 = (k0 >= cs) && (k0 < cs + 16), v1 = (k1 >= cs) && (k1 < cs + 16);
                    const float b0 = brow[v0 ? k0 : cq], b1 = brow[v1 ? k1 : cq];
                    p0[r] = v0 ? p0[r] + b0 : NEG; p1[r] = v1 ? p1[r] + b1 : NEG;
                }
            }
            float tm = fmaxf(p0[0], p1[0]);
#pragma unroll
            for (int r = 1; r < 16; ++r) tm = fmaxf(tm, fmaxf(p0[r], p1[r]));
            tm = fmaxf(tm, __shfl_xor(tm, 32));
            if (__any(tm > mrun + THR)) {
                const float mn = fmaxf(mrun, tm), al = __builtin_amdgcn_exp2f(mrun - mn);
                lsum *= al; mrun = mn;
                if (hi == 0) wsf[l31] = al;
                LDS_WAIT();
#pragma unroll
                for (int r = 0; r < 16; ++r) { const float f = wsf[crow(r, hi)];
#pragma unroll
                    for (int i = 0; i < DVB; ++i) o[i][r] *= f; }
                LDS_WAIT();
            }
            float sacc = 0.f;
#pragma unroll
            for (int r = 0; r < 16; ++r) { p0[r] = __builtin_amdgcn_exp2f(p0[r] - mrun); p1[r] = __builtin_amdgcn_exp2f(p1[r] - mrun); sacc += p0[r] + p1[r]; }
            lsum += sacc;
            bf16x8 pa[2][2];
#pragma unroll
            for (int s = 0; s < 2; ++s) {
                u32x4 w0, w1;
                w0.x = pk2(p0[8 * s + 0], p0[8 * s + 1]); w0.y = pk2(p0[8 * s + 2], p0[8 * s + 3]); w0.z = pk2(p0[8 * s + 4], p0[8 * s + 5]); w0.w = pk2(p0[8 * s + 6], p0[8 * s + 7]);
                w1.x = pk2(p1[8 * s + 0], p1[8 * s + 1]); w1.y = pk2(p1[8 * s + 2], p1[8 * s + 3]); w1.z = pk2(p1[8 * s + 4], p1[8 * s + 5]); w1.w = pk2(p1[8 * s + 6], p1[8 * s + 7]);
                pa[0][s] = __builtin_bit_cast(bf16x8, w0); pa[1][s] = __builtin_bit_cast(bf16x8, w1);
            }
            const LAS char* vb = (const LAS char*)(lds + (t & 1) * BUF + kvoff);
#pragma unroll
            for (int d0 = 0; d0 < DVB; ++d0)
#pragma unroll
                for (int blk = 0; blk < 2; ++blk)
#pragma unroll
                    for (int s = 0; s < 2; ++s) {
                        const s16x4 lo = vtr(vb + (32 * blk + 16 * s) * VS + 64 * d0), hh = vtr(vb + (32 * blk + 16 * s + 8) * VS + 64 * d0);
                        const bf16x8 vf = (bf16x8){lo[0], lo[1], lo[2], lo[3], hh[0], hh[1], hh[2], hh[3]};
                        o[d0] = __builtin_amdgcn_mfma_f32_32x32x16_bf16(pa[blk][s], vf, o[d0], 0, 0, 0);
                    }
        }
        if (more) ATT_STORE((t + 1) & 1);
        __syncthreads();
    }
#undef ATT_LOAD
#undef ATT_STORE
    lsum += __shfl_xor(lsum, 32);
    if (hi == 0) wsf[l31] = 1.f / lsum;
    LDS_WAIT();
    float inv[16];
#pragma unroll
    for (int r = 0; r < 16; ++r) inv[r] = wsf[crow(r, hi)];
    LDS_WAIT();
    if constexpr (!DIFF) {
        LAS bf16_t* stg = (LAS bf16_t*)(lds + OST_OFF) + wid * 2048;
#pragma unroll
        for (int r = 0; r < 16; ++r) { const int q = crow(r, hi);
#pragma unroll
            for (int d0 = 0; d0 < 2; ++d0) { const unsigned w = pk2(o[d0][r] * inv[r], 0.f); stg[q * 64 + d0 * 32 + l31] = (bf16_t)(w & 0xffffu); } }
        LDS_WAIT();
#pragma unroll
        for (int i = 0; i < 4; ++i) { const int row = i * 8 + (lane >> 3), ch = lane & 7; const u32x4 v = *(const LAS u32x4*)(stg + row * 64 + ch * 8); *(u32x4*)(Ow + (size_t)row * D + ch * 8) = v; }
        LDS_WAIT();
        __syncthreads();
    } else {
        constexpr int RS = 132;
        LAS float* ex = (LAS float*)lds + (wid & 3) * 32 * RS;
        if (mp == 1) {
#pragma unroll
            for (int r = 0; r < 16; ++r) { const int q = crow(r, hi); const float f = inv[r] * lam;
#pragma unroll
                for (int d0 = 0; d0 < 4; ++d0) ex[q * RS + d0 * 32 + l31] = o[d0][r] * f; }
        }
        LDS_WAIT();
        __syncthreads();
        if (mp == 0) {
#pragma unroll
            for (int r = 0; r < 16; ++r) { const int q = crow(r, hi);
#pragma unroll
                for (int d0 = 0; d0 < 4; ++d0) { LAS float* p = ex + q * RS + d0 * 32 + l31; *p = o[d0][r] * inv[r] - *p; } }
            LDS_WAIT();
            const LAS float* rp = ex + l31 * RS + hi * 64;
            f32x4 v[16]; float ss = 0.f;
#pragma unroll
            for (int j = 0; j < 16; ++j) { v[j] = *(const LAS f32x4*)(rp + 4 * j); ss += (v[j][0] * v[j][0] + v[j][1] * v[j][1]) + (v[j][2] * v[j][2] + v[j][3] * v[j][3]); }
            ss += __shfl_xor(ss, 32);
            const float rstd = rsqrtf(ss * (1.f / 128.f) + EPS) * post_scale;
            bf16_t* orow = Ow + (size_t)l31 * D + hi * 64;
#pragma unroll
            for (int j = 0; j < 8; ++j) { const f32x4 g0 = *(const f32x4*)(subg + hi * 64 + 8 * j), g1 = *(const f32x4*)(subg + hi * 64 + 8 * j + 4);
                const f32x4 a = v[2 * j] * rstd * g0, b = v[2 * j + 1] * rstd * g1;
                u32x4 w; w.x = pk2(a[0], a[1]); w.y = pk2(a[2], a[3]); w.z = pk2(b[0], b[1]); w.w = pk2(b[2], b[3]);
                *(u32x4*)(orow + 8 * j) = w; }
        }
        LDS_WAIT();
        __syncthreads();
    }
}
}

#define XB_TMO      128
#define XB_XCNT(j)  (256  + 64 * (j))
#define XB_XSUB(j)  (1280 + 64 * (j))
#define XB_XGEN(j)  (2304 + 64 * (j))
#define XB_TOP      3328
#define XB_TOPGEN   3392
#define XCD_BAR_WORDS 3456
#define XB_SPIN_CAP (1u << 18)
__device__ __forceinline__ unsigned xb_ld(unsigned* p)              { return __hip_atomic_load(p, __ATOMIC_RELAXED, __HIP_MEMORY_SCOPE_AGENT); }
__device__ __forceinline__ unsigned xb_add(unsigned* p, unsigned v) { return __hip_atomic_fetch_add(p, v, __ATOMIC_RELAXED, __HIP_MEMORY_SCOPE_AGENT); }
__device__ __forceinline__ unsigned xb_xcc_id() { return (unsigned)__builtin_amdgcn_s_getreg((3 << 11) | 20) & 0xFu; }
#define XB_SPIN(cond, bar) do { unsigned _sp = 0; while (cond) { __builtin_amdgcn_s_sleep(1); \
    if ((++_sp & 255u) == 0u) { if (xb_ld(&(bar)[XB_TMO])) break; if (_sp > XB_SPIN_CAP) { atomicAdd(&(bar)[XB_TMO], 1u); break; } } } } while (0)
struct XcdBarrier { unsigned* bar; unsigned x; volatile LAS unsigned* st; };
__device__ __forceinline__ XcdBarrier xcd_barrier_post(unsigned* bar, volatile LAS unsigned* st) {
    XcdBarrier b; b.bar = bar; b.x = xb_xcc_id(); b.st = st;
    if (threadIdx.x == 0) (void)xb_add(&bar[XB_XCNT(b.x)], 1u);
    return b;
}
__device__ __forceinline__ void xcd_barrier_complete(unsigned* bar, unsigned x, unsigned& nloc, unsigned& nx) {
    const unsigned G = gridDim.x * gridDim.y * gridDim.z;
    unsigned sum, cnt, mine, sp = 0u;
    for (;;) {
        sum = 0u; cnt = 0u; mine = 0u;
#pragma unroll
        for (unsigned j = 0; j < 16; ++j) { const unsigned c = xb_ld(&bar[XB_XCNT(j)]); sum += c; cnt += (c > 0u) ? 1u : 0u; mine = (j == x) ? c : mine; }
        if (sum == G) break;
        __builtin_amdgcn_s_sleep(1);
        if ((++sp & 255u) == 0u) { if (xb_ld(&bar[XB_TMO])) break; if (sp > XB_SPIN_CAP) { atomicAdd(&bar[XB_TMO], 1u); break; } }
    }
    nloc = mine > 0u ? mine : 1u; nx = cnt > 0u ? cnt : 1u;
}
__device__ __forceinline__ void xcd_barrier(const XcdBarrier& b) {
    asm volatile("s_waitcnt vmcnt(0)" ::: "memory");
    __syncthreads();
    if (threadIdx.x == 0) {
        unsigned* bar = b.bar;
        __builtin_amdgcn_s_waitcnt(0);
        unsigned nloc = b.st[0], nx = b.st[1];
        if (nloc == 0u) { xcd_barrier_complete(bar, b.x, nloc, nx); b.st[0] = nloc; b.st[1] = nx; }
        const unsigned old = xb_add(&bar[XB_XSUB(b.x)], 1u);
        const unsigned gen = old / nloc;
        if (old + 1u == (gen + 1u) * nloc) {
            __builtin_amdgcn_fence(__ATOMIC_RELEASE, "agent");
            asm volatile("s_waitcnt vmcnt(0)" ::: "memory");
            const unsigned og = xb_add(&bar[XB_TOP], 1u);
            const unsigned tg = og / nx;
            if (og + 1u == (tg + 1u) * nx) xb_add(&bar[XB_TOPGEN], 1u);
            else XB_SPIN(xb_ld(&bar[XB_TOPGEN]) == tg, bar);
            __builtin_amdgcn_fence(__ATOMIC_ACQUIRE, "agent");
            xb_add(&bar[XB_XGEN(b.x)], 1u);
            asm volatile("s_waitcnt vmcnt(0)" ::: "memory");
        } else {
            XB_SPIN(xb_ld(&bar[XB_XGEN(b.x)]) == gen, bar);
            __builtin_amdgcn_fence(__ATOMIC_ACQUIRE, "agent");
            asm volatile("s_waitcnt vmcnt(0)" ::: "memory");
        }
    }
    __syncthreads();
}

struct Args { const float* in[28]; float* out; unsigned char* ws; int ph_lo, ph_hi; };
typedef const __attribute__((address_space(4))) Args* CArgs;
__device__ __forceinline__ CArgs args_ptr() { unsigned long long p = (unsigned long long)__builtin_amdgcn_kernarg_segment_ptr(); asm volatile("" : "+s"(p)); return (CArgs)p; }

template <bool QKVMAP>
__device__ __forceinline__ void transpose_item(const float* W, int K, int N, bf16_t* WT, int item, int lane) {
    const int nblk = N / 64, kb = item / nblk, nb = item % nblk, k0 = 64 * kb, n = 64 * nb + lane;
    int nr = n;
    if (QKVMAP && n < 2048) { const int c = n & 255; nr = (n - c) + ((c & 63) >> 5) * 128 + (c >> 6) * 32 + (c & 31); }
    const float* src = W + (size_t)k0 * N + n;
    bf16_t* dst = WT + (size_t)nr * K + k0;
#pragma unroll
    for (int half = 0; half < 2; ++half) {
        float v[32];
#pragma unroll
        for (int j = 0; j < 32; ++j) v[j] = src[(size_t)(32 * half + j) * N];
#pragma unroll
        for (int c = 0; c < 4; ++c) { u32x4 w; w.x = pk2(v[8 * c], v[8 * c + 1]); w.y = pk2(v[8 * c + 2], v[8 * c + 3]); w.z = pk2(v[8 * c + 4], v[8 * c + 5]); w.w = pk2(v[8 * c + 6], v[8 * c + 7]);
            *(u32x4*)(dst + 32 * half + 8 * c) = w; }
    }
}

__global__ void __launch_bounds__(512, 2) fwd_kernel(Args args_by_value_unused) {
    extern __shared__ __attribute__((aligned(16))) unsigned char lds_raw[];
    LAS unsigned char* lds = (LAS unsigned char*)lds_raw;
    const int tid = threadIdx.x, lane = tid & 63; const int wave = __builtin_amdgcn_readfirstlane(tid >> 6);
    const int G = gridDim.x; const int bx = blockIdx.x; const int vcu = (G % 8 == 0) ? (bx % 8) * (G / 8) + bx / 8 : bx;
    int lo, hi;
    volatile LAS unsigned* MISC = (volatile LAS unsigned*)(lds + MISC_OFF);
    for (int u = tid; u < (LDS_BYTES - LDSCTL_OFF) / 4; u += 512) ((LAS unsigned*)(lds + LDSCTL_OFF))[u] = 0u;
    __syncthreads();
    XcdBarrier bar;
    { CArgs A = args_ptr(); lo = A->ph_lo; hi = A->ph_hi; unsigned* ctl = (unsigned*)(A->ws + WS_CTL);
      bar.bar = ctl + CW_BAR; bar.x = 0; bar.st = nullptr;
      if (MK_SINGLE) bar = xcd_barrier_post(ctl + CW_BAR, MISC + 8); }
#define IN(k) (lo <= (k) && (k) < hi)
#define SEAM(k) do { if (IN(k) && IN((k) + 1)) { for (int d_ = 0; d_ < DUP_BAR; ++d_) xcd_barrier(bar); } } while (0)
    const int gw = vcu * 8 + wave, NGW = G * 8;

    if (EN_PRO && IN(0)) for (int dup_ = 0; dup_ < DUP_PRO; ++dup_) {
        {
            CArgs A = args_ptr();
            LAS float* sl = (LAS float*)lds;
            LAS f32x4* red = (LAS f32x4*)(lds + 20480);
            const float* c = A->in[6]; const float* cctx = A->in[7]; float* mod = (float*)(A->ws + WS_MOD);
            for (int idx = tid; idx < 5120; idx += 512) { const int n = idx >> 10, k = idx & 1023; const float x = n == 0 ? cctx[k] : c[(n - 1) * 1024 + k]; sl[idx] = x / (1.f + __expf(-x)); }
            __syncthreads();
            for (int wq = bx; wq < 256; wq += G) {
                const int l = wq >> 6, cb = (wq & 63) * 96;
                if (tid < 384) {
                    const int cg = tid % 24, ks = tid / 24;
                    const float* wp = A->in[8] + ((size_t)l * 1024 + ks * 64) * 6144 + cb + 4 * cg;
                    f32x4 a[5];
#pragma unroll
                    for (int n = 0; n < 5; ++n) a[n] = (f32x4){0.f, 0.f, 0.f, 0.f};
#pragma unroll 8
                    for (int k = 0; k < 64; ++k) { const f32x4 w4 = *(const f32x4*)(wp + (size_t)k * 6144);
#pragma unroll
                        for (int n = 0; n < 5; ++n) a[n] += sl[n * 1024 + ks * 64 + k] * w4; }
#pragma unroll
                    for (int n = 0; n < 5; ++n) red[(ks * 24 + cg) * 5 + n] = a[n];
                }
                __syncthreads();
                if (tid < 120) { const int cg = tid / 5, n = tid % 5; f32x4 s = *(const f32x4*)(A->in[9] + l * 6144 + cb + 4 * cg);
                    for (int ks = 0; ks < 16; ++ks) s += red[(ks * 24 + cg) * 5 + n];
                    *(f32x4*)(mod + ((size_t)l * 5 + n) * 6144 + cb + 4 * cg) = s; }
                __syncthreads();
            }
        }
        if (bx == 0) {
            CArgs A = args_ptr(); float* ropet = (float*)(A->ws + WS_ROPE);
            for (int idx = tid; idx < 1024; idx += 512) { const int pos = idx >> 4, j = idx & 15; const float fr = powf(10000.f, -(float)j / 16.f); const float ang = (float)pos * fr; ropet[2 * idx] = cosf(ang); ropet[2 * idx + 1] = sinf(ang); }
        }
        if (bx == 1 % G && wave < 2) {
            CArgs A = args_ptr(); float* lamv = (float*)(A->ws + WS_LAM);
            const int i = wave; const float a1 = A->in[18][i * 64 + lane] * A->in[19][i * 64 + lane], a2 = A->in[20][i * 64 + lane] * A->in[21][i * 64 + lane];
            const float s1 = wave_sum(a1), s2 = wave_sum(a2); const float linit = 0.8f - 0.6f * expf(-0.3f * (float)(2 * i));
            if (lane == 0) lamv[i] = expf(s1) - expf(s2) + linit;
        }
        {
            CArgs A = args_ptr(); bf16_t* cache = (bf16_t*)(A->ws + WS_CACHE);
            for (int ch = gw * 64 + lane; ch < 4 * 2 * 4 * 256 * 128; ch += NGW * 64) {
                const int c8 = ch & 127, t = (ch >> 7) & 255, b = (ch >> 15) & 3, i = (ch >> 17) & 1, kind = ch >> 18;
                const float* src = A->in[2 + kind] + (((size_t)(b * 2 + i) * 256 + t) * 1024);
                f32x4 v0, v1;
                if ((kind & 1) == 0) { const int Gh = c8 >> 3, p8 = c8 & 7, bj = p8 >> 2, fq = p8 & 3; const float* sp = src + 64 * Gh + 32 * bj + 4 * fq; v0 = *(const f32x4*)sp; v1 = *(const f32x4*)(sp + 16); }
                else { v0 = *(const f32x4*)(src + 8 * c8); v1 = *(const f32x4*)(src + 8 * c8 + 4); }
                u32x4 w; w.x = pk2(v0[0], v0[1]); w.y = pk2(v0[2], v0[3]); w.z = pk2(v1[0], v1[1]); w.w = pk2(v1[2], v1[3]);
                *(u32x4*)(cache + (size_t)ch * 8) = w;
            }
        }
        {
            constexpr int I_QKV = 16 * 48, I_O = 16 * 16, I_1 = 16 * 64, I_2 = 64 * 16, I_L = I_QKV + I_O + I_1 + I_2;
            for (int it = gw; it < DEPTH * I_L; it += NGW) {
                CArgs A = args_ptr();
                const int l = it / I_L, i = l >> 1; int r = it % I_L;
                unsigned char* wl = A->ws + WS_W + (size_t)l * W_LAYER;
                if (r < I_QKV) { transpose_item<true>(A->in[(l & 1) ? 23 : 14] + (size_t)i * 1024 * 3072, 1024, 3072, (bf16_t*)(wl + W_QKV), r, lane); continue; } r -= I_QKV;
                if (r < I_O) { transpose_item<false>(A->in[(l & 1) ? 24 : 15] + (size_t)i * 1024 * 1024, 1024, 1024, (bf16_t*)(wl + W_O), r, lane); continue; } r -= I_O;
                if (r < I_1) { transpose_item<false>(A->in[12] + (size_t)l * 1024 * 4096, 1024, 4096, (bf16_t*)(wl + W_1), r, lane); continue; } r -= I_1;
                transpose_item<false>(A->in[13] + (size_t)l * 4096 * 1024, 4096, 1024, (bf16_t*)(wl + W_2), r, lane);
            }
        }
    }
    SEAM(0);

    for (int l = 0; l < DEPTH; ++l) {
        const int pb = 1 + 7 * l, i = l >> 1; const bool diff = (l & 1) == 0;
#define NORM_PHASE(FIRST, GIDX, SHC) do { CArgs A = args_ptr(); int ptid = threadIdx.x; asm volatile("" : "+v"(ptid)); const int lane = ptid & 63; const int gw = vcu * 8 + __builtin_amdgcn_readfirstlane(ptid >> 6); \
            const float* rp_ = (FIRST) ? A->in[0] : A->out + OUT_Y; const float* rs_ = (FIRST) ? A->in[1] : A->out + OUT_Y + (size_t)MP * D; \
            const float* gam_ = A->in[GIDX] + l * 1024; const float* modl_ = (const float*)(A->ws + WS_MOD) + (size_t)l * 5 * 6144; bf16_t* XN_ = (bf16_t*)(A->ws + WS_XN); \
            for (int row = gw; row < M; row += NGW) { \
                const float* xr = row < MP ? rp_ + (size_t)row * D : rs_ + (size_t)(row - MP) * D; \
                const float* mrow = modl_ + (row < MP ? 0 : 1 + ((row - MP) >> 10)) * 6144 + (SHC) * 1024; \
                f32x4 v[4]; float ss = 0.f; \
                _Pragma("unroll") for (int j = 0; j < 4; ++j) { v[j] = *(const f32x4*)(xr + 4 * lane + 256 * j); ss += (v[j][0] * v[j][0] + v[j][1] * v[j][1]) + (v[j][2] * v[j][2] + v[j][3] * v[j][3]); } \
                const float rstd = rsqrtf(wave_sum(ss) * (1.f / D) + EPS); \
                _Pragma("unroll") for (int j = 0; j < 4; ++j) { const int c = 4 * lane + 256 * j; const f32x4 g = *(const f32x4*)(gam_ + c), sh = *(const f32x4*)(mrow + c), sc = *(const f32x4*)(mrow + 1024 + c); \
                    const f32x4 h = v[j] * rstd * g * (1.f + sc) + sh; u32x2 w; w.x = pk2(h[0], h[1]); w.y = pk2(h[2], h[3]); *(u32x2*)(XN_ + (size_t)row * D + c) = w; } \
            } } while (0)
        if (EN_NORM && IN(pb + 0)) for (int dup_ = 0; dup_ < DUP_NORM; ++dup_) NORM_PHASE(l == 0, 10, 0);
        SEAM(pb + 0);
        if (EN_QKV && IN(pb + 1)) for (int dup_ = 0; dup_ < DUP_QKV; ++dup_) {
            {
                CArgs A = args_ptr(); unsigned char* ws = A->ws; int ptid = threadIdx.x; asm volatile("" : "+v"(ptid)); const bf16_t* wq = (const bf16_t*)(ws + WS_W + (size_t)l * W_LAYER + W_QKV);
                pg8::Gemm g{(const bf16_t*)(ws + WS_XN), wq, 1024}; pg8::StaticOrder S; S.init(32, 8, G, bx);
                pg8::EpiQK E{(bf16_t*)(ws + WS_Q), (bf16_t*)(ws + WS_K), A->in[diff ? 16 : 25] + i * 64, A->in[diff ? 17 : 26] + i * 64, diff ? (const float*)(ws + WS_ROPE) : nullptr,
                             A->out + (diff ? OUT_DK : OUT_NK) + (size_t)i * 256 * 1024};
                pg8::gemm_phase<pg8::EpiQK, 2, true>(lds, g, S, E, ptid);
            }
            {
                CArgs A = args_ptr(); unsigned char* ws = A->ws; int ptid = threadIdx.x; asm volatile("" : "+v"(ptid)); const bf16_t* wq = (const bf16_t*)(ws + WS_W + (size_t)l * W_LAYER + W_QKV);
                pg8::Gemm g{(const bf16_t*)(ws + WS_XN), wq + (size_t)2048 * 1024, 1024}; pg8::StaticOrder S; S.init(32, 8, G, bx);
                pg8::EpiV E{(bf16_t*)(ws + WS_V), A->out + (diff ? OUT_DV : OUT_NV) + (size_t)i * 256 * 1024};
                pg8::gemm_phase_n1<pg8::EpiV, true>(lds, g, S, E, ptid);
            }
        }
        SEAM(pb + 1);
        if (EN_ATT && IN(pb + 2)) {
            for (int v = vcu; v < 256; v += G) {
                if (diff) {
                    const float linit = 0.8f - 0.6f * expf(-0.3f * (float)l);
                    for (int dup_ = 0; dup_ < DUP_ADP; ++dup_) {
                        CArgs A = args_ptr(); unsigned char* ws = A->ws; int ptid = threadIdx.x; asm volatile("" : "+v"(ptid)); const bf16_t* Qb = (const bf16_t*)(ws + WS_Q); const bf16_t* Kb = (const bf16_t*)(ws + WS_K); const bf16_t* Vb = (const bf16_t*)(ws + WS_V); bf16_t* Ob = (bf16_t*)(ws + WS_O);
                        const float lam = ((const float*)(ws + WS_LAM))[i]; const float* subg = A->in[22] + i * 128;
                        const int pw = __builtin_amdgcn_readfirstlane(ptid >> 6), rg = pw & 3, mp = pw >> 2; const int b = v >> 4, h = (v >> 1) & 7, qb = v & 1; const int q0 = b * 256 + qb * 128 + rg * 32;
                        att::Seg sg{Kb + (size_t)(b * 256) * D + h * 128, Vb + (size_t)(b * 256) * D + h * 128, 4, nullptr, nullptr, 0};
                        att::attn_unit<true, false>(ptid, lds, Qb + (size_t)q0 * D + h * 128 + mp * 64, sg, Ob + (size_t)q0 * D + h * 128, 0, 0, 0, nullptr, lam, 1.f - linit, subg);
                    }
                    for (int dup_ = 0; dup_ < DUP_ADL; ++dup_) {
                        CArgs A = args_ptr(); unsigned char* ws = A->ws; int ptid = threadIdx.x; asm volatile("" : "+v"(ptid)); const bf16_t* Qb = (const bf16_t*)(ws + WS_Q); const bf16_t* Kb = (const bf16_t*)(ws + WS_K); const bf16_t* Vb = (const bf16_t*)(ws + WS_V); bf16_t* Ob = (bf16_t*)(ws + WS_O);
                        const bf16_t* cache = (const bf16_t*)(ws + WS_CACHE);
                        const float lam = ((const float*)(ws + WS_LAM))[i]; const float* subg = A->in[22] + i * 128;
                        const int pw = __builtin_amdgcn_readfirstlane(ptid >> 6), rg = pw & 3, mp = pw >> 2; const int b = v >> 6, h = (v >> 3) & 7, qb = v & 7; const int q0 = MP + b * 1024 + qb * 128 + rg * 32;
                        const bf16_t* ck = cache + ((size_t)(0 * 2 + i) * 4 + b) * 256 * 1024 + h * 128; const bf16_t* cv = cache + ((size_t)(1 * 2 + i) * 4 + b) * 256 * 1024 + h * 128;
                        att::Seg sg{Kb + (size_t)(MP + b * 1024) * D + h * 128, Vb + (size_t)(MP + b * 1024) * D + h * 128, 16, ck, cv, 4};
                        att::attn_unit<true, false>(ptid, lds, Qb + (size_t)q0 * D + h * 128 + mp * 64, sg, Ob + (size_t)q0 * D + h * 128, 0, 0, 0, nullptr, lam, 1.f - linit, subg);
                    }
                } else {
                    for (int dup_ = 0; dup_ < DUP_ANP; ++dup_) {
                        CArgs A = args_ptr(); unsigned char* ws = A->ws; int ptid = threadIdx.x; asm volatile("" : "+v"(ptid)); const bf16_t* Qb = (const bf16_t*)(ws + WS_Q); const bf16_t* Kb = (const bf16_t*)(ws + WS_K); const bf16_t* Vb = (const bf16_t*)(ws + WS_V); bf16_t* Ob = (bf16_t*)(ws + WS_O);
                        const int pw = __builtin_amdgcn_readfirstlane(ptid >> 6); const int b = v >> 4, h = v & 15; const int q0 = b * 256 + pw * 32;
                        att::Seg sg{Kb + (size_t)(b * 256) * D + h * 64, Vb + (size_t)(b * 256) * D + h * 64, 4, nullptr, nullptr, 0};
                        att::attn_unit<false, false>(ptid, lds, Qb + (size_t)q0 * D + h * 64, sg, Ob + (size_t)q0 * D + h * 64, 0, 0, 0, nullptr, 0.f, 0.f, nullptr);
                    }
                    for (int dup_ = 0; dup_ < DUP_ANL; ++dup_) {
                        CArgs A = args_ptr(); unsigned char* ws = A->ws; int ptid = threadIdx.x; asm volatile("" : "+v"(ptid)); const bf16_t* Qb = (const bf16_t*)(ws + WS_Q); const bf16_t* Kb = (const bf16_t*)(ws + WS_K); const bf16_t* Vb = (const bf16_t*)(ws + WS_V); bf16_t* Ob = (bf16_t*)(ws + WS_O);
                        const bf16_t* cache = (const bf16_t*)(ws + WS_CACHE);
                        const int b = v >> 6, h = (v >> 2) & 15, R = v & 3; const int pw = __builtin_amdgcn_readfirstlane(ptid >> 6); const int r_q = 4 * R + (pw >> 1), jj = pw & 1; const int q0 = MP + b * 1024 + r_q * 64 + jj * 32;
                        const int kr_lo = min(max(4 * R - 4, 0), 8), kr_hi = min(max(4 * R + 3 - 4, 0), 8) + 8;
                        const bf16_t* ck = cache + ((size_t)(2 * 2 + i) * 4 + b) * 256 * 1024 + h * 64; const bf16_t* cv = cache + ((size_t)(3 * 2 + i) * 4 + b) * 256 * 1024 + h * 64;
                        att::Seg sg{Kb + (size_t)(MP + b * 1024 + kr_lo * 64) * D + h * 64, Vb + (size_t)(MP + b * 1024 + kr_lo * 64) * D + h * 64, kr_hi - kr_lo, ck, cv, 4};
                        att::attn_unit<false, true>(ptid, lds, Qb + (size_t)q0 * D + h * 64, sg, Ob + (size_t)q0 * D + h * 64, kr_lo, r_q, jj, A->in[27] + ((size_t)i * 16 + h) * 465, 0.f, 0.f, nullptr);
                    }
                }
            }
        }
        SEAM(pb + 2);
        if (EN_O && IN(pb + 3)) for (int dup_ = 0; dup_ < DUP_O; ++dup_) {
            CArgs A = args_ptr(); unsigned char* ws = A->ws; int ptid = threadIdx.x; asm volatile("" : "+v"(ptid)); float* out = A->out; float* outw = dup_ + 1 < DUP_O ? (float*)(ws + WS_Q) : out + OUT_Y;
            pg8::Gemm g{(const bf16_t*)(ws + WS_O), (const bf16_t*)(ws + WS_W + (size_t)l * W_LAYER + W_O), 1024}; pg8::StaticOrder S; S.init(32, 8, G, bx);
            pg8::EpiResid E{l == 0 ? A->in[0] : out + OUT_Y, l == 0 ? A->in[1] : out + OUT_Y + (size_t)MP * D, outw, (const float*)(ws + WS_MOD) + (size_t)l * 5 * 6144 + 2 * 1024};
            pg8::gemm_phase_n1<pg8::EpiResid, true>(lds, g, S, E, ptid);
        }
        SEAM(pb + 3);
        if (EN_NORM && IN(pb + 4)) for (int dup_ = 0; dup_ < DUP_NORM; ++dup_) NORM_PHASE(false, 11, 3);
        SEAM(pb + 4);
        if (EN_FC1 && IN(pb + 5)) for (int dup_ = 0; dup_ < DUP_FC1; ++dup_) {
            CArgs A = args_ptr(); unsigned char* ws = A->ws; int ptid = threadIdx.x; asm volatile("" : "+v"(ptid));
            pg8::Gemm g{(const bf16_t*)(ws + WS_XN), (const bf16_t*)(ws + WS_W + (size_t)l * W_LAYER + W_1), 1024}; pg8::StaticOrder S; S.init(32, 16, G, bx);
            pg8::EpiRelu2 E{(bf16_t*)(ws + WS_H)};
            pg8::gemm_phase<pg8::EpiRelu2, 2, true>(lds, g, S, E, ptid);
        }
        SEAM(pb + 5);
        if (EN_FC2 && IN(pb + 6)) for (int dup_ = 0; dup_ < DUP_FC2; ++dup_) {
            CArgs A = args_ptr(); unsigned char* ws = A->ws; int ptid = threadIdx.x; asm volatile("" : "+v"(ptid)); float* out = A->out; float* outw = dup_ + 1 < DUP_FC2 ? (float*)(ws + WS_Q) : out + OUT_Y;
            pg8::Gemm g{(const bf16_t*)(ws + WS_H), (const bf16_t*)(ws + WS_W + (size_t)l * W_LAYER + W_2), 4096}; pg8::StaticOrder S; S.init(32, 8, G, bx);
            pg8::EpiResid E{out + OUT_Y, out + OUT_Y + (size_t)MP * D, outw, (const float*)(ws + WS_MOD) + (size_t)l * 5 * 6144 + 5 * 1024};
            pg8::gemm_phase_n1<pg8::EpiResid, true>(lds, g, S, E, ptid);
        }
        SEAM(pb + 6);
    }
#undef IN
#undef SEAM
#undef NORM_PHASE
}

extern "C" void kernel_launch(void* const* d_in, const int* in_sizes, int n_in, void* d_out, int out_size, void* d_ws, size_t ws_size, hipStream_t stream) {
    static int grid = 0;
    if (grid == 0) {
        if (n_in != 28 || out_size != 41943040 || ws_size < WS_END) { fprintf(stderr, "kernel_launch: unexpected shapes (n_in %d, out %d, ws %zu); nothing launched\n", n_in, out_size, ws_size); grid = -1; return; }
        int dev = 0, cus = 0;
        if (hipGetDevice(&dev) != hipSuccess || hipDeviceGetAttribute(&cus, hipDeviceAttributeMultiprocessorCount, dev) != hipSuccess) { grid = -1; return; }
        if (hipFuncSetAttribute((const void*)fwd_kernel, hipFuncAttributeMaxDynamicSharedMemorySize, LDS_BYTES) != hipSuccess) { fprintf(stderr, "kernel_launch: hipFuncSetAttribute failed\n"); grid = -1; return; }
        int per_cu = 0;
        if (hipOccupancyMaxActiveBlocksPerMultiprocessor(&per_cu, (const void*)fwd_kernel, 512, LDS_BYTES) != hipSuccess || per_cu < 1) fprintf(stderr, "kernel_launch: occupancy query reports %d\n", per_cu);
        (void)hipGetLastError();
        grid = cus;
    }
    if (grid < 0) return;
    (void)hipMemsetAsync((char*)d_ws + WS_CTL, 0, CTL_ZERO_BYTES, stream);
    Args a{};
    for (int i = 0; i < 28; ++i) a.in[i] = (const float*)d_in[i];
    a.out = (float*)d_out; a.ws = (unsigned char*)d_ws;
    constexpr int NPH = 1 + 7 * DEPTH;
#if MK_SINGLE
    a.ph_lo = 0; a.ph_hi = NPH;
    hipLaunchKernelGGL(fwd_kernel, dim3(grid), dim3(512), LDS_BYTES, stream, a);
#else
    for (int p = 0; p < NPH; ++p) { a.ph_lo = p; a.ph_hi = p + 1; hipLaunchKernelGGL(fwd_kernel, dim3(grid), dim3(512), LDS_BYTES, stream, a); }
#endif
}
```

```cpp
#include <hip/hip_runtime.h>
#include <cstdio>
#include <cstdint>

#ifndef MK_SINGLE
#define MK_SINGLE 1
#endif

#ifndef DUP_PRO
#define DUP_PRO 1
#endif
#ifndef DUP_NORM
#define DUP_NORM 1
#endif
#ifndef DUP_QKV
#define DUP_QKV 1
#endif
#ifndef DUP_ADP
#define DUP_ADP 1
#endif
#ifndef DUP_ADL
#define DUP_ADL 1
#endif
#ifndef DUP_ANP
#define DUP_ANP 1
#endif
#ifndef DUP_ANL
#define DUP_ANL 1
#endif
#ifndef DUP_FC1
#define DUP_FC1 1
#endif
#ifndef DUP_O
#define DUP_O 1
#endif
#ifndef DUP_FC2
#define DUP_FC2 1
#endif
#ifndef DUP_BAR
#define DUP_BAR 1
#endif
#ifndef EN_PRO
#define EN_PRO 1
#endif
#ifndef EN_NORM
#define EN_NORM 1
#endif
#ifndef EN_QKV
#define EN_QKV 1
#endif
#ifndef EN_ATT
#define EN_ATT 1
#endif
#ifndef EN_O
#define EN_O 1
#endif
#ifndef EN_FC1
#define EN_FC1 1
#endif
#ifndef EN_FC2
#define EN_FC2 1
#endif
#define LAS __attribute__((address_space(3)))
#define GAS __attribute__((address_space(1)))
typedef unsigned short bf16_t;
typedef short bf16x8 __attribute__((ext_vector_type(8)));
typedef short s16x4 __attribute__((ext_vector_type(4)));
typedef float f32x4 __attribute__((ext_vector_type(4)));
typedef float f32x2 __attribute__((ext_vector_type(2)));
typedef float f32x16 __attribute__((ext_vector_type(16)));
typedef unsigned u32x4 __attribute__((ext_vector_type(4)));
typedef unsigned u32x2 __attribute__((ext_vector_type(2)));
typedef __bf16 bf16x2_t __attribute__((ext_vector_type(2)));

constexpr int D = 1024, FF = 4096, DEPTH = 4;
constexpr int MP = 4096, M = 8192;
constexpr float EPS = 1e-6f;
constexpr float LOG2E = 1.4426950408889634f;
constexpr float C2 = 0.125f * LOG2E;
constexpr size_t OUT_Y = 0, OUT_DK = 8388608, OUT_DV = 16777216, OUT_NK = 25165824, OUT_NV = 33554432;

constexpr size_t MiB = 1u << 20;
constexpr size_t WS_CTL = 0, CTL_ZERO_BYTES = 64 * 1024;
constexpr size_t WS_MOD = 1 * MiB;
constexpr size_t WS_ROPE = WS_MOD + 512 * 1024;
constexpr size_t WS_LAM = WS_ROPE + 16 * 1024;
constexpr size_t WS_W = 2 * MiB;
constexpr size_t W_LAYER = 24 * MiB, W_QKV = 0, W_O = 6 * MiB, W_1 = 8 * MiB, W_2 = 16 * MiB;
constexpr size_t WS_CACHE = 98 * MiB;
constexpr size_t WS_XN = 114 * MiB, WS_Q = 130 * MiB, WS_K = 146 * MiB, WS_V = 162 * MiB, WS_O = 178 * MiB, WS_H = 194 * MiB, WS_SSQ = 258 * MiB  , WS_SW = 259 * MiB  , WS_END = 260 * MiB;
constexpr int CW_BAR = 1024;

constexpr int RING_BYTES = 147456;
constexpr int LDSCTL_OFF = RING_BYTES, MISC_OFF = LDSCTL_OFF + 320;
constexpr int LDS_BYTES = 148480;

__device__ __forceinline__ unsigned pk2(float lo, float hi) { f32x2 v = {lo, hi}; bf16x2_t b = __builtin_convertvector(v, bf16x2_t); return __builtin_bit_cast(unsigned, b); }
__device__ __forceinline__ float wave_sum(float v) {
#pragma unroll
    for (int o = 1; o < 64; o <<= 1) v += __shfl_xor(v, o);
    return v;
}
#define LDS_WAIT() asm volatile("s_waitcnt lgkmcnt(0)" ::: "memory")
#define VM_WAIT() asm volatile("s_waitcnt vmcnt(0)" ::: "memory")

namespace pg8 {
constexpr int BM = 256, BK = 64, HALF = 128, HTB = HALF * BK * 2, NXCD = 8, WGM = 8;
__host__ __device__ __forceinline__ int lds_byte(int r, int c) { const int st = (r >> 4) * 2 + (c >> 5), rr = r & 15, cc = c & 31, ob = rr * 64 + cc * 2; return st * 1024 + (ob ^ (((ob >> 9) & 1) << 5)); }
__host__ __device__ __forceinline__ void stage_rc(int b, int& R, int& C) { const int st = b / 1024, sb = b % 1024, swz = sb ^ (((sb >> 9) & 1) << 5); R = (st >> 1) * 16 + swz / 64; C = (st & 1) * 32 + (swz % 64) / 2; }
__host__ __device__ __forceinline__ int perm32(int rho) { const int n = rho >> 4, i = rho & 15; return 8 * (i >> 2) + 4 * n + (i & 3); }

struct Unit { int pm, pn; };
struct Gemm { const bf16_t* A; const bf16_t* Bt; int K; };

struct StaticOrder {
    int nM, nN, nwg, G, c;
    __device__ void init(int nM_, int nN_, int G_, int c_) { nM = nM_; nN = nN_; nwg = nM * nN; G = G_; c = c_; }
    __device__ bool next(int i, Unit& u) const {
        const long L = (long)i * G + c; if (L >= nwg) return false;
        int wgid = (int)L; { const int q = nwg / NXCD, r = nwg % NXCD, xcd = wgid % NXCD, off = wgid / NXCD; wgid = (xcd < r ? xcd * (q + 1) : r * (q + 1) + (xcd - r) * q) + off; }
        const int nig = WGM * nN, gid = wgid / nig, fm = gid * WGM, gsz = (nM - fm) < WGM ? (nM - fm) : WGM;
        u.pm = fm + ((wgid % nig) % gsz); u.pn = (wgid % nig) / gsz; return true;
    }
};

template <class Epi, int NB, bool ALIGN_EPI>
__device__ __forceinline__ void gemm_phase(LAS unsigned char* lds, const Gemm g, const StaticOrder& S, const Epi& E, const int tid) {
    const int wid = __builtin_amdgcn_readfirstlane(tid >> 6), lane = tid & 63, wr = wid >> 2, wc = wid & 3, fr = lane & 15, fq = lane >> 4;
    const int K = g.K, nt = K / BK;
    unsigned voffA[2], voffB[2];
#pragma unroll
    for (int i = 0; i < 2; ++i) { int R, C; stage_rc(tid * 16 + i * 8192, R, C); const int Rb = Epi::PERM ? ((R & ~31) + perm32(R & 31)) : R;
        voffA[i] = (unsigned)(R * K + C) * 2u; voffB[i] = (unsigned)(Rb * K + C) * 2u; }
    const size_t kstep = (size_t)(BK * 2);
    const size_t hstep = (size_t)HALF * K * 2;
    const size_t tstepA = 2 * hstep, tstepB = NB * hstep;
    const unsigned ldsw = (unsigned)wid * 1024u;
    const int aoff = lds_byte(wr * 64 + fr, fq * 8), boff = lds_byte(wc * 32 + fr, fq * 8);
#define PG8_SA(b, h) (((b) * 2 + (h)) * HTB)
#define PG8_SB(b, h) ((4 + (b) * 2 + (h)) * HTB)
#define PG8_STAGE(bufoff, gbase, voff) do { _Pragma("unroll") for (int _i = 0; _i < 2; ++_i) \
        __builtin_amdgcn_global_load_lds((const unsigned*)((const char*)(gbase) + (voff)[_i]), (LAS unsigned*)(lds + (bufoff) + ldsw + _i * 8192), 16, 0, 0); } while (0)
#define PG8_LDA(dst, b, h) do { _Pragma("unroll") for (int m = 0; m < 4; ++m) _Pragma("unroll") for (int k = 0; k < 2; ++k) dst[m][k] = *(const LAS bf16x8*)(lds + PG8_SA(b, h) + aoff + m * 2048 + k * 1024); } while (0)
#define PG8_LDB(dst, b, h) do { _Pragma("unroll") for (int n = 0; n < 2; ++n) _Pragma("unroll") for (int k = 0; k < 2; ++k) dst[n][k] = *(const LAS bf16x8*)(lds + PG8_SB(b, h) + boff + n * 2048 + k * 1024); } while (0)
#define PG8_MMA(ai, bj, At, Bt) do { __builtin_amdgcn_s_setprio(1); _Pragma("unroll") for (int m = 0; m < 4; ++m) _Pragma("unroll") for (int n = 0; n < 2; ++n) _Pragma("unroll") for (int k = 0; k < 2; ++k) \
        acc[ai][bj][m][n] = __builtin_amdgcn_mfma_f32_16x16x32_bf16(Bt[n][k], At[m][k], acc[ai][bj][m][n], 0, 0, 0); __builtin_amdgcn_s_setprio(0); } while (0)
#define PG8_WAIT_V(n) asm volatile("s_waitcnt vmcnt(" #n ")" ::: "memory")
#define PG8_WAIT_L(n) asm volatile("s_waitcnt lgkmcnt(" #n ")" ::: "memory")
#define PG8_BAR __builtin_amdgcn_s_barrier()
#define PG8_SCHED __builtin_amdgcn_sched_barrier(0)
    Unit cur, nxt; int ui = 0;
    if (!S.next(0, cur)) return;
    f32x4 acc[2][NB][4][2];
#pragma unroll
    for (int a = 0; a < 2; ++a)
#pragma unroll
        for (int b = 0; b < NB; ++b)
#pragma unroll
            for (int m = 0; m < 4; ++m)
#pragma unroll
                for (int n = 0; n < 2; ++n) acc[a][b][m][n] = (f32x4){0.f, 0.f, 0.f, 0.f};
    bf16x8 At[4][2], B0[2][2], B1[2][2];
    const char* cA = (const char*)g.A + (size_t)cur.pm * tstepA; const char* cB = (const char*)g.Bt + (size_t)cur.pn * tstepB;
    if constexpr (NB == 2) {
        PG8_STAGE(PG8_SB(0, 0), cB, voffB); PG8_STAGE(PG8_SB(0, 1), cB + hstep, voffB); PG8_STAGE(PG8_SA(0, 0), cA, voffA); PG8_STAGE(PG8_SA(0, 1), cA + hstep, voffA);
        if (wr == 1) PG8_BAR;
        PG8_WAIT_V(2); PG8_BAR;
        PG8_STAGE(PG8_SB(1, 0), cB + kstep, voffB); PG8_STAGE(PG8_SA(1, 0), cA + kstep, voffA); PG8_STAGE(PG8_SB(1, 1), cB + hstep + kstep, voffB);
        PG8_WAIT_V(6); PG8_BAR;
    } else {
        PG8_STAGE(PG8_SB(0, 0), cB, voffB); PG8_STAGE(PG8_SA(0, 0), cA, voffA); PG8_STAGE(PG8_SA(0, 1), cA + hstep, voffA);
        if (wr == 1) PG8_BAR;
        PG8_WAIT_V(2); PG8_BAR;
        PG8_STAGE(PG8_SB(1, 0), cB + kstep, voffB); PG8_STAGE(PG8_SA(1, 0), cA + kstep, voffA);
        PG8_WAIT_V(4); PG8_BAR;
    }
    for (;;) {
        const bool has_next = S.next(ui + 1, nxt);
        const char* nA = has_next ? (const char*)g.A + (size_t)nxt.pm * tstepA : cA; const char* nB = has_next ? (const char*)g.Bt + (size_t)nxt.pn * tstepB : cB;
        for (int t = 0; t < nt; t += 2) {
            const bool last = (t == nt - 2);
            const char* a1 = cA + (size_t)(t + 1) * kstep;
            const char* a2 = last ? nA : cA + (size_t)(t + 2) * kstep; const char* b2 = last ? nB : cB + (size_t)(t + 2) * kstep;
            const char* a3 = a2 + kstep; const char* b3 = b2 + kstep;
            if constexpr (NB == 2) {
            PG8_LDB(B0, 0, 0); PG8_LDB(B1, 0, 1); PG8_SCHED; PG8_LDA(At, 0, 0); PG8_STAGE(PG8_SA(1, 1), a1 + hstep, voffA);
            PG8_WAIT_V(8); PG8_WAIT_L(0); PG8_BAR; PG8_MMA(0, 0, At, B0); PG8_MMA(0, 1, At, B1); PG8_BAR; PG8_SCHED;
            PG8_LDA(At, 0, 1); PG8_STAGE(PG8_SB(0, 0), b2, voffB); PG8_STAGE(PG8_SB(0, 1), b2 + hstep, voffB); PG8_STAGE(PG8_SA(0, 0), a2, voffA);
            PG8_WAIT_V(8); PG8_WAIT_L(0); PG8_BAR; PG8_MMA(1, 0, At, B0); PG8_MMA(1, 1, At, B1); PG8_BAR; PG8_SCHED;
            PG8_LDB(B0, 1, 0); PG8_LDB(B1, 1, 1); PG8_SCHED; PG8_LDA(At, 1, 0); PG8_STAGE(PG8_SA(0, 1), a2 + hstep, voffA);
            PG8_WAIT_V(8); PG8_WAIT_L(0); PG8_BAR; PG8_MMA(0, 0, At, B0); PG8_MMA(0, 1, At, B1); PG8_BAR; PG8_SCHED;
            PG8_LDA(At, 1, 1); PG8_STAGE(PG8_SB(1, 0), b3, voffB); PG8_STAGE(PG8_SB(1, 1), b3 + hstep, voffB); PG8_STAGE(PG8_SA(1, 0), a3, voffA);
            PG8_WAIT_V(8); PG8_WAIT_L(0); PG8_BAR; PG8_MMA(1, 0, At, B0); PG8_MMA(1, 1, At, B1); PG8_BAR; PG8_SCHED;
            } else {
            PG8_LDB(B0, 0, 0); PG8_SCHED; PG8_LDA(At, 0, 0); PG8_STAGE(PG8_SA(1, 1), a1 + hstep, voffA);
            PG8_WAIT_V(6); PG8_WAIT_L(0); PG8_BAR; PG8_MMA(0, 0, At, B0); PG8_BAR; PG8_SCHED;
            PG8_LDA(At, 0, 1); PG8_STAGE(PG8_SB(0, 0), b2, voffB); PG8_STAGE(PG8_SA(0, 0), a2, voffA);
            PG8_WAIT_V(6); PG8_WAIT_L(0); PG8_BAR; PG8_MMA(1, 0, At, B0); PG8_BAR; PG8_SCHED;
            PG8_LDB(B0, 1, 0); PG8_SCHED; PG8_LDA(At, 1, 0); PG8_STAGE(PG8_SA(0, 1), a2 + hstep, voffA);
            PG8_WAIT_V(6); PG8_WAIT_L(0); PG8_BAR; PG8_MMA(0, 0, At, B0); PG8_BAR; PG8_SCHED;
            PG8_LDA(At, 1, 1); PG8_STAGE(PG8_SB(1, 0), b3, voffB); PG8_STAGE(PG8_SA(1, 0), a3, voffA);
            PG8_WAIT_V(6); PG8_WAIT_L(0); PG8_BAR; PG8_MMA(1, 0, At, B0); PG8_BAR; PG8_SCHED;
            }
        }
        if constexpr (ALIGN_EPI) { if (wr == 0) PG8_BAR; }
        E(acc, cur, wr, wc, fr, fq);
        if (!has_next) break;
#pragma unroll
        for (int a = 0; a < 2; ++a)
#pragma unroll
            for (int b = 0; b < NB; ++b)
#pragma unroll
                for (int m = 0; m < 4; ++m)
#pragma unroll
                    for (int n = 0; n < 2; ++n) acc[a][b][m][n] = (f32x4){0.f, 0.f, 0.f, 0.f};
        cur = nxt; cA = nA; cB = nB; ++ui;
        if constexpr (ALIGN_EPI) { if (wr == 1) PG8_BAR; }
    }
    PG8_WAIT_V(0);
    if constexpr (!ALIGN_EPI) { if (wr == 0) PG8_BAR; }
    PG8_BAR;
#undef PG8_SA
#undef PG8_SB
#undef PG8_STAGE
#undef PG8_LDA
#undef PG8_LDB
#undef PG8_MMA
#undef PG8_WAIT_V
#undef PG8_WAIT_L
#undef PG8_BAR
#undef PG8_SCHED
}

template <class Epi, bool ALIGN_EPI>
__device__ __forceinline__ void gemm_phase_n1(LAS unsigned char* lds, const Gemm g, const StaticOrder& S, const Epi& E, const int tid) {
    const int wid = __builtin_amdgcn_readfirstlane(tid >> 6), lane = tid & 63, wr = wid >> 2, wc = wid & 3, fr = lane & 15, fq = lane >> 4;
    const int K = g.K, nt = K / BK;
    unsigned voffA[2], voffB[2];
#pragma unroll
    for (int i = 0; i < 2; ++i) { int R, C; stage_rc(tid * 16 + i * 8192, R, C); const int Rb = Epi::PERM ? ((R & ~31) + perm32(R & 31)) : R;
        voffA[i] = (unsigned)(R * K + C) * 2u; voffB[i] = (unsigned)(Rb * K + C) * 2u; }
    const size_t kstep = (size_t)(BK * 2);
    const size_t hstep = (size_t)HALF * K * 2;
    const size_t tstepA = 2 * hstep, tstepB = hstep;
    const unsigned ldsw = (unsigned)wid * 1024u;
    const int aoff = lds_byte(wr * 64 + fr, fq * 8), boff = lds_byte(wc * 32 + fr, fq * 8);
    constexpr int BUF3 = 3 * HTB;
#define N1_STAGE1(bufoff, gbase, voff) do { _Pragma("unroll") for (int _i = 0; _i < 2; ++_i) \
        __builtin_amdgcn_global_load_lds((const unsigned*)((const char*)(gbase) + (voff)[_i]), (LAS unsigned*)(lds + (bufoff) + ldsw + _i * 8192), 16, 0, 0); } while (0)
#define N1_STAGE3(c, pa, pb) do { N1_STAGE1((c) * BUF3, pb, voffB); N1_STAGE1((c) * BUF3 + HTB, pa, voffA); N1_STAGE1((c) * BUF3 + 2 * HTB, (pa) + hstep, voffA); } while (0)
#define N1_LDA(dst, c, h) do { _Pragma("unroll") for (int m = 0; m < 4; ++m) _Pragma("unroll") for (int k = 0; k < 2; ++k) dst[m][k] = *(const LAS bf16x8*)(lds + (c) * BUF3 + (1 + (h)) * HTB + aoff + m * 2048 + k * 1024); } while (0)
#define N1_LDB(dst, c) do { _Pragma("unroll") for (int n = 0; n < 2; ++n) _Pragma("unroll") for (int k = 0; k < 2; ++k) dst[n][k] = *(const LAS bf16x8*)(lds + (c) * BUF3 + boff + n * 2048 + k * 1024); } while (0)
#define N1_MMA(ai, At, Bt) do { _Pragma("unroll") for (int m = 0; m < 4; ++m) _Pragma("unroll") for (int n = 0; n < 2; ++n) _Pragma("unroll") for (int k = 0; k < 2; ++k) \
        acc[ai][0][m][n] = __builtin_amdgcn_mfma_f32_16x16x32_bf16(Bt[n][k], At[m][k], acc[ai][0][m][n], 0, 0, 0); } while (0)
#define N1_WAIT_V(n) asm volatile("s_waitcnt vmcnt(" #n ")" ::: "memory")
#define N1_WAIT_L(n) asm volatile("s_waitcnt lgkmcnt(" #n ")" ::: "memory")
#define N1_BAR __builtin_amdgcn_s_barrier()
#define N1_SCHED __builtin_amdgcn_sched_barrier(0)
    Unit cur, nxt; int ui = 0;
    if (!S.next(0, cur)) return;
    f32x4 acc[2][1][4][2];
#pragma unroll
    for (int a = 0; a < 2; ++a)
#pragma unroll
        for (int m = 0; m < 4; ++m)
#pragma unroll
            for (int n = 0; n < 2; ++n) acc[a][0][m][n] = (f32x4){0.f, 0.f, 0.f, 0.f};
    bf16x8 At0[4][2], At1[4][2], B0[2][2];
    const char* cA = (const char*)g.A + (size_t)cur.pm * tstepA; const char* cB = (const char*)g.Bt + (size_t)cur.pn * tstepB;
    N1_STAGE3(0, cA, cB); N1_STAGE3(1, cA + kstep, cB + kstep);
    if (wr == 1) N1_BAR;
    N1_WAIT_V(6); N1_BAR;
    N1_BAR;
    int c0 = 0;
    for (;;) {
        const bool has_next = S.next(ui + 1, nxt);
        const char* nA = has_next ? (const char*)g.A + (size_t)nxt.pm * tstepA : cA; const char* nB = has_next ? (const char*)g.Bt + (size_t)nxt.pn * tstepB : cB;
        for (int t = 0; t < nt; ++t) {
            const bool tail = (t + 2 >= nt);
            const char* sa = tail ? nA + (size_t)(t + 2 - nt) * kstep : cA + (size_t)(t + 2) * kstep;
            const char* sb = tail ? nB + (size_t)(t + 2 - nt) * kstep : cB + (size_t)(t + 2) * kstep;
            const int c2 = (c0 == 0) ? 2 : c0 - 1;
            N1_LDB(B0, c0); N1_SCHED; N1_LDA(At0, c0, 0); N1_LDA(At1, c0, 1); N1_STAGE3(c2, sa, sb);
            N1_WAIT_V(6); N1_WAIT_L(0); N1_BAR;
            __builtin_amdgcn_s_setprio(1); N1_MMA(0, At0, B0); N1_MMA(1, At1, B0); __builtin_amdgcn_s_setprio(0);
            N1_BAR; N1_SCHED;
            c0 = (c0 == 2) ? 0 : c0 + 1;
        }
        if constexpr (ALIGN_EPI) { if (wr == 0) N1_BAR; }
        E(acc, cur, wr, wc, fr, fq);
        if (!has_next) break;
#pragma unroll
        for (int a = 0; a < 2; ++a)
#pragma unroll
            for (int m = 0; m < 4; ++m)
#pragma unroll
                for (int n = 0; n < 2; ++n) acc[a][0][m][n] = (f32x4){0.f, 0.f, 0.f, 0.f};
        cur = nxt; cA = nA; cB = nB; ++ui;
        if constexpr (ALIGN_EPI) { if (wr == 1) N1_BAR; }
    }
    N1_WAIT_V(0);
    if constexpr (!ALIGN_EPI) { if (wr == 0) N1_BAR; }
    N1_BAR;
#undef N1_STAGE1
#undef N1_STAGE3
#undef N1_LDA
#undef N1_LDB
#undef N1_MMA
#undef N1_WAIT_V
#undef N1_WAIT_L
#undef N1_BAR
#undef N1_SCHED
}

__device__ __forceinline__ int cond_of_pm(int pm) { return pm < 16 ? 0 : 1 + ((pm - 16) >> 2); }
__device__ __forceinline__ float row_rstd(const float* ssq, int row, int fq) {
    const f32x4 a = *(const f32x4*)(ssq + (size_t)row * 32 + 8 * fq), b = *(const f32x4*)(ssq + (size_t)row * 32 + 8 * fq + 4);
    float s = ((a[0] + a[1]) + (a[2] + a[3])) + ((b[0] + b[1]) + (b[2] + b[3]));
    s += __shfl_xor(s, 16); s += __shfl_xor(s, 32);
    return rsqrtf(s * (1.f / 1024.f) + EPS);
}

struct EpiQK {
    static constexpr bool PERM = false;
    bf16_t* Q; bf16_t* Kb; const float* qg; const float* kg; const float* rope; float* outk; const float* ssq; const float* sw;
    __device__ __forceinline__ void operator()(const f32x4 (&acc)[2][2][4][2], const Unit& u, int wr, int wc, int fr, int fq) const {
        const bool isk = u.pn >= 4; const int G = (u.pn & 3) * 4 + wc;
        const float* swp = sw + cond_of_pm(u.pm) * 7168 + u.pn * 256 + wc * 32 + 4 * fq;
        const float* g = isk ? kg : qg; bf16_t* dst = isk ? Kb : Q; const float sc = isk ? 1.f : C2;
        const bool prompt = u.pm < 16; const bool do_rope = (rope != nullptr) && !prompt;
        f32x4 gv[2][2];
#pragma unroll
        for (int bj = 0; bj < 2; ++bj)
#pragma unroll
            for (int n = 0; n < 2; ++n) gv[bj][n] = *(const f32x4*)(g + 32 * bj + 16 * n + 4 * fq);
#pragma unroll
        for (int ai = 0; ai < 2; ++ai)
#pragma unroll
            for (int m = 0; m < 4; ++m) {
                const int row = u.pm * BM + ai * HALF + wr * 64 + m * 16 + fr;
                const float rrow = row_rstd(ssq, row, fq);
                f32x4 x[2][2];
                float ss = 0.f;
#pragma unroll
                for (int bj = 0; bj < 2; ++bj)
#pragma unroll
                    for (int n = 0; n < 2; ++n) { const f32x4 xx = acc[ai][bj][m][n] * rrow + *(const f32x4*)(swp + 128 * bj + 16 * n); x[bj][n] = xx; ss += (xx[0] * xx[0] + xx[1] * xx[1]) + (xx[2] * xx[2] + xx[3] * xx[3]); }
                ss += __shfl_xor(ss, 16); ss += __shfl_xor(ss, 32);
                const float rstd = rsqrtf(ss * (1.f / 64.f) + EPS);
#pragma unroll
                for (int bj = 0; bj < 2; ++bj)
#pragma unroll
                    for (int n = 0; n < 2; ++n) x[bj][n] = x[bj][n] * rstd * gv[bj][n];
                if (isk && prompt) {
                    float* o = outk + (size_t)u.pm * (2 * 256 * 1024) + (size_t)(row & 255) * 1024 + 64 * G + 4 * fq;
#pragma unroll
                    for (int bj = 0; bj < 2; ++bj)
#pragma unroll
                        for (int n = 0; n < 2; ++n) *(f32x4*)(o + 32 * bj + 16 * n) = x[bj][n];
                }
                if (do_rope) {
                    const int t = (row - MP) & 1023;
#pragma unroll
                    for (int bj = 0; bj < 2; ++bj) {
                        const int pos = bj == 0 ? (t >> 6) : (t & 63);
                        const f32x4 cs01 = *(const f32x4*)(rope + (pos * 16 + 4 * fq) * 2), cs23 = *(const f32x4*)(rope + (pos * 16 + 4 * fq) * 2 + 4);
                        const float cc[4] = {cs01[0], cs01[2], cs23[0], cs23[2]}, sn[4] = {cs01[1], cs01[3], cs23[1], cs23[3]};
#pragma unroll
                        for (int e = 0; e < 4; ++e) { const float x0 = x[bj][0][e], x1 = x[bj][1][e]; x[bj][0][e] = x0 * cc[e] - x1 * sn[e]; x[bj][1][e] = x1 * cc[e] + x0 * sn[e]; }
                    }
                }
                bf16_t* rp = dst + (size_t)row * D + 64 * G + 8 * fq;
#pragma unroll
                for (int bj = 0; bj < 2; ++bj) { const f32x4 v0 = x[bj][0] * sc, v1 = x[bj][1] * sc;
                    u32x4 w; w.x = pk2(v0[0], v0[1]); w.y = pk2(v0[2], v0[3]); w.z = pk2(v1[0], v1[1]); w.w = pk2(v1[2], v1[3]);
                    *(u32x4*)(rp + 32 * bj) = w; }
            }
    }
};
struct EpiV {
    static constexpr bool PERM = true;
    bf16_t* V; float* outv; const float* ssq; const float* sw;
    __device__ __forceinline__ void operator()(const f32x4 (&acc)[2][1][4][2], const Unit& u, int wr, int wc, int fr, int fq) const {
        const int col0 = u.pn * HALF + wc * 32 + 8 * fq; const bool prompt = u.pm < 16;
        const float* swp = sw + cond_of_pm(u.pm) * 7168 + 2048 + col0; const f32x4 s0 = *(const f32x4*)swp, s1 = *(const f32x4*)(swp + 4);
#pragma unroll
        for (int ai = 0; ai < 2; ++ai)
#pragma unroll
            for (int m = 0; m < 4; ++m) {
                const int row = u.pm * BM + ai * HALF + wr * 64 + m * 16 + fr;
                const float rrow = row_rstd(ssq, row, fq);
                const f32x4 v0 = acc[ai][0][m][0] * rrow + s0, v1 = acc[ai][0][m][1] * rrow + s1;
                u32x4 w; w.x = pk2(v0[0], v0[1]); w.y = pk2(v0[2], v0[3]); w.z = pk2(v1[0], v1[1]); w.w = pk2(v1[2], v1[3]);
                *(u32x4*)(V + (size_t)row * D + col0) = w;
                if (prompt) { float* o = outv + (size_t)u.pm * (2 * 256 * 1024) + (size_t)(row & 255) * 1024 + col0; *(f32x4*)o = v0; *(f32x4*)(o + 4) = v1; }
            }
    }
};
struct EpiResid {
    static constexpr bool PERM = true;
    const float* resid_p; const float* resid_s; float* out; const float* gate;
    const float* gnorm; const float* scale; bf16_t* XN; float* ssq;
    __device__ __forceinline__ void operator()(const f32x4 (&acc)[2][1][4][2], const Unit& u, int wr, int wc, int fr, int fq) const {
        const int col0 = u.pn * HALF + wc * 32 + 8 * fq; const int cond = cond_of_pm(u.pm);
        const float* gp = gate + cond * 6144 + col0;
        const f32x4 g0 = *(const f32x4*)gp, g1 = *(const f32x4*)(gp + 4);
        f32x4 gs0 = (f32x4){0.f, 0.f, 0.f, 0.f}, gs1 = gs0;
        if (XN) { const float* sp = scale + cond * 6144 + col0; gs0 = *(const f32x4*)(gnorm + col0) * (1.f + *(const f32x4*)sp); gs1 = *(const f32x4*)(gnorm + col0 + 4) * (1.f + *(const f32x4*)(sp + 4)); }
        const float* src = u.pm < 16 ? resid_p + (size_t)u.pm * BM * D : resid_s + (size_t)(u.pm - 16) * BM * D;
        float* dstb = out + (size_t)u.pm * BM * D;
#pragma unroll
        for (int ai = 0; ai < 2; ++ai)
#pragma unroll
            for (int m = 0; m < 4; ++m) {
                const int rl = ai * HALF + wr * 64 + m * 16 + fr;
                const size_t off = (size_t)rl * D + col0;
                const f32x4 r0 = *(const f32x4*)(src + off), r1 = *(const f32x4*)(src + off + 4);
                const f32x4 y0 = r0 + g0 * acc[ai][0][m][0], y1 = r1 + g1 * acc[ai][0][m][1];
                *(f32x4*)(dstb + off) = y0; *(f32x4*)(dstb + off + 4) = y1;
                if (XN) {
                    const f32x4 a0 = y0 * gs0, a1 = y1 * gs1;
                    u32x4 w; w.x = pk2(a0[0], a0[1]); w.y = pk2(a0[2], a0[3]); w.z = pk2(a1[0], a1[1]); w.w = pk2(a1[2], a1[3]);
                    *(u32x4*)(XN + (size_t)u.pm * BM * D + off) = w;
                    float ss = ((y0[0] * y0[0] + y0[1] * y0[1]) + (y0[2] * y0[2] + y0[3] * y0[3])) + ((y1[0] * y1[0] + y1[1] * y1[1]) + (y1[2] * y1[2] + y1[3] * y1[3]));
                    ss += __shfl_xor(ss, 16); ss += __shfl_xor(ss, 32);
                    if (fq == 0) ssq[(size_t)(u.pm * BM + rl) * 32 + u.pn * 4 + wc] = ss;
                }
            }
    }
};
struct EpiRelu2 {
    static constexpr bool PERM = true;
    bf16_t* H; const float* ssq; const float* sw;
    __device__ __forceinline__ void operator()(const f32x4 (&acc)[2][2][4][2], const Unit& u, int wr, int wc, int fr, int fq) const {
        const int col0 = u.pn * BM + wc * 32 + 8 * fq;
        const float* swp = sw + cond_of_pm(u.pm) * 7168 + 3072 + col0;
        f32x4 sv[2][2];
#pragma unroll
        for (int bj = 0; bj < 2; ++bj) { sv[bj][0] = *(const f32x4*)(swp + bj * HALF); sv[bj][1] = *(const f32x4*)(swp + bj * HALF + 4); }
#pragma unroll
        for (int ai = 0; ai < 2; ++ai)
#pragma unroll
            for (int m = 0; m < 4; ++m) {
                const int row = u.pm * BM + ai * HALF + wr * 64 + m * 16 + fr;
                const float rrow = row_rstd(ssq, row, fq);
                bf16_t* rp = H + (size_t)row * FF + col0;
#pragma unroll
                for (int bj = 0; bj < 2; ++bj) {
                    f32x4 v0 = acc[ai][bj][m][0] * rrow + sv[bj][0], v1 = acc[ai][bj][m][1] * rrow + sv[bj][1];
#pragma unroll
                    for (int e = 0; e < 4; ++e) { const float a = fmaxf(v0[e], 0.f), b = fmaxf(v1[e], 0.f); v0[e] = a * a; v1[e] = b * b; }
                    u32x4 w; w.x = pk2(v0[0], v0[1]); w.y = pk2(v0[2], v0[3]); w.z = pk2(v1[0], v1[1]); w.w = pk2(v1[2], v1[3]);
                    *(u32x4*)(rp + bj * HALF) = w; }
            }
    }
};
}

namespace att {
constexpr float THR = 8.f, NEG = -1e30f;
__device__ __forceinline__ int crow(int r, int hi) { return (r & 3) + 8 * (r >> 2) + 4 * hi; }
__device__ __forceinline__ s16x4 vtr(const LAS char* p) { return __builtin_bit_cast(s16x4, __builtin_amdgcn_ds_read_tr16_b64_v4i16((LAS s16x4*)p)); }

struct Seg { const bf16_t* K1; const bf16_t* V1; int nt1; const bf16_t* K2; const bf16_t* V2; int nt2; };

template <bool DIFF, bool NA>
__device__ __forceinline__ void attn_unit(const int tid, LAS unsigned char* lds, const bf16_t* Qw  , const Seg sg, bf16_t* Ow  ,
                                          int kr_lo, int r_q, int jj, const float* relb  ,
                                          float lam, float post_scale, const float* subg) {
    constexpr int KW = DIFF ? 256 : 128, VW = DIFF ? 256 : 128, KS = KW + 16, VS = VW + 64, KBY = 64 * KS, VBY = 64 * VS, BUF = KBY + VBY;
    constexpr int DVB = DIFF ? 4 : 2, KC = DIFF ? 2 : 1;
    constexpr int WSF_OFF = 2 * BUF, BIAS_OFF = WSF_OFF + 2048, OST_OFF = BIAS_OFF + 2048;
    const int lane = tid & 63, l31 = lane & 31, hi = lane >> 5; const int wid = __builtin_amdgcn_readfirstlane(tid >> 6);
    const int mp = DIFF ? (wid >> 2) : 0;
    LAS float* wsf = (LAS float*)(lds + WSF_OFF) + wid * 64;
    LAS float* biasl = (LAS float*)(lds + BIAS_OFF);
    const int nt = sg.nt1 + sg.nt2;
    int srow[KC], sch[KC];
#pragma unroll
    for (int i = 0; i < KC; ++i) { const int ci = tid + 512 * i; srow[i] = ci / (KW / 16); sch[i] = ci % (KW / 16); }
    u32x4 kst[KC], vst[KC];
#define ATT_LOAD(t) do { const bf16_t* kb_ = (t) < sg.nt1 ? sg.K1 + (size_t)(t) * 64 * D : sg.K2 + (size_t)((t) - sg.nt1) * 64 * D; \
        const bf16_t* vb_ = (t) < sg.nt1 ? sg.V1 + (size_t)(t) * 64 * D : sg.V2 + (size_t)((t) - sg.nt1) * 64 * D; \
        _Pragma("unroll") for (int i = 0; i < KC; ++i) { kst[i] = *(const u32x4*)(kb_ + (size_t)srow[i] * D + sch[i] * 8); vst[i] = *(const u32x4*)(vb_ + (size_t)srow[i] * D + sch[i] * 8); } } while (0)
#define ATT_STORE(b) do { _Pragma("unroll") for (int i = 0; i < KC; ++i) { *(LAS u32x4*)(lds + (b) * BUF + srow[i] * KS + sch[i] * 16) = kst[i]; *(LAS u32x4*)(lds + (b) * BUF + KBY + srow[i] * VS + sch[i] * 16) = vst[i]; } } while (0)
    ATT_LOAD(0);
    if (NA) { for (int i = tid; i < 465; i += 512) biasl[i] = relb[i] * LOG2E; }
    bf16x8 qf[4];
#pragma unroll
    for (int d0 = 0; d0 < 4; ++d0) qf[d0] = *(const bf16x8*)(Qw + (size_t)l31 * D + d0 * 16 + hi * 8);
    f32x16 o[DVB];
#pragma unroll
    for (int i = 0; i < DVB; ++i) o[i] = f32x16{};
    float mrun = NEG, lsum = 0.f;
    ATT_STORE(0);
    __syncthreads();
    const int rs_q = NA ? min(max(r_q - 4, 0), 8) : 0;
    const int cq = 32 * jj + l31, cs = min(max(cq - 8, 0), 48);
    const int kvoff = KBY + (4 * hi + ((lane & 15) >> 2)) * VS + ((lane >> 4) & 1) * 32 + (lane & 3) * 8;
    for (int t = 0; t < nt; ++t) {
        const bool more = (t + 1 < nt);
        if (more) ATT_LOAD(t + 1);
        bool active = true; int kr = 0;
        if (NA && t < sg.nt1) { kr = kr_lo + t; active = (kr >= rs_q) && (kr < rs_q + 8); }
        if (active) {
            const LAS unsigned char* kb = lds + (t & 1) * BUF + mp * 128 + l31 * KS + hi * 16;
            f32x16 p0 = f32x16{}, p1 = f32x16{};
#pragma unroll
            for (int d0 = 0; d0 < 4; ++d0) {
                const bf16x8 a0 = *(const LAS bf16x8*)(kb + d0 * 32), a1 = *(const LAS bf16x8*)(kb + 32 * KS + d0 * 32);
                p0 = __builtin_amdgcn_mfma_f32_32x32x16_bf16(a0, qf[d0], p0, 0, 0, 0);
                p1 = __builtin_amdgcn_mfma_f32_32x32x16_bf16(a1, qf[d0], p1, 0, 0, 0);
            }
            if (NA && t < sg.nt1) {
                const LAS float* brow = biasl + (kr - r_q + 7) * 31 + 15 - cq;
#pragma unroll
                for (int r = 0; r < 16; ++r) {
                    const int k0 = crow(r, hi), k1 = k0 + 32;
                    const bool v0 = (k0 >= cs) && (k0 < cs + 16), v1 = (k1 >= cs) && (k1 < cs + 16);
                    const float b0 = brow[v0 ? k0 : cq], b1 = brow[v1 ? k1 : cq];
                    p0[r] = v0 ? p0[r] + b0 : NEG; p1[r] = v1 ? p1[r] + b1 : NEG;
                }
            }
            float tm = fmaxf(p0[0], p1[0]);
#pragma unroll
            for (int r = 1; r < 16; ++r) tm = fmaxf(tm, fmaxf(p0[r], p1[r]));
            tm = fmaxf(tm, __shfl_xor(tm, 32));
            if (__any(tm > mrun + THR)) {
                const float mn = fmaxf(mrun, tm), al = __builtin_amdgcn_exp2f(mrun - mn);
                lsum *= al; mrun = mn;
                if (hi == 0) wsf[l31] = al;
                LDS_WAIT();
#pragma unroll
                for (int r = 0; r < 16; ++r) { const float f = wsf[crow(r, hi)];
#pragma unroll
                    for (int i = 0; i < DVB; ++i) o[i][r] *= f; }
                LDS_WAIT();
            }
            float sacc = 0.f;
#pragma unroll
            for (int r = 0; r < 16; ++r) { p0[r] = __builtin_amdgcn_exp2f(p0[r] - mrun); p1[r] = __builtin_amdgcn_exp2f(p1[r] - mrun); sacc += p0[r] + p1[r]; }
            lsum += sacc;
            bf16x8 pa[2][2];
#pragma unroll
            for (int s = 0; s < 2; ++s) {
                u32x4 w0, w1;
                w0.x = pk2(p0[8 * s + 0], p0[8 * s + 1]); w0.y = pk2(p0[8 * s + 2], p0[8 * s + 3]); w0.z = pk2(p0[8 * s + 4], p0[8 * s + 5]); w0.w = pk2(p0[8 * s + 6], p0[8 * s + 7]);
                w1.x = pk2(p1[8 * s + 0], p1[8 * s + 1]); w1.y = pk2(p1[8 * s + 2], p1[8 * s + 3]); w1.z = pk2(p1[8 * s + 4], p1[8 * s + 5]); w1.w = pk2(p1[8 * s + 6], p1[8 * s + 7]);
                pa[0][s] = __builtin_bit_cast(bf16x8, w0); pa[1][s] = __builtin_bit_cast(bf16x8, w1);
            }
            const LAS char* vb = (const LAS char*)(lds + (t & 1) * BUF + kvoff);
#pragma unroll
            for (int d0 = 0; d0 < DVB; ++d0)
#pragma unroll
                for (int blk = 0; blk < 2; ++blk)
#pragma unroll
                    for (int s = 0; s < 2; ++s) {
                        const s16x4 lo = vtr(vb + (32 * blk + 16 * s) * VS + 64 * d0), hh = vtr(vb + (32 * blk + 16 * s + 8) * VS + 64 * d0);
                        const bf16x8 vf = (bf16x8){lo[0], lo[1], lo[2], lo[3], hh[0], hh[1], hh[2], hh[3]};
                        o[d0] = __builtin_amdgcn_mfma_f32_32x32x16_bf16(pa[blk][s], vf, o[d0], 0, 0, 0);
                    }
        }
        if (more) ATT_STORE((t + 1) & 1);
        __syncthreads();
    }
#undef ATT_LOAD
#undef ATT_STORE
    lsum += __shfl_xor(lsum, 32);
    if (hi == 0) wsf[l31] = 1.f / lsum;
    LDS_WAIT();
    float inv[16];
#pragma unroll
    for (int r = 0; r < 16; ++r) inv[r] = wsf[crow(r, hi)];
    LDS_WAIT();
    if constexpr (!DIFF) {
        LAS bf16_t* stg = (LAS bf16_t*)(lds + OST_OFF) + wid * 2048;
#pragma unroll
        for (int r = 0; r < 16; ++r) { const int q = crow(r, hi);
#pragma unroll
            for (int d0 = 0; d0 < 2; ++d0) { const unsigned w = pk2(o[d0][r] * inv[r], 0.f); stg[q * 64 + d0 * 32 + l31] = (bf16_t)(w & 0xffffu); } }
        LDS_WAIT();
#pragma unroll
        for (int i = 0; i < 4; ++i) { const int row = i * 8 + (lane >> 3), ch = lane & 7; const u32x4 v = *(const LAS u32x4*)(stg + row * 64 + ch * 8); *(u32x4*)(Ow + (size_t)row * D + ch * 8) = v; }
        LDS_WAIT();
        __syncthreads();
    } else {
        constexpr int RS = 132;
        LAS float* ex = (LAS float*)lds + (wid & 3) * 32 * RS;
        if (mp == 1) {
#pragma unroll
            for (int r = 0; r < 16; ++r) { const int q = crow(r, hi); const float f = inv[r] * lam;
#pragma unroll
                for (int d0 = 0; d0 < 4; ++d0) ex[q * RS + d0 * 32 + l31] = o[d0][r] * f; }
        }
        LDS_WAIT();
        __syncthreads();
        if (mp == 0) {
#pragma unroll
            for (int r = 0; r < 16; ++r) { const int q = crow(r, hi);
#pragma unroll
                for (int d0 = 0; d0 < 4; ++d0) { LAS float* p = ex + q * RS + d0 * 32 + l31; *p = o[d0][r] * inv[r] - *p; } }
            LDS_WAIT();
            const LAS float* rp = ex + l31 * RS + hi * 64;
            f32x4 v[16]; float ss = 0.f;
#pragma unroll
            for (int j = 0; j < 16; ++j) { v[j] = *(const LAS f32x4*)(rp + 4 * j); ss += (v[j][0] * v[j][0] + v[j][1] * v[j][1]) + (v[j][2] * v[j][2] + v[j][3] * v[j][3]); }
            ss += __shfl_xor(ss, 32);
            const float rstd = rsqrtf(ss * (1.f / 128.f) + EPS) * post_scale;
            bf16_t* orow = Ow + (size_t)l31 * D + hi * 64;
#pragma unroll
            for (int j = 0; j < 8; ++j) { const f32x4 g0 = *(const f32x4*)(subg + hi * 64 + 8 * j), g1 = *(const f32x4*)(subg + hi * 64 + 8 * j + 4);
                const f32x4 a = v[2 * j] * rstd * g0, b = v[2 * j + 1] * rstd * g1;
                u32x4 w; w.x = pk2(a[0], a[1]); w.y = pk2(a[2], a[3]); w.z = pk2(b[0], b[1]); w.w = pk2(b[2], b[3]);
                *(u32x4*)(orow + 8 * j) = w; }
        }
        LDS_WAIT();
        __syncthreads();
    }
}
}

#define XB_TMO      128
#define XB_XCNT(j)  (256  + 64 * (j))
#define XB_XSUB(j)  (1280 + 64 * (j))
#define XB_XGEN(j)  (2304 + 64 * (j))
#define XB_TOP      3328
#define XB_TOPGEN   3392
#define XCD_BAR_WORDS 3456
#define XB_SPIN_CAP (1u << 18)
__device__ __forceinline__ unsigned xb_ld(unsigned* p)              { return __hip_atomic_load(p, __ATOMIC_RELAXED, __HIP_MEMORY_SCOPE_AGENT); }
__device__ __forceinline__ unsigned xb_add(unsigned* p, unsigned v) { return __hip_atomic_fetch_add(p, v, __ATOMIC_RELAXED, __HIP_MEMORY_SCOPE_AGENT); }
__device__ __forceinline__ unsigned xb_xcc_id() { return (unsigned)__builtin_amdgcn_s_getreg((3 << 11) | 20) & 0xFu; }
#define XB_SPIN(cond, bar) do { unsigned _sp = 0; while (cond) { __builtin_amdgcn_s_sleep(1); \
    if ((++_sp & 255u) == 0u) { if (xb_ld(&(bar)[XB_TMO])) break; if (_sp > XB_SPIN_CAP) { atomicAdd(&(bar)[XB_TMO], 1u); break; } } } } while (0)
struct XcdBarrier { unsigned* bar; unsigned x; volatile LAS unsigned* st; };
__device__ __forceinline__ XcdBarrier xcd_barrier_post(unsigned* bar, volatile LAS unsigned* st) {
    XcdBarrier b; b.bar = bar; b.x = xb_xcc_id(); b.st = st;
    if (threadIdx.x == 0) (void)xb_add(&bar[XB_XCNT(b.x)], 1u);
    return b;
}
__device__ __forceinline__ void xcd_barrier_complete(unsigned* bar, unsigned x, unsigned& nloc, unsigned& nx) {
    const unsigned G = gridDim.x * gridDim.y * gridDim.z;
    unsigned sum, cnt, mine, sp = 0u;
    for (;;) {
        sum = 0u; cnt = 0u; mine = 0u;
#pragma unroll
        for (unsigned j = 0; j < 16; ++j) { const unsigned c = xb_ld(&bar[XB_XCNT(j)]); sum += c; cnt += (c > 0u) ? 1u : 0u; mine = (j == x) ? c : mine; }
        if (sum == G) break;
        __builtin_amdgcn_s_sleep(1);
        if ((++sp & 255u) == 0u) { if (xb_ld(&bar[XB_TMO])) break; if (sp > XB_SPIN_CAP) { atomicAdd(&bar[XB_TMO], 1u); break; } }
    }
    nloc = mine > 0u ? mine : 1u; nx = cnt > 0u ? cnt : 1u;
}
__device__ __forceinline__ void xcd_barrier(const XcdBarrier& b) {
    asm volatile("s_waitcnt vmcnt(0)" ::: "memory");
    __syncthreads();
    if (threadIdx.x == 0) {
        unsigned* bar = b.bar;
        __builtin_amdgcn_s_waitcnt(0);
        unsigned nloc = b.st[0], nx = b.st[1];
        if (nloc == 0u) { xcd_barrier_complete(bar, b.x, nloc, nx); b.st[0] = nloc; b.st[1] = nx; }
        const unsigned old = xb_add(&bar[XB_XSUB(b.x)], 1u);
        const unsigned gen = old / nloc;
        if (old + 1u == (gen + 1u) * nloc) {
            __builtin_amdgcn_fence(__ATOMIC_RELEASE, "agent");
            asm volatile("s_waitcnt vmcnt(0)" ::: "memory");
            const unsigned og = xb_add(&bar[XB_TOP], 1u);
            const unsigned tg = og / nx;
            if (og + 1u == (tg + 1u) * nx) xb_add(&bar[XB_TOPGEN], 1u);
            else XB_SPIN(xb_ld(&bar[XB_TOPGEN]) == tg, bar);
            __builtin_amdgcn_fence(__ATOMIC_ACQUIRE, "agent");
            xb_add(&bar[XB_XGEN(b.x)], 1u);
            asm volatile("s_waitcnt vmcnt(0)" ::: "memory");
        } else {
            XB_SPIN(xb_ld(&bar[XB_XGEN(b.x)]) == gen, bar);
            __builtin_amdgcn_fence(__ATOMIC_ACQUIRE, "agent");
            asm volatile("s_waitcnt vmcnt(0)" ::: "memory");
        }
    }
    __syncthreads();
}

struct Args { const float* in[28]; float* out; unsigned char* ws; int ph_lo, ph_hi; };
typedef const __attribute__((address_space(4))) Args* CArgs;
__device__ __forceinline__ CArgs args_ptr() { unsigned long long p = (unsigned long long)__builtin_amdgcn_kernarg_segment_ptr(); asm volatile("" : "+s"(p)); return (CArgs)p; }

template <bool QKVMAP>
__device__ __forceinline__ void transpose_item(const float* W, int K, int N, bf16_t* WT, int item, int lane) {
    const int nblk = N / 64, kb = item / nblk, nb = item % nblk, k0 = 64 * kb, n = 64 * nb + lane;
    int nr = n;
    if (QKVMAP && n < 2048) { const int c = n & 255; nr = (n - c) + ((c & 63) >> 5) * 128 + (c >> 6) * 32 + (c & 31); }
    const float* src = W + (size_t)k0 * N + n;
    bf16_t* dst = WT + (size_t)nr * K + k0;
#pragma unroll
    for (int half = 0; half < 2; ++half) {
        float v[32];
#pragma unroll
        for (int j = 0; j < 32; ++j) v[j] = src[(size_t)(32 * half + j) * N];
#pragma unroll
        for (int c = 0; c < 4; ++c) { u32x4 w; w.x = pk2(v[8 * c], v[8 * c + 1]); w.y = pk2(v[8 * c + 2], v[8 * c + 3]); w.z = pk2(v[8 * c + 4], v[8 * c + 5]); w.w = pk2(v[8 * c + 6], v[8 * c + 7]);
            *(u32x4*)(dst + 32 * half + 8 * c) = w; }
    }
}

__global__ void __launch_bounds__(512, 2) fwd_kernel(Args args_by_value_unused) {
    extern __shared__ __attribute__((aligned(16))) unsigned char lds_raw[];
    LAS unsigned char* lds = (LAS unsigned char*)lds_raw;
    const int tid = threadIdx.x, lane = tid & 63; const int wave = __builtin_amdgcn_readfirstlane(tid >> 6);
    const int G = gridDim.x; const int bx = blockIdx.x; const int vcu = (G % 8 == 0) ? (bx % 8) * (G / 8) + bx / 8 : bx;
    int lo, hi;
    volatile LAS unsigned* MISC = (volatile LAS unsigned*)(lds + MISC_OFF);
    for (int u = tid; u < (LDS_BYTES - LDSCTL_OFF) / 4; u += 512) ((LAS unsigned*)(lds + LDSCTL_OFF))[u] = 0u;
    __syncthreads();
    XcdBarrier bar;
    { CArgs A = args_ptr(); lo = A->ph_lo; hi = A->ph_hi; unsigned* ctl = (unsigned*)(A->ws + WS_CTL);
      bar.bar = ctl + CW_BAR; bar.x = 0; bar.st = nullptr;
      if (MK_SINGLE) bar = xcd_barrier_post(ctl + CW_BAR, MISC + 8); }
#define IN(k) (lo <= (k) && (k) < hi)
#define SEAM(k) do { if (IN(k) && IN((k) + 1)) { for (int d_ = 0; d_ < DUP_BAR; ++d_) xcd_barrier(bar); } } while (0)
    const int gw = vcu * 8 + wave, NGW = G * 8;

    if (EN_PRO && IN(0)) for (int dup_ = 0; dup_ < DUP_PRO; ++dup_) {
        {
            CArgs A = args_ptr();
            LAS float* sl = (LAS float*)lds;
            LAS f32x4* red = (LAS f32x4*)(lds + 20480);
            const float* c = A->in[6]; const float* cctx = A->in[7]; float* mod = (float*)(A->ws + WS_MOD);
            for (int idx = tid; idx < 5120; idx += 512) { const int n = idx >> 10, k = idx & 1023; const float x = n == 0 ? cctx[k] : c[(n - 1) * 1024 + k]; sl[idx] = x / (1.f + __expf(-x)); }
            __syncthreads();
            for (int wq = bx; wq < 256; wq += G) {
                const int l = wq >> 6, cb = (wq & 63) * 96;
                if (tid < 384) {
                    const int cg = tid % 24, ks = tid / 24;
                    const float* wp = A->in[8] + ((size_t)l * 1024 + ks * 64) * 6144 + cb + 4 * cg;
                    f32x4 a[5];
#pragma unroll
                    for (int n = 0; n < 5; ++n) a[n] = (f32x4){0.f, 0.f, 0.f, 0.f};
#pragma unroll 8
                    for (int k = 0; k < 64; ++k) { const f32x4 w4 = *(const f32x4*)(wp + (size_t)k * 6144);
#pragma unroll
                        for (int n = 0; n < 5; ++n) a[n] += sl[n * 1024 + ks * 64 + k] * w4; }
#pragma unroll
                    for (int n = 0; n < 5; ++n) red[(ks * 24 + cg) * 5 + n] = a[n];
                }
                __syncthreads();
                if (tid < 120) { const int cg = tid / 5, n = tid % 5; f32x4 s = *(const f32x4*)(A->in[9] + l * 6144 + cb + 4 * cg);
                    for (int ks = 0; ks < 16; ++ks) s += red[(ks * 24 + cg) * 5 + n];
                    *(f32x4*)(mod + ((size_t)l * 5 + n) * 6144 + cb + 4 * cg) = s; }
                __syncthreads();
            }
        }
        if (bx == 0) {
            CArgs A = args_ptr(); float* ropet = (float*)(A->ws + WS_ROPE);
            for (int idx = tid; idx < 1024; idx += 512) { const int pos = idx >> 4, j = idx & 15; const float fr = powf(10000.f, -(float)j / 16.f); const float ang = (float)pos * fr; ropet[2 * idx] = cosf(ang); ropet[2 * idx + 1] = sinf(ang); }
        }
        if (bx == 1 % G && wave < 2) {
            CArgs A = args_ptr(); float* lamv = (float*)(A->ws + WS_LAM);
            const int i = wave; const float a1 = A->in[18][i * 64 + lane] * A->in[19][i * 64 + lane], a2 = A->in[20][i * 64 + lane] * A->in[21][i * 64 + lane];
            const float s1 = wave_sum(a1), s2 = wave_sum(a2); const float linit = 0.8f - 0.6f * expf(-0.3f * (float)(2 * i));
            if (lane == 0) lamv[i] = expf(s1) - expf(s2) + linit;
        }
        {
            CArgs A = args_ptr(); bf16_t* cache = (bf16_t*)(A->ws + WS_CACHE);
            for (int ch = gw * 64 + lane; ch < 4 * 2 * 4 * 256 * 128; ch += NGW * 64) {
                const int c8 = ch & 127, t = (ch >> 7) & 255, b = (ch >> 15) & 3, i = (ch >> 17) & 1, kind = ch >> 18;
                const float* src = A->in[2 + kind] + (((size_t)(b * 2 + i) * 256 + t) * 1024);
                f32x4 v0, v1;
                if ((kind & 1) == 0) { const int Gh = c8 >> 3, p8 = c8 & 7, bj = p8 >> 2, fq = p8 & 3; const float* sp = src + 64 * Gh + 32 * bj + 4 * fq; v0 = *(const f32x4*)sp; v1 = *(const f32x4*)(sp + 16); }
                else { v0 = *(const f32x4*)(src + 8 * c8); v1 = *(const f32x4*)(src + 8 * c8 + 4); }
                u32x4 w; w.x = pk2(v0[0], v0[1]); w.y = pk2(v0[2], v0[3]); w.z = pk2(v1[0], v1[1]); w.w = pk2(v1[2], v1[3]);
                *(u32x4*)(cache + (size_t)ch * 8) = w;
            }
        }
        {
            constexpr int I_QKV = 16 * 48, I_O = 16 * 16, I_1 = 16 * 64, I_2 = 64 * 16, I_L = I_QKV + I_O + I_1 + I_2;
            for (int it = gw; it < DEPTH * I_L; it += NGW) {
                CArgs A = args_ptr();
                const int l = it / I_L, i = l >> 1; int r = it % I_L;
                unsigned char* wl = A->ws + WS_W + (size_t)l * W_LAYER;
                if (r < I_QKV) { transpose_item<true>(A->in[(l & 1) ? 23 : 14] + (size_t)i * 1024 * 3072, 1024, 3072, (bf16_t*)(wl + W_QKV), r, lane); continue; } r -= I_QKV;
                if (r < I_O) { transpose_item<false>(A->in[(l & 1) ? 24 : 15] + (size_t)i * 1024 * 1024, 1024, 1024, (bf16_t*)(wl + W_O), r, lane); continue; } r -= I_O;
                if (r < I_1) { transpose_item<false>(A->in[12] + (size_t)l * 1024 * 4096, 1024, 4096, (bf16_t*)(wl + W_1), r, lane); continue; } r -= I_1;
                transpose_item<false>(A->in[13] + (size_t)l * 4096 * 1024, 4096, 1024, (bf16_t*)(wl + W_2), r, lane);
            }
        }
    }
    SEAM(0);
    if (EN_NORM && IN(1)) for (int dup_ = 0; dup_ < DUP_NORM; ++dup_) {
        {
            CArgs A = args_ptr(); int ptid = threadIdx.x; asm volatile("" : "+v"(ptid)); const int lane = ptid & 63; const int gwv = vcu * 8 + __builtin_amdgcn_readfirstlane(ptid >> 6);
            const float* gam = A->in[10]; const float* modl = (const float*)(A->ws + WS_MOD); bf16_t* XN = (bf16_t*)(A->ws + WS_XN); float* ssq = (float*)(A->ws + WS_SSQ);
            for (int row = gwv; row < M; row += NGW) {
                const float* xr = row < MP ? A->in[0] + (size_t)row * D : A->in[1] + (size_t)(row - MP) * D;
                const float* sc = modl + (row < MP ? 0 : 1 + ((row - MP) >> 10)) * 6144 + 1024;
                f32x4 v[4]; float ss = 0.f;
#pragma unroll
                for (int j = 0; j < 4; ++j) { v[j] = *(const f32x4*)(xr + 4 * lane + 256 * j); ss += (v[j][0] * v[j][0] + v[j][1] * v[j][1]) + (v[j][2] * v[j][2] + v[j][3] * v[j][3]); }
                ss = wave_sum(ss);
#pragma unroll
                for (int j = 0; j < 4; ++j) { const int c = 4 * lane + 256 * j; const f32x4 h = v[j] * *(const f32x4*)(gam + c) * (1.f + *(const f32x4*)(sc + c));
                    u32x2 w; w.x = pk2(h[0], h[1]); w.y = pk2(h[2], h[3]); *(u32x2*)(XN + (size_t)row * D + c) = w; }
                if (lane < 32) ssq[(size_t)row * 32 + lane] = ss * (1.f / 32.f);
            }
        }
        {
            CArgs A = args_ptr(); int ptid = threadIdx.x; asm volatile("" : "+v"(ptid)); const int lane = ptid & 63; const int gwv = vcu * 8 + __builtin_amdgcn_readfirstlane(ptid >> 6);
            const float* mod = (const float*)(A->ws + WS_MOD); float* swt = (float*)(A->ws + WS_SW);
            for (int it = gwv; it < DEPTH * 7168; it += NGW) {
                const int l = it / 7168, r = it % 7168;
                const bf16_t* wrow = r < 3072 ? (const bf16_t*)(A->ws + WS_W + (size_t)l * W_LAYER + W_QKV) + (size_t)r * 1024 : (const bf16_t*)(A->ws + WS_W + (size_t)l * W_LAYER + W_1) + (size_t)(r - 3072) * 1024;
                const float* sh = mod + (size_t)l * 5 * 6144 + (r < 3072 ? 0 : 3) * 1024;
                const u32x4 w0 = *(const u32x4*)(wrow + 8 * lane), w1 = *(const u32x4*)(wrow + 512 + 8 * lane);
                float wf[16];
#pragma unroll
                for (int j = 0; j < 4; ++j) { wf[2 * j] = __uint_as_float(w0[j] << 16); wf[2 * j + 1] = __uint_as_float(w0[j] & 0xffff0000u); wf[8 + 2 * j] = __uint_as_float(w1[j] << 16); wf[8 + 2 * j + 1] = __uint_as_float(w1[j] & 0xffff0000u); }
                float a[5];
#pragma unroll
                for (int n = 0; n < 5; ++n) { const float* sp = sh + n * 6144 + 8 * lane; const f32x4 s0 = *(const f32x4*)sp, s1 = *(const f32x4*)(sp + 4), s2 = *(const f32x4*)(sp + 512), s3 = *(const f32x4*)(sp + 516);
                    a[n] = ((wf[0] * s0[0] + wf[1] * s0[1]) + (wf[2] * s0[2] + wf[3] * s0[3])) + ((wf[4] * s1[0] + wf[5] * s1[1]) + (wf[6] * s1[2] + wf[7] * s1[3]))
                         + ((wf[8] * s2[0] + wf[9] * s2[1]) + (wf[10] * s2[2] + wf[11] * s2[3])) + ((wf[12] * s3[0] + wf[13] * s3[1]) + (wf[14] * s3[2] + wf[15] * s3[3])); }
#pragma unroll
                for (int n = 0; n < 5; ++n) a[n] = wave_sum(a[n]);
                if (lane < 5) { const float v = lane == 0 ? a[0] : lane == 1 ? a[1] : lane == 2 ? a[2] : lane == 3 ? a[3] : a[4]; swt[((size_t)l * 5 + lane) * 7168 + r] = v; }
            }
        }
    }
    SEAM(1);

    for (int l = 0; l < DEPTH; ++l) {
        const int pb = 2 + 5 * l, i = l >> 1; const bool diff = (l & 1) == 0;
        if (EN_QKV && IN(pb + 0)) for (int dup_ = 0; dup_ < DUP_QKV; ++dup_) {
            {
                CArgs A = args_ptr(); unsigned char* ws = A->ws; int ptid = threadIdx.x; asm volatile("" : "+v"(ptid)); const bf16_t* wq = (const bf16_t*)(ws + WS_W + (size_t)l * W_LAYER + W_QKV);
                pg8::Gemm g{(const bf16_t*)(ws + WS_XN), wq, 1024}; pg8::StaticOrder S; S.init(32, 8, G, bx);
                pg8::EpiQK E{(bf16_t*)(ws + WS_Q), (bf16_t*)(ws + WS_K), A->in[diff ? 16 : 25] + i * 64, A->in[diff ? 17 : 26] + i * 64, diff ? (const float*)(ws + WS_ROPE) : nullptr,
                             A->out + (diff ? OUT_DK : OUT_NK) + (size_t)i * 256 * 1024, (const float*)(ws + WS_SSQ), (const float*)(ws + WS_SW) + (size_t)l * 5 * 7168};
                pg8::gemm_phase<pg8::EpiQK, 2, true>(lds, g, S, E, ptid);
            }
            {
                CArgs A = args_ptr(); unsigned char* ws = A->ws; int ptid = threadIdx.x; asm volatile("" : "+v"(ptid)); const bf16_t* wq = (const bf16_t*)(ws + WS_W + (size_t)l * W_LAYER + W_QKV);
                pg8::Gemm g{(const bf16_t*)(ws + WS_XN), wq + (size_t)2048 * 1024, 1024}; pg8::StaticOrder S; S.init(32, 8, G, bx);
                pg8::EpiV E{(bf16_t*)(ws + WS_V), A->out + (diff ? OUT_DV : OUT_NV) + (size_t)i * 256 * 1024, (const float*)(ws + WS_SSQ), (const float*)(ws + WS_SW) + (size_t)l * 5 * 7168};
                pg8::gemm_phase_n1<pg8::EpiV, true>(lds, g, S, E, ptid);
            }
        }
        SEAM(pb + 0);
        if (EN_ATT && IN(pb + 1)) {
            for (int v = vcu; v < 256; v += G) {
                if (diff) {
                    const float linit = 0.8f - 0.6f * expf(-0.3f * (float)l);
                    for (int dup_ = 0; dup_ < DUP_ADP; ++dup_) {
                        CArgs A = args_ptr(); unsigned char* ws = A->ws; int ptid = threadIdx.x; asm volatile("" : "+v"(ptid)); const bf16_t* Qb = (const bf16_t*)(ws + WS_Q); const bf16_t* Kb = (const bf16_t*)(ws + WS_K); const bf16_t* Vb = (const bf16_t*)(ws + WS_V); bf16_t* Ob = (bf16_t*)(ws + WS_O);
                        const float lam = ((const float*)(ws + WS_LAM))[i]; const float* subg = A->in[22] + i * 128;
                        const int pw = __builtin_amdgcn_readfirstlane(ptid >> 6), rg = pw & 3, mp = pw >> 2; const int b = v >> 4, h = (v >> 1) & 7, qb = v & 1; const int q0 = b * 256 + qb * 128 + rg * 32;
                        att::Seg sg{Kb + (size_t)(b * 256) * D + h * 128, Vb + (size_t)(b * 256) * D + h * 128, 4, nullptr, nullptr, 0};
                        att::attn_unit<true, false>(ptid, lds, Qb + (size_t)q0 * D + h * 128 + mp * 64, sg, Ob + (size_t)q0 * D + h * 128, 0, 0, 0, nullptr, lam, 1.f - linit, subg);
                    }
                    for (int dup_ = 0; dup_ < DUP_ADL; ++dup_) {
                        CArgs A = args_ptr(); unsigned char* ws = A->ws; int ptid = threadIdx.x; asm volatile("" : "+v"(ptid)); const bf16_t* Qb = (const bf16_t*)(ws + WS_Q); const bf16_t* Kb = (const bf16_t*)(ws + WS_K); const bf16_t* Vb = (const bf16_t*)(ws + WS_V); bf16_t* Ob = (bf16_t*)(ws + WS_O);
                        const bf16_t* cache = (const bf16_t*)(ws + WS_CACHE);
                        const float lam = ((const float*)(ws + WS_LAM))[i]; const float* subg = A->in[22] + i * 128;
                        const int pw = __builtin_amdgcn_readfirstlane(ptid >> 6), rg = pw & 3, mp = pw >> 2; const int b = v >> 6, h = (v >> 3) & 7, qb = v & 7; const int q0 = MP + b * 1024 + qb * 128 + rg * 32;
                        const bf16_t* ck = cache + ((size_t)(0 * 2 + i) * 4 + b) * 256 * 1024 + h * 128; const bf16_t* cv = cache + ((size_t)(1 * 2 + i) * 4 + b) * 256 * 1024 + h * 128;
                        att::Seg sg{Kb + (size_t)(MP + b * 1024) * D + h * 128, Vb + (size_t)(MP + b * 1024) * D + h * 128, 16, ck, cv, 4};
                        att::attn_unit<true, false>(ptid, lds, Qb + (size_t)q0 * D + h * 128 + mp * 64, sg, Ob + (size_t)q0 * D + h * 128, 0, 0, 0, nullptr, lam, 1.f - linit, subg);
                    }
                } else {
                    for (int dup_ = 0; dup_ < DUP_ANP; ++dup_) {
                        CArgs A = args_ptr(); unsigned char* ws = A->ws; int ptid = threadIdx.x; asm volatile("" : "+v"(ptid)); const bf16_t* Qb = (const bf16_t*)(ws + WS_Q); const bf16_t* Kb = (const bf16_t*)(ws + WS_K); const bf16_t* Vb = (const bf16_t*)(ws + WS_V); bf16_t* Ob = (bf16_t*)(ws + WS_O);
                        const int pw = __builtin_amdgcn_readfirstlane(ptid >> 6); const int b = v >> 4, h = v & 15; const int q0 = b * 256 + pw * 32;
                        att::Seg sg{Kb + (size_t)(b * 256) * D + h * 64, Vb + (size_t)(b * 256) * D + h * 64, 4, nullptr, nullptr, 0};
                        att::attn_unit<false, false>(ptid, lds, Qb + (size_t)q0 * D + h * 64, sg, Ob + (size_t)q0 * D + h * 64, 0, 0, 0, nullptr, 0.f, 0.f, nullptr);
                    }
                    for (int dup_ = 0; dup_ < DUP_ANL; ++dup_) {
                        CArgs A = args_ptr(); unsigned char* ws = A->ws; int ptid = threadIdx.x; asm volatile("" : "+v"(ptid)); const bf16_t* Qb = (const bf16_t*)(ws + WS_Q); const bf16_t* Kb = (const bf16_t*)(ws + WS_K); const bf16_t* Vb = (const bf16_t*)(ws + WS_V); bf16_t* Ob = (bf16_t*)(ws + WS_O);
                        const bf16_t* cache = (const bf16_t*)(ws + WS_CACHE);
                        const int b = v >> 6, h = (v >> 2) & 15, R = v & 3; const int pw = __builtin_amdgcn_readfirstlane(ptid >> 6); const int r_q = 4 * R + (pw >> 1), jj = pw & 1; const int q0 = MP + b * 1024 + r_q * 64 + jj * 32;
                        const int kr_lo = min(max(4 * R - 4, 0), 8), kr_hi = min(max(4 * R + 3 - 4, 0), 8) + 8;
                        const bf16_t* ck = cache + ((size_t)(2 * 2 + i) * 4 + b) * 256 * 1024 + h * 64; const bf16_t* cv = cache + ((size_t)(3 * 2 + i) * 4 + b) * 256 * 1024 + h * 64;
                        att::Seg sg{Kb + (size_t)(MP + b * 1024 + kr_lo * 64) * D + h * 64, Vb + (size_t)(MP + b * 1024 + kr_lo * 64) * D + h * 64, kr_hi - kr_lo, ck, cv, 4};
                        att::attn_unit<false, true>(ptid, lds, Qb + (size_t)q0 * D + h * 64, sg, Ob + (size_t)q0 * D + h * 64, kr_lo, r_q, jj, A->in[27] + ((size_t)i * 16 + h) * 465, 0.f, 0.f, nullptr);
                    }
                }
            }
        }
        SEAM(pb + 1);
        if (EN_O && IN(pb + 2)) for (int dup_ = 0; dup_ < DUP_O; ++dup_) {
            CArgs A = args_ptr(); unsigned char* ws = A->ws; int ptid = threadIdx.x; asm volatile("" : "+v"(ptid)); float* out = A->out; float* outw = dup_ + 1 < DUP_O ? (float*)(ws + WS_Q) : out + OUT_Y;
            const float* modl = (const float*)(ws + WS_MOD) + (size_t)l * 5 * 6144;
            pg8::Gemm g{(const bf16_t*)(ws + WS_O), (const bf16_t*)(ws + WS_W + (size_t)l * W_LAYER + W_O), 1024}; pg8::StaticOrder S; S.init(32, 8, G, bx);
            pg8::EpiResid E{l == 0 ? A->in[0] : out + OUT_Y, l == 0 ? A->in[1] : out + OUT_Y + (size_t)MP * D, outw, modl + 2 * 1024,
                            A->in[11] + l * 1024, modl + 4 * 1024, (bf16_t*)(ws + WS_XN), (float*)(ws + WS_SSQ)};
            pg8::gemm_phase_n1<pg8::EpiResid, true>(lds, g, S, E, ptid);
        }
        SEAM(pb + 2);
        if (EN_FC1 && IN(pb + 3)) for (int dup_ = 0; dup_ < DUP_FC1; ++dup_) {
            CArgs A = args_ptr(); unsigned char* ws = A->ws; int ptid = threadIdx.x; asm volatile("" : "+v"(ptid));
            pg8::Gemm g{(const bf16_t*)(ws + WS_XN), (const bf16_t*)(ws + WS_W + (size_t)l * W_LAYER + W_1), 1024}; pg8::StaticOrder S; S.init(32, 16, G, bx);
            pg8::EpiRelu2 E{(bf16_t*)(ws + WS_H), (const float*)(ws + WS_SSQ), (const float*)(ws + WS_SW) + (size_t)l * 5 * 7168};
            pg8::gemm_phase<pg8::EpiRelu2, 2, true>(lds, g, S, E, ptid);
        }
        SEAM(pb + 3);
        if (EN_FC2 && IN(pb + 4)) for (int dup_ = 0; dup_ < DUP_FC2; ++dup_) {
            CArgs A = args_ptr(); unsigned char* ws = A->ws; int ptid = threadIdx.x; asm volatile("" : "+v"(ptid)); float* out = A->out; float* outw = dup_ + 1 < DUP_FC2 ? (float*)(ws + WS_Q) : out + OUT_Y;
            const float* modl = (const float*)(ws + WS_MOD) + (size_t)l * 5 * 6144; const bool more = l + 1 < DEPTH;
            pg8::Gemm g{(const bf16_t*)(ws + WS_H), (const bf16_t*)(ws + WS_W + (size_t)l * W_LAYER + W_2), 4096}; pg8::StaticOrder S; S.init(32, 8, G, bx);
            pg8::EpiResid E{out + OUT_Y, out + OUT_Y + (size_t)MP * D, outw, modl + 5 * 1024,
                            A->in[10] + (l + 1) * 1024, modl + 5 * 6144 + 1 * 1024, more ? (bf16_t*)(ws + WS_XN) : nullptr, (float*)(ws + WS_SSQ)};
            pg8::gemm_phase_n1<pg8::EpiResid, true>(lds, g, S, E, ptid);
        }
        SEAM(pb + 4);
    }
#undef IN
#undef SEAM
}

extern "C" void kernel_launch(void* const* d_in, const int* in_sizes, int n_in, void* d_out, int out_size, void* d_ws, size_t ws_size, hipStream_t stream) {
    static int grid = 0;
    if (grid == 0) {
        if (n_in != 28 || out_size != 41943040 || ws_size < WS_END) { fprintf(stderr, "kernel_launch: unexpected shapes (n_in %d, out %d, ws %zu); nothing launched\n", n_in, out_size, ws_size); grid = -1; return; }
        int dev = 0, cus = 0;
        if (hipGetDevice(&dev) != hipSuccess || hipDeviceGetAttribute(&cus, hipDeviceAttributeMultiprocessorCount, dev) != hipSuccess) { grid = -1; return; }
        if (hipFuncSetAttribute((const void*)fwd_kernel, hipFuncAttributeMaxDynamicSharedMemorySize, LDS_BYTES) != hipSuccess) { fprintf(stderr, "kernel_launch: hipFuncSetAttribute failed\n"); grid = -1; return; }
        int per_cu = 0;
        if (hipOccupancyMaxActiveBlocksPerMultiprocessor(&per_cu, (const void*)fwd_kernel, 512, LDS_BYTES) != hipSuccess || per_cu < 1) fprintf(stderr, "kernel_launch: occupancy query reports %d\n", per_cu);
        (void)hipGetLastError();
        grid = cus;
    }
    if (grid < 0) return;
    (void)hipMemsetAsync((char*)d_ws + WS_CTL, 0, CTL_ZERO_BYTES, stream);
    Args a{};
    for (int i = 0; i < 28; ++i) a.in[i] = (const float*)d_in[i];
    a.out = (float*)d_out; a.ws = (unsigned char*)d_ws;
    constexpr int NPH = 2 + 5 * DEPTH;
#if MK_SINGLE
    a.ph_lo = 0; a.ph_hi = NPH;
    hipLaunchKernelGGL(fwd_kernel, dim3(grid), dim3(512), LDS_BYTES, stream, a);
#else
    for (int p = 0; p < NPH; ++p) { a.ph_lo = p; a.ph_hi = p + 1; hipLaunchKernelGGL(fwd_kernel, dim3(grid), dim3(512), LDS_BYTES, stream, a); }
#endif
}
```

```cpp
#include <hip/hip_runtime.h>
#include <cstdio>
#include <cstdint>

#ifndef MK_SINGLE
#define MK_SINGLE 1
#endif

#ifndef DUP_PRO
#define DUP_PRO 1
#endif
#ifndef DUP_NORM
#define DUP_NORM 1
#endif
#ifndef DUP_QKV
#define DUP_QKV 1
#endif
#ifndef DUP_ADP
#define DUP_ADP 1
#endif
#ifndef DUP_ADL
#define DUP_ADL 1
#endif
#ifndef DUP_ANP
#define DUP_ANP 1
#endif
#ifndef DUP_ANL
#define DUP_ANL 1
#endif
#ifndef DUP_FC1
#define DUP_FC1 1
#endif
#ifndef DUP_O
#define DUP_O 1
#endif
#ifndef DUP_FC2
#define DUP_FC2 1
#endif
#ifndef NS
#define NS 2
#endif
#ifndef STREAM_DELAY_US
#define STREAM_DELAY_US 0
#endif
#ifndef DUP_YST
#define DUP_YST 1
#endif
#ifndef XCC_MODE
#define XCC_MODE 1
#endif
#ifndef MICRO_PAT
#define MICRO_PAT 0
#endif
#ifndef MICRO_REP
#define MICRO_REP 4
#endif
#ifndef ABL_N1
#define ABL_N1 0
#endif
#ifndef KROT_ON
#define KROT_ON 0
#endif
#ifndef PROBE_KL
#define PROBE_KL 0
#endif
#ifndef PROBE_PH
#define PROBE_PH -1
#endif
#ifndef DUP_BAR
#define DUP_BAR 1
#endif
#ifndef EN_PRO
#define EN_PRO 1
#endif
#ifndef EN_NORM
#define EN_NORM 1
#endif
#ifndef EN_QKV
#define EN_QKV 1
#endif
#ifndef EN_ATT
#define EN_ATT 1
#endif
#ifndef EN_O
#define EN_O 1
#endif
#ifndef EN_FC1
#define EN_FC1 1
#endif
#ifndef EN_FC2
#define EN_FC2 1
#endif
#define LAS __attribute__((address_space(3)))
#define GAS __attribute__((address_space(1)))
typedef unsigned short bf16_t;
typedef short bf16x8 __attribute__((ext_vector_type(8)));
typedef short s16x4 __attribute__((ext_vector_type(4)));
typedef float f32x4 __attribute__((ext_vector_type(4)));
typedef float f32x2 __attribute__((ext_vector_type(2)));
typedef float f32x16 __attribute__((ext_vector_type(16)));
typedef unsigned u32x4 __attribute__((ext_vector_type(4)));
typedef unsigned u32x2 __attribute__((ext_vector_type(2)));
typedef __bf16 bf16x2_t __attribute__((ext_vector_type(2)));

constexpr int D = 1024, FF = 4096, DEPTH = 4;
constexpr int MP = 4096, M = 8192;
constexpr float EPS = 1e-6f;
constexpr float LOG2E = 1.4426950408889634f;
constexpr float C2 = 0.125f * LOG2E;
constexpr size_t OUT_Y = 0, OUT_DK = 8388608, OUT_DV = 16777216, OUT_NK = 25165824, OUT_NV = 33554432;

constexpr size_t MiB = 1u << 20;
constexpr size_t WS_CTL = 0, CTL_ZERO_BYTES = 128 * 1024;
constexpr size_t WS_MOD = 1 * MiB;
constexpr size_t WS_ROPE = WS_MOD + 512 * 1024;
constexpr size_t WS_LAM = WS_ROPE + 16 * 1024;
constexpr size_t WS_W = 2 * MiB;
constexpr size_t W_LAYER = 24 * MiB, W_QKV = 0, W_O = 6 * MiB, W_1 = 8 * MiB, W_2 = 16 * MiB;
constexpr size_t WS_CACHE = 98 * MiB;
constexpr size_t WS_XN = 114 * MiB, WS_Q = 130 * MiB, WS_K = 146 * MiB, WS_V = 162 * MiB, WS_O = 178 * MiB, WS_H = 194 * MiB, WS_SSQ = 258 * MiB  , WS_SW = 259 * MiB  , WS_END = 260 * MiB;
constexpr int CW_BAR = 1024, CW_XL = 16384;

constexpr int RING_BYTES = 147456;
constexpr int LDSCTL_OFF = RING_BYTES, MISC_OFF = LDSCTL_OFF + 320;
constexpr int LDS_BYTES = 148480;

__device__ __forceinline__ unsigned pk2(float lo, float hi) { f32x2 v = {lo, hi}; bf16x2_t b = __builtin_convertvector(v, bf16x2_t); return __builtin_bit_cast(unsigned, b); }
__device__ __forceinline__ float wave_sum(float v) {
#pragma unroll
    for (int o = 1; o < 64; o <<= 1) v += __shfl_xor(v, o);
    return v;
}
#ifndef WT_STORES
#define WT_STORES 0
#endif
__device__ __forceinline__ void st16(void* p, u32x4 v) {
#if WT_STORES
    asm volatile("global_store_dwordx4 %0, %1, off sc1\n\ts_nop 1" :: "v"(p), "v"(v) : "memory");
#else
    *(u32x4*)p = v;
#endif
}
__device__ __forceinline__ void st16f(void* p, f32x4 v) { st16(p, __builtin_bit_cast(u32x4, v)); }
__device__ __forceinline__ void st8(void* p, u32x2 v) {
#if WT_STORES
    asm volatile("global_store_dwordx2 %0, %1, off sc1\n\ts_nop 1" :: "v"(p), "v"(v) : "memory");
#else
    *(u32x2*)p = v;
#endif
}
__device__ __forceinline__ void st4f(float* p, float v) {
#if WT_STORES
    asm volatile("global_store_dword %0, %1, off sc1\n\ts_nop 1" :: "v"(p), "v"(v) : "memory");
#else
    *p = v;
#endif
}
#define LDS_WAIT() asm volatile("s_waitcnt lgkmcnt(0)" ::: "memory")
#define VM_WAIT() asm volatile("s_waitcnt vmcnt(0)" ::: "memory")

namespace pg8 {
constexpr int BM = 256, BK = 64, HALF = 128, HTB = HALF * BK * 2, NXCD = 8, WGM = 8;
__host__ __device__ __forceinline__ int lds_byte(int r, int c) { const int st = (r >> 4) * 2 + (c >> 5), rr = r & 15, cc = c & 31, ob = rr * 64 + cc * 2; return st * 1024 + (ob ^ (((ob >> 9) & 1) << 5)); }
__host__ __device__ __forceinline__ void stage_rc(int b, int& R, int& C) { const int st = b / 1024, sb = b % 1024, swz = sb ^ (((sb >> 9) & 1) << 5); R = (st >> 1) * 16 + swz / 64; C = (st & 1) * 32 + (swz % 64) / 2; }
__host__ __device__ __forceinline__ int perm32(int rho) { const int n = rho >> 4, i = rho & 15; return 8 * (i >> 2) + 4 * n + (i & 3); }

struct Unit { int pm, pn; };
struct Gemm { const bf16_t* A; const bf16_t* Bt; int K; unsigned long long* stamp; };

struct StaticOrder {
    int nN, half, pbase_p, pbase_s, lb;
    __device__ void init(int nN_, int strm, int lb_) { nN = nN_; half = 16 / NS; pbase_p = strm * half; pbase_s = 16 + strm * half; lb = lb_; }
    __device__ bool next(int i, Unit& u) const { const int pn = 8 * i + (lb & 7); if (pn >= nN) return false; const int pl = lb >> 3; u.pm = pl < half ? pbase_p + pl : pbase_s + (pl - half); u.pn = pn; return true; }
};

template <class Epi, int NB, bool ALIGN_EPI>
__device__ __forceinline__ void gemm_phase(LAS unsigned char* lds, const Gemm g, const StaticOrder& S, const Epi& E, const int tid) {
    const int wid = __builtin_amdgcn_readfirstlane(tid >> 6), lane = tid & 63, wr = wid >> 2, wc = wid & 3, fr = lane & 15, fq = lane >> 4;
    const int K = g.K, nt = K / BK;
    unsigned voffA[2], voffB[2];
#pragma unroll
    for (int i = 0; i < 2; ++i) { int R, C; stage_rc(tid * 16 + i * 8192, R, C); const int Rb = Epi::PERM ? ((R & ~31) + perm32(R & 31)) : R;
        voffA[i] = (unsigned)(R * K + C) * 2u; voffB[i] = (unsigned)(Rb * K + C) * 2u; }
    const size_t kstep = (size_t)(BK * 2);
    const size_t hstep = (size_t)HALF * K * 2;
    const size_t tstepA = 2 * hstep, tstepB = NB * hstep;
    const unsigned ldsw = (unsigned)wid * 1024u;
    const int aoff = lds_byte(wr * 64 + fr, fq * 8), boff = lds_byte(wc * 32 + fr, fq * 8);
#define PG8_SA(b, h) (((b) * 2 + (h)) * HTB)
#define PG8_SB(b, h) ((4 + (b) * 2 + (h)) * HTB)
#define PG8_STAGE(bufoff, gbase, voff) do { _Pragma("unroll") for (int _i = 0; _i < 2; ++_i) \
        __builtin_amdgcn_global_load_lds((const unsigned*)((const char*)(gbase) + (voff)[_i]), (LAS unsigned*)(lds + (bufoff) + ldsw + _i * 8192), 16, 0, 0); } while (0)
#define PG8_LDA(dst, b, h) do { _Pragma("unroll") for (int m = 0; m < 4; ++m) _Pragma("unroll") for (int k = 0; k < 2; ++k) dst[m][k] = *(const LAS bf16x8*)(lds + PG8_SA(b, h) + aoff + m * 2048 + k * 1024); } while (0)
#define PG8_LDB(dst, b, h) do { _Pragma("unroll") for (int n = 0; n < 2; ++n) _Pragma("unroll") for (int k = 0; k < 2; ++k) dst[n][k] = *(const LAS bf16x8*)(lds + PG8_SB(b, h) + boff + n * 2048 + k * 1024); } while (0)
#define PG8_MMA(ai, bj, At, Bt) do { __builtin_amdgcn_s_setprio(1); _Pragma("unroll") for (int m = 0; m < 4; ++m) _Pragma("unroll") for (int n = 0; n < 2; ++n) _Pragma("unroll") for (int k = 0; k < 2; ++k) \
        acc[ai][bj][m][n] = __builtin_amdgcn_mfma_f32_16x16x32_bf16(Bt[n][k], At[m][k], acc[ai][bj][m][n], 0, 0, 0); __builtin_amdgcn_s_setprio(0); } while (0)
#define PG8_WAIT_V(n) asm volatile("s_waitcnt vmcnt(" #n ")" ::: "memory")
#define PG8_WAIT_L(n) asm volatile("s_waitcnt lgkmcnt(" #n ")" ::: "memory")
#define PG8_BAR __builtin_amdgcn_s_barrier()
#define PG8_SCHED __builtin_amdgcn_sched_barrier(0)
    Unit cur, nxt; int ui = 0;
    if (!S.next(0, cur)) return;
    f32x4 acc[2][NB][4][2];
#pragma unroll
    for (int a = 0; a < 2; ++a)
#pragma unroll
        for (int b = 0; b < NB; ++b)
#pragma unroll
            for (int m = 0; m < 4; ++m)
#pragma unroll
                for (int n = 0; n < 2; ++n) acc[a][b][m][n] = (f32x4){0.f, 0.f, 0.f, 0.f};
    bf16x8 At[4][2], B0[2][2], B1[2][2];
    const char* cA = (const char*)g.A + (size_t)cur.pm * tstepA; const char* cB = (const char*)g.Bt + (size_t)cur.pn * tstepB;
    if constexpr (NB == 2) {
        PG8_STAGE(PG8_SB(0, 0), cB, voffB); PG8_STAGE(PG8_SB(0, 1), cB + hstep, voffB); PG8_STAGE(PG8_SA(0, 0), cA, voffA); PG8_STAGE(PG8_SA(0, 1), cA + hstep, voffA);
        if (wr == 1) PG8_BAR;
        PG8_WAIT_V(2); PG8_BAR;
        PG8_STAGE(PG8_SB(1, 0), cB + kstep, voffB); PG8_STAGE(PG8_SA(1, 0), cA + kstep, voffA); PG8_STAGE(PG8_SB(1, 1), cB + hstep + kstep, voffB);
        PG8_WAIT_V(6); PG8_BAR;
    } else {
        PG8_STAGE(PG8_SB(0, 0), cB, voffB); PG8_STAGE(PG8_SA(0, 0), cA, voffA); PG8_STAGE(PG8_SA(0, 1), cA + hstep, voffA);
        if (wr == 1) PG8_BAR;
        PG8_WAIT_V(2); PG8_BAR;
        PG8_STAGE(PG8_SB(1, 0), cB + kstep, voffB); PG8_STAGE(PG8_SA(1, 0), cA + kstep, voffA);
        PG8_WAIT_V(4); PG8_BAR;
    }
    for (;;) {
        const bool has_next = S.next(ui + 1, nxt);
        const char* nA = has_next ? (const char*)g.A + (size_t)nxt.pm * tstepA : cA; const char* nB = has_next ? (const char*)g.Bt + (size_t)nxt.pn * tstepB : cB;
        for (int t = 0; t < nt; t += 2) {
            const bool last = (t == nt - 2);
            const char* a1 = cA + (size_t)(t + 1) * kstep;
            const char* a2 = last ? nA : cA + (size_t)(t + 2) * kstep; const char* b2 = last ? nB : cB + (size_t)(t + 2) * kstep;
            const char* a3 = a2 + kstep; const char* b3 = b2 + kstep;
            if constexpr (NB == 2) {
            PG8_LDB(B0, 0, 0); PG8_LDB(B1, 0, 1); PG8_SCHED; PG8_LDA(At, 0, 0); PG8_STAGE(PG8_SA(1, 1), a1 + hstep, voffA);
            PG8_WAIT_V(8); PG8_WAIT_L(0); PG8_BAR; PG8_MMA(0, 0, At, B0); PG8_MMA(0, 1, At, B1); PG8_BAR; PG8_SCHED;
            PG8_LDA(At, 0, 1); PG8_STAGE(PG8_SB(0, 0), b2, voffB); PG8_STAGE(PG8_SB(0, 1), b2 + hstep, voffB); PG8_STAGE(PG8_SA(0, 0), a2, voffA);
            PG8_WAIT_V(8); PG8_WAIT_L(0); PG8_BAR; PG8_MMA(1, 0, At, B0); PG8_MMA(1, 1, At, B1); PG8_BAR; PG8_SCHED;
            PG8_LDB(B0, 1, 0); PG8_LDB(B1, 1, 1); PG8_SCHED; PG8_LDA(At, 1, 0); PG8_STAGE(PG8_SA(0, 1), a2 + hstep, voffA);
            PG8_WAIT_V(8); PG8_WAIT_L(0); PG8_BAR; PG8_MMA(0, 0, At, B0); PG8_MMA(0, 1, At, B1); PG8_BAR; PG8_SCHED;
            PG8_LDA(At, 1, 1); PG8_STAGE(PG8_SB(1, 0), b3, voffB); PG8_STAGE(PG8_SB(1, 1), b3 + hstep, voffB); PG8_STAGE(PG8_SA(1, 0), a3, voffA);
            PG8_WAIT_V(8); PG8_WAIT_L(0); PG8_BAR; PG8_MMA(1, 0, At, B0); PG8_MMA(1, 1, At, B1); PG8_BAR; PG8_SCHED;
            } else {
            PG8_LDB(B0, 0, 0); PG8_SCHED; PG8_LDA(At, 0, 0); PG8_STAGE(PG8_SA(1, 1), a1 + hstep, voffA);
            PG8_WAIT_V(6); PG8_WAIT_L(0); PG8_BAR; PG8_MMA(0, 0, At, B0); PG8_BAR; PG8_SCHED;
            PG8_LDA(At, 0, 1); PG8_STAGE(PG8_SB(0, 0), b2, voffB); PG8_STAGE(PG8_SA(0, 0), a2, voffA);
            PG8_WAIT_V(6); PG8_WAIT_L(0); PG8_BAR; PG8_MMA(1, 0, At, B0); PG8_BAR; PG8_SCHED;
            PG8_LDB(B0, 1, 0); PG8_SCHED; PG8_LDA(At, 1, 0); PG8_STAGE(PG8_SA(0, 1), a2 + hstep, voffA);
            PG8_WAIT_V(6); PG8_WAIT_L(0); PG8_BAR; PG8_MMA(0, 0, At, B0); PG8_BAR; PG8_SCHED;
            PG8_LDA(At, 1, 1); PG8_STAGE(PG8_SB(1, 0), b3, voffB); PG8_STAGE(PG8_SA(1, 0), a3, voffA);
            PG8_WAIT_V(6); PG8_WAIT_L(0); PG8_BAR; PG8_MMA(1, 0, At, B0); PG8_BAR; PG8_SCHED;
            }
        }
        if (PROBE_KL && blockIdx.x == 0 && tid == 0) *(volatile unsigned long long*)g.stamp = __builtin_amdgcn_s_memrealtime();
        if constexpr (ALIGN_EPI) { if (wr == 0) PG8_BAR; }
        E(acc, cur, wr, wc, fr, fq);
        if (!has_next) break;
#pragma unroll
        for (int a = 0; a < 2; ++a)
#pragma unroll
            for (int b = 0; b < NB; ++b)
#pragma unroll
                for (int m = 0; m < 4; ++m)
#pragma unroll
                    for (int n = 0; n < 2; ++n) acc[a][b][m][n] = (f32x4){0.f, 0.f, 0.f, 0.f};
        cur = nxt; cA = nA; cB = nB; ++ui;
        if constexpr (ALIGN_EPI) { if (wr == 1) PG8_BAR; }
    }
    PG8_WAIT_V(0);
    if constexpr (!ALIGN_EPI) { if (wr == 0) PG8_BAR; }
    PG8_BAR;
#undef PG8_SA
#undef PG8_SB
#undef PG8_STAGE
#undef PG8_LDA
#undef PG8_LDB
#undef PG8_MMA
#undef PG8_WAIT_V
#undef PG8_WAIT_L
#undef PG8_BAR
#undef PG8_SCHED
}

template <class Epi, bool ALIGN_EPI, int ABL = 0>
__device__ __forceinline__ void gemm_phase_n1(LAS unsigned char* lds, const Gemm g, const StaticOrder& S, const Epi& E, const int tid) {
    const int wid = __builtin_amdgcn_readfirstlane(tid >> 6), lane = tid & 63, wr = wid >> 2, wc = wid & 3, fr = lane & 15, fq = lane >> 4;
    const int K = g.K, nt = K / BK;
    unsigned voffA[2], voffB[2];
#pragma unroll
    for (int i = 0; i < 2; ++i) { int R, C; stage_rc(tid * 16 + i * 8192, R, C); const int Rb = Epi::PERM ? ((R & ~31) + perm32(R & 31)) : R;
        voffA[i] = (unsigned)(R * K + C) * 2u; voffB[i] = (unsigned)(Rb * K + C) * 2u; }
    const size_t kstep = (size_t)(BK * 2);
    const size_t hstep = (size_t)HALF * K * 2;
    const size_t tstepA = 2 * hstep, tstepB = hstep;
    const unsigned ldsw = (unsigned)wid * 1024u;
    const int aoff = lds_byte(wr * 64 + fr, fq * 8), boff = lds_byte(wc * 32 + fr, fq * 8);
    constexpr int BUF3 = 3 * HTB;
#define N1_STAGE1(bufoff, gbase, voff) do { _Pragma("unroll") for (int _i = 0; _i < 2; ++_i) \
        __builtin_amdgcn_global_load_lds((const unsigned*)((const char*)(gbase) + (voff)[_i]), (LAS unsigned*)(lds + (bufoff) + ldsw + _i * 8192), 16, 0, 0); } while (0)
#define N1_STAGE3(c, pa, pb) do { N1_STAGE1((c) * BUF3, pb, voffB); N1_STAGE1((c) * BUF3 + HTB, pa, voffA); N1_STAGE1((c) * BUF3 + 2 * HTB, (pa) + hstep, voffA); } while (0)
#define N1_LDA(dst, c, h) do { _Pragma("unroll") for (int m = 0; m < 4; ++m) _Pragma("unroll") for (int k = 0; k < 2; ++k) dst[m][k] = *(const LAS bf16x8*)(lds + (c) * BUF3 + (1 + (h)) * HTB + aoff + m * 2048 + k * 1024); } while (0)
#define N1_LDB(dst, c) do { _Pragma("unroll") for (int n = 0; n < 2; ++n) _Pragma("unroll") for (int k = 0; k < 2; ++k) dst[n][k] = *(const LAS bf16x8*)(lds + (c) * BUF3 + boff + n * 2048 + k * 1024); } while (0)
#define N1_MMA(ai, At, Bt) do { _Pragma("unroll") for (int m = 0; m < 4; ++m) _Pragma("unroll") for (int n = 0; n < 2; ++n) _Pragma("unroll") for (int k = 0; k < 2; ++k) \
        acc[ai][0][m][n] = __builtin_amdgcn_mfma_f32_16x16x32_bf16(Bt[n][k], At[m][k], acc[ai][0][m][n], 0, 0, 0); } while (0)
#define N1_WAIT_V(n) asm volatile("s_waitcnt vmcnt(" #n ")" ::: "memory")
#define N1_WAIT_L(n) asm volatile("s_waitcnt lgkmcnt(" #n ")" ::: "memory")
#define N1_BAR __builtin_amdgcn_s_barrier()
#define N1_SCHED __builtin_amdgcn_sched_barrier(0)
    Unit cur, nxt; int ui = 0;
    if (!S.next(0, cur)) return;
    f32x4 acc[2][1][4][2];
#pragma unroll
    for (int a = 0; a < 2; ++a)
#pragma unroll
        for (int m = 0; m < 4; ++m)
#pragma unroll
            for (int n = 0; n < 2; ++n) acc[a][0][m][n] = (f32x4){0.f, 0.f, 0.f, 0.f};
    bf16x8 At0[4][2], At1[4][2], B0[2][2];
    const char* cA = (const char*)g.A + (size_t)cur.pm * tstepA; const char* cB = (const char*)g.Bt + (size_t)cur.pn * tstepB;
    typename Epi::Pre pre; E.pre_load(pre, cur, wr, wc, fr, fq);
#define KROT(u) (KROT_ON ? ((((u).pn & 7) + 8 * ((u).pm & 3)) * nt / 32) : 0)
    int rot = KROT(cur);
    N1_STAGE3(0, cA + (size_t)(rot & (nt - 1)) * kstep, cB + (size_t)(rot & (nt - 1)) * kstep); N1_STAGE3(1, cA + (size_t)((rot + 1) & (nt - 1)) * kstep, cB + (size_t)((rot + 1) & (nt - 1)) * kstep);
    if (wr == 1) N1_BAR;
    N1_WAIT_V(6); N1_BAR;
    N1_BAR;
    int c0 = 0;
    for (;;) {
        const bool has_next = S.next(ui + 1, nxt);
        const char* nA = has_next ? (const char*)g.A + (size_t)nxt.pm * tstepA : cA; const char* nB = has_next ? (const char*)g.Bt + (size_t)nxt.pn * tstepB : cB;
        const int nrot = has_next ? KROT(nxt) : rot;
        for (int t = 0; t < nt; ++t) {
            const bool tail = (t + 2 >= nt);
            const int kt = tail ? ((t + 2 - nt + nrot) & (nt - 1)) : ((t + 2 + rot) & (nt - 1));
            const char* sa = (tail ? nA : cA) + (size_t)kt * kstep;
            const char* sb = (tail ? nB : cB) + (size_t)kt * kstep;
            const int c2 = (c0 == 0) ? 2 : c0 - 1;
            N1_LDB(B0, c0); N1_SCHED; N1_LDA(At0, c0, 0); if (!(ABL == 1)) { N1_LDA(At1, c0, 1); } if (ABL == 5) { N1_STAGE1((c2) * BUF3, sb, voffB); N1_STAGE1((c2) * BUF3 + HTB, sa, voffA); } else if (ABL == 6) { N1_STAGE1((c2) * BUF3, sb, voffB); } else if (ABL == 7) { } else if (ABL != 4) { N1_STAGE3(c2, sa, sb); } else { N1_STAGE1((c2) * BUF3, sb, voffB); N1_STAGE1((c2) * BUF3 + HTB, sa, voffA); N1_STAGE1((c2) * BUF3 + 2 * HTB, sa, voffA); }
            if (ABL == 5) N1_WAIT_V(4); else if (ABL == 6) N1_WAIT_V(2); else if (ABL == 7) N1_WAIT_V(0); else N1_WAIT_V(6); N1_WAIT_L(0); N1_BAR;
            __builtin_amdgcn_s_setprio(1); N1_MMA(0, At0, B0); if (ABL == 1) { N1_MMA(1, At0, B0); } else if (ABL != 3) { N1_MMA(1, At1, B0); } __builtin_amdgcn_s_setprio(0);
            N1_BAR; N1_SCHED;
            c0 = (c0 == 2) ? 0 : c0 + 1;
        }
        if (PROBE_KL && blockIdx.x == 0 && tid == 0) *(volatile unsigned long long*)g.stamp = __builtin_amdgcn_s_memrealtime();
        if constexpr (ALIGN_EPI) { if (wr == 0) N1_BAR; }
        E(acc, pre, cur, wr, wc, fr, fq);
        if (!has_next) break;
#pragma unroll
        for (int a = 0; a < 2; ++a)
#pragma unroll
            for (int m = 0; m < 4; ++m)
#pragma unroll
                for (int n = 0; n < 2; ++n) acc[a][0][m][n] = (f32x4){0.f, 0.f, 0.f, 0.f};
        cur = nxt; cA = nA; cB = nB; ++ui; rot = nrot;
        E.pre_load(pre, cur, wr, wc, fr, fq);
        if constexpr (ALIGN_EPI) { if (wr == 1) N1_BAR; }
    }
    N1_WAIT_V(0);
    if constexpr (!ALIGN_EPI) { if (wr == 0) N1_BAR; }
    N1_BAR;
#undef N1_STAGE1
#undef N1_STAGE3
#undef N1_LDA
#undef N1_LDB
#undef N1_MMA
#undef N1_WAIT_V
#undef N1_WAIT_L
#undef N1_BAR
#undef N1_SCHED
#undef KROT
}

__device__ __forceinline__ int cond_of_pm(int pm) { return pm < 16 ? 0 : 1 + ((pm - 16) >> 2); }
__device__ __forceinline__ void row_rstd8(float (&rr)[2][4], const float* ssq, int row0  , int fq) {
#pragma unroll
    for (int ai = 0; ai < 2; ++ai) {
        f32x4 a[4], b[4];
#pragma unroll
        for (int m = 0; m < 4; ++m) { const float* p = ssq + (size_t)(row0 + ai * HALF + m * 16) * 32 + 8 * fq; a[m] = *(const f32x4*)p; b[m] = *(const f32x4*)(p + 4); }
#pragma unroll
        for (int m = 0; m < 4; ++m) { float s = ((a[m][0] + a[m][1]) + (a[m][2] + a[m][3])) + ((b[m][0] + b[m][1]) + (b[m][2] + b[m][3]));
            s += __shfl_xor(s, 16); s += __shfl_xor(s, 32); rr[ai][m] = rsqrtf(s * (1.f / 1024.f) + EPS); }
        asm volatile("" ::: "memory");
    }
}
__device__ __forceinline__ float row_rstd(const float* ssq, int row, int fq) {
    const f32x4 a = *(const f32x4*)(ssq + (size_t)row * 32 + 8 * fq), b = *(const f32x4*)(ssq + (size_t)row * 32 + 8 * fq + 4);
    float s = ((a[0] + a[1]) + (a[2] + a[3])) + ((b[0] + b[1]) + (b[2] + b[3]));
    s += __shfl_xor(s, 16); s += __shfl_xor(s, 32);
    return rsqrtf(s * (1.f / 1024.f) + EPS);
}

struct EpiQK {
    static constexpr bool PERM = false;
    unsigned char* ws; const float* qg; const float* kg; float* outk; int layer; bool use_rope;
    __device__ __forceinline__ void operator()(const f32x4 (&acc)[2][2][4][2], const Unit& u, int wr, int wc, int fr, int fq) const {
        bf16_t* Q = (bf16_t*)(ws + WS_Q); bf16_t* Kb = (bf16_t*)(ws + WS_K); const float* rope = use_rope ? (const float*)(ws + WS_ROPE) : nullptr;
        const float* ssq = (const float*)(ws + WS_SSQ); const float* sw = (const float*)(ws + WS_SW) + (size_t)layer * 5 * 7168;
        const bool isk = u.pn >= 4; const int G = (u.pn & 3) * 4 + wc;
        const float* swp = sw + cond_of_pm(u.pm) * 7168 + u.pn * 256 + wc * 32 + 4 * fq;
        const float* g = isk ? kg : qg; bf16_t* dst = isk ? Kb : Q; const float sc = isk ? 1.f : C2;
        const bool prompt = u.pm < 16; const bool do_rope = (rope != nullptr) && !prompt;
        f32x4 gv[2][2];
#pragma unroll
        for (int bj = 0; bj < 2; ++bj)
#pragma unroll
            for (int n = 0; n < 2; ++n) gv[bj][n] = *(const f32x4*)(g + 32 * bj + 16 * n + 4 * fq);
        float rr[2][4]; row_rstd8(rr, ssq, u.pm * BM + wr * 64 + fr, fq);
#pragma unroll
        for (int ai = 0; ai < 2; ++ai)
#pragma unroll
            for (int m = 0; m < 4; ++m) {
                const int row = u.pm * BM + ai * HALF + wr * 64 + m * 16 + fr;
                const float rrow = rr[ai][m];
                f32x4 x[2][2];
                float ss = 0.f;
#pragma unroll
                for (int bj = 0; bj < 2; ++bj)
#pragma unroll
                    for (int n = 0; n < 2; ++n) { const f32x4 xx = acc[ai][bj][m][n] * rrow + *(const f32x4*)(swp + 128 * bj + 16 * n); x[bj][n] = xx; ss += (xx[0] * xx[0] + xx[1] * xx[1]) + (xx[2] * xx[2] + xx[3] * xx[3]); }
                ss += __shfl_xor(ss, 16); ss += __shfl_xor(ss, 32);
                const float rstd = rsqrtf(ss * (1.f / 64.f) + EPS);
#pragma unroll
                for (int bj = 0; bj < 2; ++bj)
#pragma unroll
                    for (int n = 0; n < 2; ++n) x[bj][n] = x[bj][n] * rstd * gv[bj][n];
                if (do_rope) {
                    const int t = (row - MP) & 1023;
#pragma unroll
                    for (int bj = 0; bj < 2; ++bj) {
                        const int pos = bj == 0 ? (t >> 6) : (t & 63);
                        const f32x4 cs01 = *(const f32x4*)(rope + (pos * 16 + 4 * fq) * 2), cs23 = *(const f32x4*)(rope + (pos * 16 + 4 * fq) * 2 + 4);
                        const float cc[4] = {cs01[0], cs01[2], cs23[0], cs23[2]}, sn[4] = {cs01[1], cs01[3], cs23[1], cs23[3]};
#pragma unroll
                        for (int e = 0; e < 4; ++e) { const float x0 = x[bj][0][e], x1 = x[bj][1][e]; x[bj][0][e] = x0 * cc[e] - x1 * sn[e]; x[bj][1][e] = x1 * cc[e] + x0 * sn[e]; }
                    }
                }
                bf16_t* rp = dst + (size_t)row * D + 64 * G + 8 * fq;
#pragma unroll
                for (int bj = 0; bj < 2; ++bj) { const f32x4 v0 = x[bj][0] * sc, v1 = x[bj][1] * sc;
                    u32x4 w; w.x = pk2(v0[0], v0[1]); w.y = pk2(v0[2], v0[3]); w.z = pk2(v1[0], v1[1]); w.w = pk2(v1[2], v1[3]);
                    st16(rp + 32 * bj, w); }
            }
    }
};
struct EpiV {
    static constexpr bool PERM = true;
    bf16_t* V; float* outv; const float* ssq; const float* sw;
    struct Pre {};
    __device__ __forceinline__ void pre_load(Pre&, const Unit&, int, int, int, int) const {}
    __device__ __forceinline__ void operator()(const f32x4 (&acc)[2][1][4][2], const Pre&, const Unit& u, int wr, int wc, int fr, int fq) const {
        const int col0 = u.pn * HALF + wc * 32 + 8 * fq; const bool prompt = u.pm < 16;
        const float* swp = sw + cond_of_pm(u.pm) * 7168 + 2048 + col0; const f32x4 s0 = *(const f32x4*)swp, s1 = *(const f32x4*)(swp + 4);
        float rr[2][4]; row_rstd8(rr, ssq, u.pm * BM + wr * 64 + fr, fq);
#pragma unroll
        for (int ai = 0; ai < 2; ++ai)
#pragma unroll
            for (int m = 0; m < 4; ++m) {
                const int row = u.pm * BM + ai * HALF + wr * 64 + m * 16 + fr;
                const float rrow = rr[ai][m];
                const f32x4 v0 = acc[ai][0][m][0] * rrow + s0, v1 = acc[ai][0][m][1] * rrow + s1;
                u32x4 w; w.x = pk2(v0[0], v0[1]); w.y = pk2(v0[2], v0[3]); w.z = pk2(v1[0], v1[1]); w.w = pk2(v1[2], v1[3]);
                st16(V + (size_t)row * D + col0, w);
            }
    }
};
struct EpiResid {
    static constexpr bool PERM = true;
    const float* resid_p; const float* resid_s; float* out; const float* gate;
    const float* gnorm; const float* scale; bf16_t* XN; float* ssq;
    struct Pre { f32x4 rv[4][2]; };
    __device__ __forceinline__ void pre_load(Pre& p, const Unit& u, int wr, int wc, int fr, int fq) const {
        const int col0 = u.pn * HALF + wc * 32 + 8 * fq;
        const float* src = u.pm < 16 ? resid_p + (size_t)u.pm * BM * D : resid_s + (size_t)(u.pm - 16) * BM * D;
#pragma unroll
        for (int m = 0; m < 4; ++m) { const size_t off = (size_t)(wr * 64 + m * 16 + fr) * D + col0; p.rv[m][0] = *(const f32x4*)(src + off); p.rv[m][1] = *(const f32x4*)(src + off + 4); }
    }
    __device__ __forceinline__ void operator()(const f32x4 (&acc)[2][1][4][2], const Pre& p, const Unit& u, int wr, int wc, int fr, int fq) const {
        const int col0 = u.pn * HALF + wc * 32 + 8 * fq; const int cond = cond_of_pm(u.pm);
        const float* gp = gate + cond * 6144 + col0;
        const f32x4 g0 = *(const f32x4*)gp, g1 = *(const f32x4*)(gp + 4);
        f32x4 gs0 = (f32x4){0.f, 0.f, 0.f, 0.f}, gs1 = gs0;
        if (XN) { const float* sp = scale + cond * 6144 + col0; gs0 = *(const f32x4*)(gnorm + col0) * (1.f + *(const f32x4*)sp); gs1 = *(const f32x4*)(gnorm + col0 + 4) * (1.f + *(const f32x4*)(sp + 4)); }
        float* dstb = out + (size_t)u.pm * BM * D;
        const float* src = u.pm < 16 ? resid_p + (size_t)u.pm * BM * D : resid_s + (size_t)(u.pm - 16) * BM * D;
        f32x4 rv1[4][2];
#pragma unroll
        for (int m = 0; m < 4; ++m) { const size_t off = (size_t)(HALF + wr * 64 + m * 16 + fr) * D + col0; rv1[m][0] = *(const f32x4*)(src + off); rv1[m][1] = *(const f32x4*)(src + off + 4); }
#pragma unroll
        for (int ai = 0; ai < 2; ++ai)
#pragma unroll
            for (int m = 0; m < 4; ++m) {
                const int rl = ai * HALF + wr * 64 + m * 16 + fr;
                const size_t off = (size_t)rl * D + col0;
                const f32x4 r0 = ai == 0 ? p.rv[m][0] : rv1[m][0], r1 = ai == 0 ? p.rv[m][1] : rv1[m][1];
                const f32x4 y0 = r0 + g0 * acc[ai][0][m][0], y1 = r1 + g1 * acc[ai][0][m][1];
                for (int d_ = 0; d_ < DUP_YST; ++d_) { st16f(dstb + off, y0); st16f(dstb + off + 4, y1); asm volatile("" ::: "memory"); }
                if (XN) {
                    const f32x4 a0 = y0 * gs0, a1 = y1 * gs1;
                    u32x4 w; w.x = pk2(a0[0], a0[1]); w.y = pk2(a0[2], a0[3]); w.z = pk2(a1[0], a1[1]); w.w = pk2(a1[2], a1[3]);
                    st16(XN + (size_t)u.pm * BM * D + off, w);
                    float ss = ((y0[0] * y0[0] + y0[1] * y0[1]) + (y0[2] * y0[2] + y0[3] * y0[3])) + ((y1[0] * y1[0] + y1[1] * y1[1]) + (y1[2] * y1[2] + y1[3] * y1[3]));
                    ss += __shfl_xor(ss, 16); ss += __shfl_xor(ss, 32);
                    if (fq == 0) st4f(ssq + (size_t)(u.pm * BM + rl) * 32 + u.pn * 4 + wc, ss);
                }
            }
    }
};
struct EpiRelu2 {
    static constexpr bool PERM = true;
    bf16_t* H; const float* ssq; const float* sw;
    __device__ __forceinline__ void operator()(const f32x4 (&acc)[2][2][4][2], const Unit& u, int wr, int wc, int fr, int fq) const {
        const int col0 = u.pn * BM + wc * 32 + 8 * fq;
        const float* swp = sw + cond_of_pm(u.pm) * 7168 + 3072 + col0;
        f32x4 sv[2][2];
#pragma unroll
        for (int bj = 0; bj < 2; ++bj) { sv[bj][0] = *(const f32x4*)(swp + bj * HALF); sv[bj][1] = *(const f32x4*)(swp + bj * HALF + 4); }
        float rr[2][4]; row_rstd8(rr, ssq, u.pm * BM + wr * 64 + fr, fq);
#pragma unroll
        for (int ai = 0; ai < 2; ++ai)
#pragma unroll
            for (int m = 0; m < 4; ++m) {
                const int row = u.pm * BM + ai * HALF + wr * 64 + m * 16 + fr;
                const float rrow = rr[ai][m];
                bf16_t* rp = H + (size_t)row * FF + col0;
#pragma unroll
                for (int bj = 0; bj < 2; ++bj) {
                    f32x4 v0 = acc[ai][bj][m][0] * rrow + sv[bj][0], v1 = acc[ai][bj][m][1] * rrow + sv[bj][1];
#pragma unroll
                    for (int e = 0; e < 4; ++e) { const float a = fmaxf(v0[e], 0.f), b = fmaxf(v1[e], 0.f); v0[e] = a * a; v1[e] = b * b; }
                    u32x4 w; w.x = pk2(v0[0], v0[1]); w.y = pk2(v0[2], v0[3]); w.z = pk2(v1[0], v1[1]); w.w = pk2(v1[2], v1[3]);
                    st16(rp + bj * HALF, w); }
            }
    }
};
}

namespace att {
constexpr float THR = 8.f, NEG = -1e30f;
__device__ __forceinline__ int crow(int r, int hi) { return (r & 3) + 8 * (r >> 2) + 4 * hi; }
__device__ __forceinline__ s16x4 vtr(const LAS char* p) { return __builtin_bit_cast(s16x4, __builtin_amdgcn_ds_read_tr16_b64_v4i16((LAS s16x4*)p)); }

struct Seg { const bf16_t* K1; const bf16_t* V1; int nt1; const bf16_t* K2; const bf16_t* V2; int nt2; };

template <bool DIFF, bool NA>
__device__ __forceinline__ void attn_unit(const int tid, LAS unsigned char* lds, const bf16_t* Qw  , const Seg sg, bf16_t* Ow  ,
                                          int kr_lo, int r_q, int jj, const float* relb  ,
                                          float lam, float post_scale, const float* subg,
                                          float* fk, float* fv) {
    constexpr int KW = DIFF ? 256 : 128, VW = DIFF ? 256 : 128, KS = KW + 16, VS = VW + 64, KBY = 64 * KS, VBY = 64 * VS;
    constexpr int DVB = DIFF ? 4 : 2, KC = DIFF ? 2 : 1;
    constexpr int VOFF = 2 * KBY, WSF_OFF = VOFF + 3 * VBY, BIAS_OFF = WSF_OFF + 2048, OST_OFF = BIAS_OFF + 2048;
    const int lane = tid & 63, l31 = lane & 31, hi = lane >> 5; const int wid = __builtin_amdgcn_readfirstlane(tid >> 6);
    const int mp = DIFF ? (wid >> 2) : 0; const bool grpB = wid >= 4;
    LAS float* wsf = (LAS float*)(lds + WSF_OFF) + wid * 64;
    LAS float* biasl = (LAS float*)(lds + BIAS_OFF);
    const int nt = sg.nt1 + sg.nt2;
    u32x4 st[KC];
#define SROW(i) ((tid + 512 * (i)) / (KW / 16))
#define SCH(i) ((tid + 512 * (i)) % (KW / 16))
#define ATT_LOADK(t) do { const bf16_t* kb_ = (t) < sg.nt1 ? sg.K1 + (size_t)(t) * 64 * D : sg.K2 + (size_t)((t) - sg.nt1) * 64 * D; \
        _Pragma("unroll") for (int i = 0; i < KC; ++i) st[i] = *(const u32x4*)(kb_ + (size_t)SROW(i) * D + SCH(i) * 8); } while (0)
#define ATT_LOADV(t) do { const bf16_t* vb_ = (t) < sg.nt1 ? sg.V1 + (size_t)(t) * 64 * D : sg.V2 + (size_t)((t) - sg.nt1) * 64 * D; \
        _Pragma("unroll") for (int i = 0; i < KC; ++i) st[i] = *(const u32x4*)(vb_ + (size_t)SROW(i) * D + SCH(i) * 8); } while (0)
#define BF2F_LO(w) __uint_as_float((w) << 16)
#define BF2F_HI(w) __uint_as_float((w) & 0xffff0000u)
#define ATT_STOREK(kb, tt) do { asm volatile("s_waitcnt vmcnt(0)" ::: "memory"); _Pragma("unroll") for (int i = 0; i < KC; ++i) *(LAS u32x4*)(lds + (kb) * KBY + SROW(i) * KS + SCH(i) * 16) = st[i]; \
        if (fk) { _Pragma("unroll") for (int i = 0; i < KC; ++i) { const int ch_ = SCH(i), c8_ = ch_ & 7; float* p_ = fk + (size_t)((tt) * 64 + SROW(i)) * 1024 + (ch_ >> 3) * 64 + 32 * (c8_ >> 2) + 4 * (c8_ & 3); \
            st16f(p_, (f32x4){BF2F_LO(st[i].x), BF2F_HI(st[i].x), BF2F_LO(st[i].y), BF2F_HI(st[i].y)}); st16f(p_ + 16, (f32x4){BF2F_LO(st[i].z), BF2F_HI(st[i].z), BF2F_LO(st[i].w), BF2F_HI(st[i].w)}); } } } while (0)
#define ATT_STOREV(vb, tt) do { asm volatile("s_waitcnt vmcnt(0)" ::: "memory"); _Pragma("unroll") for (int i = 0; i < KC; ++i) *(LAS u32x4*)(lds + VOFF + (vb) * VBY + SROW(i) * VS + SCH(i) * 16) = st[i]; \
        if (fv) { _Pragma("unroll") for (int i = 0; i < KC; ++i) { float* p_ = fv + (size_t)((tt) * 64 + SROW(i)) * 1024 + 8 * SCH(i); \
            st16f(p_, (f32x4){BF2F_LO(st[i].x), BF2F_HI(st[i].x), BF2F_LO(st[i].y), BF2F_HI(st[i].y)}); st16f(p_ + 4, (f32x4){BF2F_LO(st[i].z), BF2F_HI(st[i].z), BF2F_LO(st[i].w), BF2F_HI(st[i].w)}); } } } while (0)
#define ATT_BAR() do { asm volatile("s_waitcnt lgkmcnt(0)" ::: "memory"); __builtin_amdgcn_s_barrier(); asm volatile("" ::: "memory"); } while (0)
    ATT_LOADK(0);
    if (NA) { for (int i = tid; i < 465; i += 512) biasl[i] = relb[i] * LOG2E; }
    bf16x8 qf[4];
#pragma unroll
    for (int d0 = 0; d0 < 4; ++d0) qf[d0] = *(const bf16x8*)(Qw + (size_t)l31 * D + d0 * 16 + hi * 8);
    f32x16 o[DVB];
#pragma unroll
    for (int i = 0; i < DVB; ++i) o[i] = f32x16{};
    float mrun = NEG, lsum = 0.f;
    ATT_STOREK(0, 0); ATT_LOADV(0); ATT_STOREV(0, 0);
    ATT_BAR();
    const int rs_q = NA ? min(max(r_q - 4, 0), 8) : 0;
    const int cq = 32 * jj + l31, cs = min(max(cq - 8, 0), 48);
    const int kvoff = VOFF + (4 * hi + ((lane & 15) >> 2)) * VS + ((lane >> 4) & 1) * 32 + (lane & 3) * 8;
    bf16x8 pa[2][2];
#define ATT_QKS(t) do { \
        const LAS unsigned char* kb = lds + ((t) & 1) * KBY + mp * 128 + l31 * KS + hi * 16; \
        f32x16 p0 = f32x16{}, p1 = f32x16{}; \
        _Pragma("unroll") for (int d0 = 0; d0 < 4; ++d0) { \
            const bf16x8 a0 = *(const LAS bf16x8*)(kb + d0 * 32), a1 = *(const LAS bf16x8*)(kb + 32 * KS + d0 * 32); \
            p0 = __builtin_amdgcn_mfma_f32_32x32x16_bf16(a0, qf[d0], p0, 0, 0, 0); \
            p1 = __builtin_amdgcn_mfma_f32_32x32x16_bf16(a1, qf[d0], p1, 0, 0, 0); } \
        if (NA && (t) < sg.nt1) { \
            const int kr = kr_lo + (t); const LAS float* brow = biasl + (kr - r_q + 7) * 31 + 15 - cq; \
            _Pragma("unroll") for (int r = 0; r < 16; ++r) { \
                const int k0 = crow(r, hi), k1 = k0 + 32; \
                const bool v0 = (k0 >= cs) && (k0 < cs + 16), v1 = (k1 >= cs) && (k1 < cs + 16); \
                const float b0 = brow[v0 ? k0 : cq], b1 = brow[v1 ? k1 : cq]; \
                p0[r] = v0 ? p0[r] + b0 : NEG; p1[r] = v1 ? p1[r] + b1 : NEG; } } \
        float tm = fmaxf(fmaxf(p0[0], p1[0]), fmaxf(p0[1], p1[1])); \
        _Pragma("unroll") for (int r = 2; r < 16; r += 2) tm = fmaxf(tm, fmaxf(fmaxf(p0[r], p1[r]), fmaxf(p0[r + 1], p1[r + 1]))); \
        { auto rr_ = __builtin_amdgcn_permlane32_swap(__float_as_uint(tm), __float_as_uint(tm), false, false); tm = fmaxf(__uint_as_float(rr_[0]), __uint_as_float(rr_[1])); } \
        if (__any(tm > mrun + THR)) { \
            const float mn = fmaxf(mrun, tm), al = __builtin_amdgcn_exp2f(mrun - mn); \
            lsum *= al; mrun = mn; \
            if (hi == 0) wsf[l31] = al; \
            LDS_WAIT(); \
            _Pragma("unroll") for (int r = 0; r < 16; ++r) { const float f = wsf[crow(r, hi)]; \
                _Pragma("unroll") for (int i = 0; i < DVB; ++i) o[i][r] *= f; } \
            LDS_WAIT(); } \
        f32x2 sacc = {0.f, 0.f}; \
        _Pragma("unroll") for (int r = 0; r < 16; r += 2) { \
            p0[r] = __builtin_amdgcn_exp2f(p0[r] - mrun); p0[r + 1] = __builtin_amdgcn_exp2f(p0[r + 1] - mrun); p1[r] = __builtin_amdgcn_exp2f(p1[r] - mrun); p1[r + 1] = __builtin_amdgcn_exp2f(p1[r + 1] - mrun); \
            sacc += (f32x2){p0[r], p0[r + 1]}; sacc += (f32x2){p1[r], p1[r + 1]}; } \
        lsum += sacc[0] + sacc[1]; \
        _Pragma("unroll") for (int s_ = 0; s_ < 2; ++s_) { \
            u32x4 w0, w1; \
            w0.x = pk2(p0[8 * s_ + 0], p0[8 * s_ + 1]); w0.y = pk2(p0[8 * s_ + 2], p0[8 * s_ + 3]); w0.z = pk2(p0[8 * s_ + 4], p0[8 * s_ + 5]); w0.w = pk2(p0[8 * s_ + 6], p0[8 * s_ + 7]); \
            w1.x = pk2(p1[8 * s_ + 0], p1[8 * s_ + 1]); w1.y = pk2(p1[8 * s_ + 2], p1[8 * s_ + 3]); w1.z = pk2(p1[8 * s_ + 4], p1[8 * s_ + 5]); w1.w = pk2(p1[8 * s_ + 6], p1[8 * s_ + 7]); \
            pa[0][s_] = __builtin_bit_cast(bf16x8, w0); pa[1][s_] = __builtin_bit_cast(bf16x8, w1); } \
    } while (0)
#define ATT_PV(vb_) do { \
        const LAS char* vb = (const LAS char*)(lds + (vb_) * VBY + kvoff); \
        _Pragma("unroll") for (int d0 = 0; d0 < DVB; ++d0) { \
            _Pragma("unroll") for (int blk = 0; blk < 2; ++blk) \
                _Pragma("unroll") for (int s_ = 0; s_ < 2; ++s_) { \
                    const s16x4 lo = vtr(vb + (32 * blk + 16 * s_) * VS + 64 * d0), hh = vtr(vb + (32 * blk + 16 * s_ + 8) * VS + 64 * d0); \
                    const bf16x8 vf = (bf16x8){lo[0], lo[1], lo[2], lo[3], hh[0], hh[1], hh[2], hh[3]}; \
                    o[d0] = __builtin_amdgcn_mfma_f32_32x32x16_bf16(pa[blk][s_], vf, o[d0], 0, 0, 0); } \
            if (d0 & 1) __builtin_amdgcn_sched_barrier(0); } \
    } while (0)
#define ATT_ACTIVE(t) (!(NA && (t) < sg.nt1) || ((kr_lo + (t)) >= rs_q && (kr_lo + (t)) < rs_q + 8))
    int vcur = 0, vprev = 2;
    if constexpr (DIFF) {
        bool act_prev = false;
        for (int t = 0; t < nt; ++t) {
            const bool more = (t + 1 < nt);
            if (more) ATT_LOADK(t + 1);
            const bool act = ATT_ACTIVE(t);
            if (!grpB) { if (act) ATT_QKS(t); } else { if (act_prev) ATT_PV(vprev); }
            if (more) { ATT_STOREK((t + 1) & 1, t + 1); }
            ATT_BAR();
            if (more) ATT_LOADV(t + 1);
            if (!grpB) { if (act) ATT_PV(vcur); } else { if (act) ATT_QKS(t); }
            const int vnext = vcur == 2 ? 0 : vcur + 1;
            if (more) { ATT_STOREV(vnext, t + 1); }
            ATT_BAR();
            vprev = vcur; vcur = vnext; act_prev = act;
        }
        if (grpB && act_prev) ATT_PV(vprev);
        ATT_BAR();
    } else {
        for (int t = 0; t < nt; ++t) {
            const bool more = (t + 1 < nt);
            u32x4 st2[KC];
            if (more) { ATT_LOADK(t + 1); const bf16_t* vb_ = (t + 1) < sg.nt1 ? sg.V1 + (size_t)(t + 1) * 64 * D : sg.V2 + (size_t)((t + 1) - sg.nt1) * 64 * D;
#pragma unroll
                for (int i = 0; i < KC; ++i) st2[i] = *(const u32x4*)(vb_ + (size_t)SROW(i) * D + SCH(i) * 8); }
            if (ATT_ACTIVE(t)) { ATT_QKS(t); ATT_PV(vcur); }
            const int vnext = vcur == 2 ? 0 : vcur + 1;
            if (more) { ATT_STOREK((t + 1) & 1, t + 1);
#pragma unroll
                for (int i = 0; i < KC; ++i) { *(LAS u32x4*)(lds + VOFF + vnext * VBY + SROW(i) * VS + SCH(i) * 16) = st2[i];
                    if (fv) { float* p_ = fv + (size_t)((t + 1) * 64 + SROW(i)) * 1024 + 8 * SCH(i);
                        st16f(p_, (f32x4){BF2F_LO(st2[i].x), BF2F_HI(st2[i].x), BF2F_LO(st2[i].y), BF2F_HI(st2[i].y)}); st16f(p_ + 4, (f32x4){BF2F_LO(st2[i].z), BF2F_HI(st2[i].z), BF2F_LO(st2[i].w), BF2F_HI(st2[i].w)}); } } }
            ATT_BAR();
            vcur = vnext;
        }
    }
#undef ATT_LOADK
#undef ATT_LOADV
#undef ATT_STOREK
#undef ATT_STOREV
#undef BF2F_LO
#undef BF2F_HI
#undef SROW
#undef SCH
#undef ATT_QKS
#undef ATT_PV
#undef ATT_ACTIVE
    { auto rr_ = __builtin_amdgcn_permlane32_swap(__float_as_uint(lsum), __float_as_uint(lsum), false, false); lsum = __uint_as_float(rr_[0]) + __uint_as_float(rr_[1]); }
    if (hi == 0) wsf[l31] = 1.f / lsum;
    LDS_WAIT();
    float inv[16];
#pragma unroll
    for (int r = 0; r < 16; ++r) inv[r] = wsf[crow(r, hi)];
    LDS_WAIT();
    if constexpr (!DIFF) {
        LAS bf16_t* stg = (LAS bf16_t*)(lds + OST_OFF) + wid * 2048;
#pragma unroll
        for (int r = 0; r < 16; ++r) { const int q = crow(r, hi);
#pragma unroll
            for (int d0 = 0; d0 < 2; ++d0) { const unsigned w = pk2(o[d0][r] * inv[r], 0.f); stg[q * 64 + d0 * 32 + l31] = (bf16_t)(w & 0xffffu); } }
        LDS_WAIT();
#pragma unroll
        for (int i = 0; i < 4; ++i) { const int row = i * 8 + (lane >> 3), ch = lane & 7; const u32x4 v = *(const LAS u32x4*)(stg + row * 64 + ch * 8); st16(Ow + (size_t)row * D + ch * 8, v); }
        LDS_WAIT();
        ATT_BAR();
    } else {
        constexpr int RS = 132;
        LAS float* ex = (LAS float*)lds + (wid & 3) * 32 * RS;
        if (mp == 1) {
#pragma unroll
            for (int r = 0; r < 16; ++r) { const int q = crow(r, hi); const float f = inv[r] * lam;
#pragma unroll
                for (int d0 = 0; d0 < 4; ++d0) ex[q * RS + d0 * 32 + l31] = o[d0][r] * f; }
        }
        ATT_BAR();
        if (mp == 0) {
#pragma unroll
            for (int r = 0; r < 16; ++r) { const int q = crow(r, hi);
#pragma unroll
                for (int d0 = 0; d0 < 4; ++d0) { LAS float* p = ex + q * RS + d0 * 32 + l31; *p = o[d0][r] * inv[r] - *p; } }
            LDS_WAIT();
            { const LAS float* rp = ex + l31 * RS + hi * 64; float ss = 0.f;
#pragma unroll
              for (int j = 0; j < 16; ++j) { const f32x4 v = *(const LAS f32x4*)(rp + 4 * j); ss += (v[0] * v[0] + v[1] * v[1]) + (v[2] * v[2] + v[3] * v[3]); }
              { auto rr_ = __builtin_amdgcn_permlane32_swap(__float_as_uint(ss), __float_as_uint(ss), false, false); ss = __uint_as_float(rr_[0]) + __uint_as_float(rr_[1]); }
              if (hi == 0) wsf[l31] = rsqrtf(ss * (1.f / 128.f) + EPS) * post_scale; }
            LDS_WAIT();
            const int ch = lane & 15; const f32x4 g0 = *(const f32x4*)(subg + 8 * ch), g1 = *(const f32x4*)(subg + 8 * ch + 4);
#pragma unroll
            for (int i = 0; i < 8; ++i) { const int row = i * 4 + (lane >> 4); const float rstd = wsf[row];
                const f32x4 a = *(const LAS f32x4*)(ex + row * RS + 8 * ch) * rstd * g0, b = *(const LAS f32x4*)(ex + row * RS + 8 * ch + 4) * rstd * g1;
                u32x4 w; w.x = pk2(a[0], a[1]); w.y = pk2(a[2], a[3]); w.z = pk2(b[0], b[1]); w.w = pk2(b[2], b[3]);
                st16(Ow + (size_t)row * D + 8 * ch, w); }
        }
        LDS_WAIT();
        ATT_BAR();
    }
#undef ATT_BAR
}
}

#define XB_TMO      128
#define XB_XCNT(j)  (256  + 64 * (j))
#define XB_XSUB(j)  (1280 + 64 * (j))
#define XB_XGEN(j)  (2304 + 64 * (j))
#define XB_TOP      3328
#define XB_TOPGEN   3392
#define XCD_BAR_WORDS 3456
#define XB_SPIN_CAP (1u << 18)
__device__ __forceinline__ unsigned xb_ld(unsigned* p)              { return __hip_atomic_load(p, __ATOMIC_RELAXED, __HIP_MEMORY_SCOPE_AGENT); }
__device__ __forceinline__ unsigned xb_add(unsigned* p, unsigned v) { return __hip_atomic_fetch_add(p, v, __ATOMIC_RELAXED, __HIP_MEMORY_SCOPE_AGENT); }
__device__ __forceinline__ unsigned xb_xcc_id() { return (unsigned)__builtin_amdgcn_s_getreg((3 << 11) | 20) & 0xFu; }
#define XB_SPIN(cond, bar) do { unsigned _sp = 0; while (cond) { __builtin_amdgcn_s_sleep(1); \
    if ((++_sp & 255u) == 0u) { if (xb_ld(&(bar)[XB_TMO])) break; if (_sp > XB_SPIN_CAP) { atomicAdd(&(bar)[XB_TMO], 1u); break; } } } } while (0)
struct XcdBarrier { unsigned* bar; unsigned x; volatile LAS unsigned* st; unsigned n; };
__device__ __forceinline__ XcdBarrier xcd_barrier_post(unsigned* bar, volatile LAS unsigned* st, unsigned n) {
    XcdBarrier b; b.bar = bar; b.x = xb_xcc_id(); b.st = st; b.n = n;
    if (threadIdx.x == 0) (void)xb_add(&bar[XB_XCNT(b.x)], 1u);
    return b;
}
__device__ __forceinline__ void xcd_barrier_complete(unsigned* bar, unsigned x, unsigned G, unsigned& nloc, unsigned& nx) {
    unsigned sum, cnt, mine, sp = 0u;
    for (;;) {
        sum = 0u; cnt = 0u; mine = 0u;
#pragma unroll
        for (unsigned j = 0; j < 16; ++j) { const unsigned c = xb_ld(&bar[XB_XCNT(j)]); sum += c; cnt += (c > 0u) ? 1u : 0u; mine = (j == x) ? c : mine; }
        if (sum == G) break;
        __builtin_amdgcn_s_sleep(1);
        if ((++sp & 255u) == 0u) { if (xb_ld(&bar[XB_TMO])) break; if (sp > XB_SPIN_CAP) { atomicAdd(&bar[XB_TMO], 1u); break; } }
    }
    nloc = mine > 0u ? mine : 1u; nx = cnt > 0u ? cnt : 1u;
}
__device__ __forceinline__ void xcd_barrier(const XcdBarrier& b, const bool leader  ) {
    asm volatile("s_waitcnt vmcnt(0)" ::: "memory");
    __syncthreads();
    if (leader) {
        unsigned* bar = b.bar;
        __builtin_amdgcn_s_waitcnt(0);
        unsigned nloc = b.st[0], nx = b.st[1];
        if (nloc == 0u) { xcd_barrier_complete(bar, b.x, b.n, nloc, nx); b.st[0] = nloc; b.st[1] = nx; }
        const unsigned old = xb_add(&bar[XB_XSUB(b.x)], 1u);
        const unsigned gen = old / nloc;
        if (old + 1u == (gen + 1u) * nloc) {
            __builtin_amdgcn_fence(__ATOMIC_RELEASE, "agent");
            asm volatile("s_waitcnt vmcnt(0)" ::: "memory");
            const unsigned og = xb_add(&bar[XB_TOP], 1u);
            const unsigned tg = og / nx;
            if (og + 1u == (tg + 1u) * nx) xb_add(&bar[XB_TOPGEN], 1u);
            else XB_SPIN(xb_ld(&bar[XB_TOPGEN]) == tg, bar);
            __builtin_amdgcn_fence(__ATOMIC_ACQUIRE, "agent");
            xb_add(&bar[XB_XGEN(b.x)], 1u);
            asm volatile("s_waitcnt vmcnt(0)" ::: "memory");
        } else {
            XB_SPIN(xb_ld(&bar[XB_XGEN(b.x)]) == gen, bar);
            __builtin_amdgcn_fence(__ATOMIC_ACQUIRE, "agent");
            asm volatile("s_waitcnt vmcnt(0)" ::: "memory");
        }
    }
    __syncthreads();
}

__device__ __forceinline__ void xcc_barrier(unsigned* cnt, unsigned* tmo, const bool leader) {
    asm volatile("s_waitcnt vmcnt(0)" ::: "memory");
    __syncthreads();
    if (leader) {
        const unsigned old = xb_add(cnt, 1u); const unsigned target = (old / 32u + 1u) * 32u;
        unsigned sp = 0u;
        while (xb_ld(cnt) < target) { __builtin_amdgcn_s_sleep(1); if ((++sp & 255u) == 0u) { if (xb_ld(tmo)) break; if (sp > XB_SPIN_CAP) { atomicAdd(tmo, 1u); break; } } }
        __builtin_amdgcn_fence(__ATOMIC_ACQUIRE, "agent");
        asm volatile("s_waitcnt vmcnt(0)" ::: "memory");
    }
    __syncthreads();
}

struct Args { const float* in[28]; float* out; unsigned char* ws; int ph_lo, ph_hi; };
typedef const __attribute__((address_space(4))) Args* CArgs;
__device__ __forceinline__ CArgs args_ptr() { unsigned long long p = (unsigned long long)__builtin_amdgcn_kernarg_segment_ptr(); asm volatile("" : "+s"(p)); return (CArgs)p; }

template <bool QKVMAP>
__device__ __forceinline__ void transpose_item(const float* W, int K, int N, bf16_t* WT, int item, int lane, LAS unsigned char* tile) {
    const int nblk = N / 64, kb = item / nblk, nb = item % nblk, k0 = 64 * kb, n0 = 64 * nb;
    const int ng = lane & 15, q = lane >> 4;
    const float* src = W + (size_t)(k0 + 16 * q) * N + n0 + 4 * ng;
    f32x4 v[16];
#pragma unroll
    for (int j = 0; j < 16; ++j) v[j] = *(const f32x4*)(src + (size_t)j * N);
#pragma unroll
    for (int nn = 0; nn < 4; ++nn)
#pragma unroll
        for (int c = 0; c < 2; ++c) { u32x4 w; w.x = pk2(v[8 * c][nn], v[8 * c + 1][nn]); w.y = pk2(v[8 * c + 2][nn], v[8 * c + 3][nn]); w.z = pk2(v[8 * c + 4][nn], v[8 * c + 5][nn]); w.w = pk2(v[8 * c + 6][nn], v[8 * c + 7][nn]);
            *(LAS u32x4*)(tile + (4 * ng + nn) * 144 + (16 * q + 8 * c) * 2) = w; }
    LDS_WAIT(); asm volatile("" ::: "memory");
#pragma unroll
    for (int i = 0; i < 8; ++i) { const int r = 8 * i + (lane >> 3), ch = lane & 7; const u32x4 w = *(const LAS u32x4*)(tile + r * 144 + ch * 16);
        const int n = n0 + r; int nr = n;
        if (QKVMAP && n < 2048) { const int c = n & 255; nr = (n - c) + ((c & 63) >> 5) * 128 + (c >> 6) * 32 + (c & 31); }
        st16(WT + (size_t)nr * K + k0 + 8 * ch, w); }
    LDS_WAIT(); asm volatile("" ::: "memory");
}

__global__ void __launch_bounds__(512, 2) fwd_kernel(Args args_by_value_unused) {
    extern __shared__ __attribute__((aligned(16))) unsigned char lds_raw[];
    LAS unsigned char* lds = (LAS unsigned char*)lds_raw;
    const int tid = threadIdx.x, lane = tid & 63; const int wave = __builtin_amdgcn_readfirstlane(tid >> 6);
    constexpr int G = 256;
#define PBX() ({ int b_ = __builtin_amdgcn_readfirstlane((int)MISC[14]); asm volatile("" : "+s"(b_)); b_; })
#define PTID() ({ unsigned z_ = 0u; asm volatile("" : "+v"(z_)); (int)(wave * 64 + (int)__builtin_amdgcn_mbcnt_hi(~0u, __builtin_amdgcn_mbcnt_lo(~0u, z_))); })
#define VCU(b_) (((b_) & 7) * 32 + ((b_) >> 3))
    int lo, hi;
    volatile LAS unsigned* MISC = (volatile LAS unsigned*)(lds + MISC_OFF);
    for (int u = tid; u < (LDS_BYTES - LDSCTL_OFF) / 4; u += 512) ((LAS unsigned*)(lds + LDSCTL_OFF))[u] = 0u;
    __syncthreads();
#define STRM(b_) (((b_) & 7) / (8 / NS))
#define LBI(b_) ((((b_) & 7) % (8 / NS)) * 32 + ((b_) >> 3))
    { CArgs A = args_ptr(); lo = A->ph_lo; hi = A->ph_hi; unsigned* ctl = (unsigned*)(A->ws + WS_CTL);
      if (tid == 0) { MISC[14] = blockIdx.x; MISC[15] = 0u;
          if (MK_SINGLE) { const unsigned x = xb_xcc_id(); const unsigned idx = xb_add(&(ctl + CW_BAR)[XB_XCNT(x)], 1u); MISC[13] = idx * 8u + x; } }
      __syncthreads(); }
#define MAKE_BAR(bq_, k) XcdBarrier bq_; { CArgs Ab_ = args_ptr(); unsigned* ctl_ = (unsigned*)(Ab_->ws + WS_CTL); const bool glob_ = (k) <= 1; \
        bq_.bar = ctl_ + CW_BAR + (glob_ ? 0 : (1 + STRM(PBX())) * XCD_BAR_WORDS); bq_.x = xb_xcc_id(); bq_.st = MISC + (glob_ ? 8 : 10); bq_.n = (unsigned)(glob_ ? G : G / NS); }
#define IN(k) (lo <= (k) && (k) < hi)
#define SEAM(k) do { if (PROBE_KL == 2 && (k) == PROBE_PH && PTID() == 0) pt2 = __builtin_amdgcn_s_memrealtime(); if (PROBE_KL == 3 && (k) == PROBE_PH) { asm volatile("s_waitcnt vmcnt(0)" ::: "memory"); if (PTID() == 0) pt2 = __builtin_amdgcn_s_memrealtime(); } if (IN(k) && IN((k) + 1)) { MAKE_BAR(bq_, k); for (int d_ = 0; d_ < DUP_BAR; ++d_) xcd_barrier(bq_, PTID() == 0); } \
        if (PROBE_PH >= 0 && PTID() == 0) { if ((k) + 1 == PROBE_PH) pt0 = __builtin_amdgcn_s_memrealtime(); if ((k) == PROBE_PH) { pt1 = __builtin_amdgcn_s_memrealtime(); if (PROBE_KL >= 2) pt1 = pt2; if (PROBE_KL == 1) { CArgs A_ = args_ptr(); pt1 = __hip_atomic_load((unsigned long long*)(A_->ws + 512), __ATOMIC_RELAXED, __HIP_MEMORY_SCOPE_AGENT); } } } } while (0)
    constexpr int NGW = G * 8;
#define SEAMX(k) do { if (IN(k) && IN((k) + 1) && __builtin_amdgcn_readfirstlane((int)MISC[15])) { CArgs Ax_ = args_ptr(); unsigned* ctlx_ = (unsigned*)(Ax_->ws + WS_CTL); \
        xcc_barrier(ctlx_ + CW_XL + 64 * (xb_xcc_id() & 7u), ctlx_ + CW_BAR + XB_TMO, PTID() == 0); \
        if (PROBE_PH >= 0 && PTID() == 0) { if ((k) + 1 == PROBE_PH) pt0 = __builtin_amdgcn_s_memrealtime(); if ((k) == PROBE_PH) pt1 = __builtin_amdgcn_s_memrealtime(); } } else SEAM(k); } while (0)
    volatile LAS unsigned long long* PTS = (volatile LAS unsigned long long*)(lds + MISC_OFF + 64);
#define pt0 PTS[0]
#define pt1 PTS[1]
#define pt2 PTS[2]
    if (PROBE_PH >= 0 && tid == 0) pt0 = __builtin_amdgcn_s_memrealtime();

    if (EN_PRO && IN(0)) for (int dup_ = 0; dup_ < DUP_PRO; ++dup_) {
        const int bx = PBX(); const int gw = VCU(bx) * 8 + wave;
        {
            CArgs A = args_ptr();
            LAS float* sl = (LAS float*)lds;
            LAS f32x4* red = (LAS f32x4*)(lds + 20480);
            const float* c = A->in[6]; const float* cctx = A->in[7]; float* mod = (float*)(A->ws + WS_MOD);
            for (int idx = tid; idx < 5120; idx += 512) { const int n = idx >> 10, k = idx & 1023; const float x = n == 0 ? cctx[k] : c[(n - 1) * 1024 + k]; sl[idx] = x / (1.f + __expf(-x)); }
            __syncthreads();
            for (int wq = bx; wq < 256; wq += G) {
                const int l = wq >> 6, cb = (wq & 63) * 96;
                if (tid < 384) {
                    const int cg = tid % 24, ks = tid / 24;
                    const float* wp = A->in[8] + ((size_t)l * 1024 + ks * 64) * 6144 + cb + 4 * cg;
                    f32x4 a[5];
#pragma unroll
                    for (int n = 0; n < 5; ++n) a[n] = (f32x4){0.f, 0.f, 0.f, 0.f};
#pragma unroll 8
                    for (int k = 0; k < 64; ++k) { const f32x4 w4 = *(const f32x4*)(wp + (size_t)k * 6144);
#pragma unroll
                        for (int n = 0; n < 5; ++n) a[n] += sl[n * 1024 + ks * 64 + k] * w4; }
#pragma unroll
                    for (int n = 0; n < 5; ++n) red[(ks * 24 + cg) * 5 + n] = a[n];
                }
                __syncthreads();
                if (tid < 120) { const int cg = tid / 5, n = tid % 5; f32x4 s = *(const f32x4*)(A->in[9] + l * 6144 + cb + 4 * cg);
                    for (int ks = 0; ks < 16; ++ks) s += red[(ks * 24 + cg) * 5 + n];
                    *(f32x4*)(mod + ((size_t)l * 5 + n) * 6144 + cb + 4 * cg) = s; }
                __syncthreads();
            }
        }
        if (bx == 0) {
            CArgs A = args_ptr(); float* ropet = (float*)(A->ws + WS_ROPE);
            for (int idx = tid; idx < 1024; idx += 512) { const int pos = idx >> 4, j = idx & 15; const float fr = powf(10000.f, -(float)j / 16.f); const float ang = (float)pos * fr; ropet[2 * idx] = cosf(ang); ropet[2 * idx + 1] = sinf(ang); }
        }
        if (bx == 1 % G && wave < 2) {
            CArgs A = args_ptr(); float* lamv = (float*)(A->ws + WS_LAM);
            const int i = wave; const float a1 = A->in[18][i * 64 + lane] * A->in[19][i * 64 + lane], a2 = A->in[20][i * 64 + lane] * A->in[21][i * 64 + lane];
            const float s1 = wave_sum(a1), s2 = wave_sum(a2); const float linit = 0.8f - 0.6f * expf(-0.3f * (float)(2 * i));
            if (lane == 0) lamv[i] = expf(s1) - expf(s2) + linit;
        }
        {
            CArgs A = args_ptr(); bf16_t* cache = (bf16_t*)(A->ws + WS_CACHE);
            for (int ch = gw * 64 + lane; ch < 4 * 2 * 4 * 256 * 128; ch += NGW * 64) {
                const int c8 = ch & 127, t = (ch >> 7) & 255, b = (ch >> 15) & 3, i = (ch >> 17) & 1, kind = ch >> 18;
                const float* src = A->in[2 + kind] + (((size_t)(b * 2 + i) * 256 + t) * 1024);
                f32x4 v0, v1;
                if ((kind & 1) == 0) { const int Gh = c8 >> 3, p8 = c8 & 7, bj = p8 >> 2, fq = p8 & 3; const float* sp = src + 64 * Gh + 32 * bj + 4 * fq; v0 = *(const f32x4*)sp; v1 = *(const f32x4*)(sp + 16); }
                else { v0 = *(const f32x4*)(src + 8 * c8); v1 = *(const f32x4*)(src + 8 * c8 + 4); }
                u32x4 w; w.x = pk2(v0[0], v0[1]); w.y = pk2(v0[2], v0[3]); w.z = pk2(v1[0], v1[1]); w.w = pk2(v1[2], v1[3]);
                st16(cache + (size_t)ch * 8, w);
            }
        }
        {
            constexpr int I_QKV = 16 * 48, I_O = 16 * 16, I_1 = 16 * 64, I_2 = 64 * 16, I_L = I_QKV + I_O + I_1 + I_2;
            LAS unsigned char* ttile = lds + 65536 + wave * 9216;
            for (int it = gw; it < DEPTH * I_L; it += NGW) {
                CArgs A = args_ptr();
                const int l = it / I_L, i = l >> 1; int r = it % I_L;
                unsigned char* wl = A->ws + WS_W + (size_t)l * W_LAYER;
                if (r < I_QKV) { transpose_item<true>(A->in[(l & 1) ? 23 : 14] + (size_t)i * 1024 * 3072, 1024, 3072, (bf16_t*)(wl + W_QKV), r, lane, ttile); continue; } r -= I_QKV;
                if (r < I_O) { transpose_item<false>(A->in[(l & 1) ? 24 : 15] + (size_t)i * 1024 * 1024, 1024, 1024, (bf16_t*)(wl + W_O), r, lane, ttile); continue; } r -= I_O;
                if (r < I_1) { transpose_item<false>(A->in[12] + (size_t)l * 1024 * 4096, 1024, 4096, (bf16_t*)(wl + W_1), r, lane, ttile); continue; } r -= I_1;
                transpose_item<false>(A->in[13] + (size_t)l * 4096 * 1024, 4096, 1024, (bf16_t*)(wl + W_2), r, lane, ttile);
            }
        }
    }
    SEAM(0);
    if (MK_SINGLE && IN(0) && IN(1)) {
        if (PTID() == 0) { CArgs A = args_ptr(); unsigned* bar0 = (unsigned*)(A->ws + WS_CTL) + CW_BAR; bool ok = xb_xcc_id() < 8u;
#pragma unroll
            for (unsigned j = 0; j < 8; ++j) ok = ok && (xb_ld(&bar0[XB_XCNT(j)]) == 32u);
            if (XCC_MODE && ok) { MISC[14] = MISC[13]; MISC[15] = 1u; } }
        __syncthreads();
        if (PTID() == 0) { CArgs A = args_ptr(); unsigned* ctl = (unsigned*)(A->ws + WS_CTL); (void)xb_add(&(ctl + CW_BAR + (1 + STRM(PBX())) * XCD_BAR_WORDS)[XB_XCNT(xb_xcc_id())], 1u); }
    }
    if (EN_NORM && IN(1)) for (int dup_ = 0; dup_ < DUP_NORM; ++dup_) {
        {
            CArgs A = args_ptr(); const int ptid = PTID(); const int lane = ptid & 63; const int gwv = VCU(PBX()) * 8 + __builtin_amdgcn_readfirstlane(ptid >> 6);
            const float* gam = A->in[10]; const float* modl = (const float*)(A->ws + WS_MOD); bf16_t* XN = (bf16_t*)(A->ws + WS_XN); float* ssq = (float*)(A->ws + WS_SSQ);
            for (int rb = gwv * 4; rb < M; rb += NGW * 4) {
                const float* xr = rb < MP ? A->in[0] + (size_t)rb * D : A->in[1] + (size_t)(rb - MP) * D;
                const float* sc = modl + (rb < MP ? 0 : 1 + ((rb - MP) >> 10)) * 6144 + 1024;
                f32x4 v[4][4];
#pragma unroll
                for (int q = 0; q < 4; ++q)
#pragma unroll
                    for (int j = 0; j < 4; ++j) v[q][j] = *(const f32x4*)(xr + (size_t)q * D + 4 * lane + 256 * j);
                f32x4 gs[4];
#pragma unroll
                for (int j = 0; j < 4; ++j) { const int c = 4 * lane + 256 * j; gs[j] = *(const f32x4*)(gam + c) * (1.f + *(const f32x4*)(sc + c)); }
#pragma unroll
                for (int q = 0; q < 4; ++q) {
                    float ss = 0.f;
#pragma unroll
                    for (int j = 0; j < 4; ++j) ss += (v[q][j][0] * v[q][j][0] + v[q][j][1] * v[q][j][1]) + (v[q][j][2] * v[q][j][2] + v[q][j][3] * v[q][j][3]);
                    ss = wave_sum(ss);
#pragma unroll
                    for (int j = 0; j < 4; ++j) { const f32x4 h = v[q][j] * gs[j]; u32x2 w; w.x = pk2(h[0], h[1]); w.y = pk2(h[2], h[3]); st8(XN + (size_t)(rb + q) * D + 4 * lane + 256 * j, w); }
                    if (lane < 32) st4f(ssq + (size_t)(rb + q) * 32 + lane, ss * (1.f / 32.f));
                }
            }
        }
        {
            CArgs A = args_ptr(); const int ptid = PTID(); const int lane = ptid & 63; const int gwv = VCU(PBX()) * 8 + __builtin_amdgcn_readfirstlane(ptid >> 6);
            const float* mod = (const float*)(A->ws + WS_MOD); float* swt = (float*)(A->ws + WS_SW);
            for (int wk = gwv; wk < DEPTH * 448; wk += NGW) {
                const int l = wk / 448, r0 = (wk % 448) * 16;
                const bf16_t* wbase = r0 < 3072 ? (const bf16_t*)(A->ws + WS_W + (size_t)l * W_LAYER + W_QKV) + (size_t)r0 * 1024 : (const bf16_t*)(A->ws + WS_W + (size_t)l * W_LAYER + W_1) + (size_t)(r0 - 3072) * 1024;
                const float* sh = mod + (size_t)l * 5 * 6144 + (r0 < 3072 ? 0 : 3) * 1024 + 8 * lane;
                f32x4 sv[5][4];
#pragma unroll
                for (int n = 0; n < 5; ++n) { sv[n][0] = *(const f32x4*)(sh + n * 6144); sv[n][1] = *(const f32x4*)(sh + n * 6144 + 4); sv[n][2] = *(const f32x4*)(sh + n * 6144 + 512); sv[n][3] = *(const f32x4*)(sh + n * 6144 + 516); }
#pragma unroll 1
                for (int rq = 0; rq < 16; rq += 4) {
                    u32x4 w0[4], w1[4];
#pragma unroll
                    for (int q = 0; q < 4; ++q) { w0[q] = *(const u32x4*)(wbase + (size_t)(rq + q) * 1024 + 8 * lane); w1[q] = *(const u32x4*)(wbase + (size_t)(rq + q) * 1024 + 512 + 8 * lane); }
#pragma unroll
                    for (int q = 0; q < 4; ++q) {
                        float wf[16];
#pragma unroll
                        for (int j = 0; j < 4; ++j) { wf[2 * j] = __uint_as_float(w0[q][j] << 16); wf[2 * j + 1] = __uint_as_float(w0[q][j] & 0xffff0000u); wf[8 + 2 * j] = __uint_as_float(w1[q][j] << 16); wf[8 + 2 * j + 1] = __uint_as_float(w1[q][j] & 0xffff0000u); }
                        float a[5];
#pragma unroll
                        for (int n = 0; n < 5; ++n) {
                            a[n] = ((wf[0] * sv[n][0][0] + wf[1] * sv[n][0][1]) + (wf[2] * sv[n][0][2] + wf[3] * sv[n][0][3])) + ((wf[4] * sv[n][1][0] + wf[5] * sv[n][1][1]) + (wf[6] * sv[n][1][2] + wf[7] * sv[n][1][3]))
                                 + ((wf[8] * sv[n][2][0] + wf[9] * sv[n][2][1]) + (wf[10] * sv[n][2][2] + wf[11] * sv[n][2][3])) + ((wf[12] * sv[n][3][0] + wf[13] * sv[n][3][1]) + (wf[14] * sv[n][3][2] + wf[15] * sv[n][3][3]));
                            a[n] = wave_sum(a[n]); }
                        if (lane < 5) { const float v = lane == 0 ? a[0] : lane == 1 ? a[1] : lane == 2 ? a[2] : lane == 3 ? a[3] : a[4]; swt[((size_t)l * 5 + lane) * 7168 + r0 + rq + q] = v; }
                    }
                }
            }
        }
    }
    if (MICRO_PAT && IN(1)) {
        CArgs A = args_ptr(); const int ptid = PTID(); const int lane = ptid & 63; const int gwv = VCU(PBX()) * 8 + __builtin_amdgcn_readfirstlane(ptid >> 6);
        unsigned char* base = A->ws + WS_H + (size_t)gwv * 32768;
        const u32x4 val = {1u, 2u, 3u, (unsigned)lane};
        for (int rep = 0; rep < MICRO_REP; ++rep)
#pragma unroll 8
            for (int it = 0; it < 32; ++it) {
                unsigned char* p;
                if (MICRO_PAT == 1) p = base + it * 1024 + lane * 16;
                else if (MICRO_PAT == 2) p = base + (it >> 1) * 2048 + lane * 32 + (it & 1) * 16;
                else if (MICRO_PAT == 3) p = base + (lane >> 2) * 2048 + (it) * 64 + (lane & 3) * 16;
                else p = base + lane * 512 + it * 16;
                *(u32x4*)p = val; }
    }
    SEAM(1);
    if (NS > 1 && STREAM_DELAY_US > 0 && IN(1) && IN(2)) { const int strm = STRM(blockIdx.x); const unsigned long long t0_ = __builtin_amdgcn_s_memrealtime(); while (__builtin_amdgcn_s_memrealtime() - t0_ < (unsigned long long)(strm * STREAM_DELAY_US * 100)) __builtin_amdgcn_s_sleep(32); }

    for (int l = 0; l < DEPTH; ++l) {
        const int pb = 2 + 5 * l, i = l >> 1; const bool diff = (l & 1) == 0;
        if (EN_QKV && IN(pb + 0)) for (int dup_ = 0; dup_ < DUP_QKV; ++dup_) {
            {
                CArgs A = args_ptr(); unsigned char* ws = A->ws; const int ptid = PTID(); const int pbx = PBX(); const bf16_t* wq = (const bf16_t*)(ws + WS_W + (size_t)l * W_LAYER + W_QKV);
                pg8::Gemm g{(const bf16_t*)(ws + WS_XN), wq, 1024, (unsigned long long*)(ws + 512)}; pg8::StaticOrder S; S.init(8, STRM(pbx), LBI(pbx));
                pg8::EpiQK E{ws, A->in[diff ? 16 : 25] + i * 64, A->in[diff ? 17 : 26] + i * 64, A->out + (diff ? OUT_DK : OUT_NK) + (size_t)i * 256 * 1024, l, diff};
                pg8::gemm_phase<pg8::EpiQK, 2, true>(lds, g, S, E, ptid);
            }
            {
                CArgs A = args_ptr(); unsigned char* ws = A->ws; const int ptid = PTID(); const int pbx = PBX(); const bf16_t* wq = (const bf16_t*)(ws + WS_W + (size_t)l * W_LAYER + W_QKV);
                pg8::Gemm g{(const bf16_t*)(ws + WS_XN), wq + (size_t)2048 * 1024, 1024, (unsigned long long*)(ws + 512)}; pg8::StaticOrder S; S.init(8, STRM(pbx), LBI(pbx));
                pg8::EpiV E{(bf16_t*)(ws + WS_V), A->out + (diff ? OUT_DV : OUT_NV) + (size_t)i * 256 * 1024, (const float*)(ws + WS_SSQ), (const float*)(ws + WS_SW) + (size_t)l * 5 * 7168};
                pg8::gemm_phase_n1<pg8::EpiV, true>(lds, g, S, E, ptid);
            }
        }
        SEAM(pb + 0);
        if (EN_ATT && IN(pb + 1)) {
            { const int abx = PBX(); const int v = LBI(abx), strm = STRM(abx); constexpr int HB = 16 / NS, LB = 4 / NS;
                if (diff) {
                    const float linit = 0.8f - 0.6f * expf(-0.3f * (float)l);
                    for (int dup_ = 0; dup_ < DUP_ADP; ++dup_) {
                        CArgs A = args_ptr(); unsigned char* ws = A->ws; const int ptid = PTID(); const int pbx = PBX(); const bf16_t* Qb = (const bf16_t*)(ws + WS_Q); const bf16_t* Kb = (const bf16_t*)(ws + WS_K); const bf16_t* Vb = (const bf16_t*)(ws + WS_V); bf16_t* Ob = (bf16_t*)(ws + WS_O);
                        const float lam = ((const float*)(ws + WS_LAM))[i]; const float* subg = A->in[22] + i * 128;
                        const int pw = __builtin_amdgcn_readfirstlane(ptid >> 6), rg = pw & 3, mp = pw >> 2; const int b = strm * HB + (v >> 4), h = (v >> 1) & 7, qb = v & 1; const int q0 = b * 256 + qb * 128 + rg * 32;
                        att::Seg sg{Kb + (size_t)(b * 256) * D + h * 128, Vb + (size_t)(b * 256) * D + h * 128, 4, nullptr, nullptr, 0};
                        float* fo = A->out + (size_t)(b * 2 + i) * 256 * 1024 + h * 128;
                        att::attn_unit<true, false>(ptid, lds, Qb + (size_t)q0 * D + h * 128 + mp * 64, sg, Ob + (size_t)q0 * D + h * 128, 0, 0, 0, nullptr, lam, 1.f - linit, subg, qb == 0 ? fo + OUT_DK : nullptr, qb == 1 ? fo + OUT_DV : nullptr);
                    }
                    for (int dup_ = 0; dup_ < DUP_ADL; ++dup_) {
                        CArgs A = args_ptr(); unsigned char* ws = A->ws; const int ptid = PTID(); const int pbx = PBX(); const bf16_t* Qb = (const bf16_t*)(ws + WS_Q); const bf16_t* Kb = (const bf16_t*)(ws + WS_K); const bf16_t* Vb = (const bf16_t*)(ws + WS_V); bf16_t* Ob = (bf16_t*)(ws + WS_O);
                        const bf16_t* cache = (const bf16_t*)(ws + WS_CACHE);
                        const float lam = ((const float*)(ws + WS_LAM))[i]; const float* subg = A->in[22] + i * 128;
                        const int pw = __builtin_amdgcn_readfirstlane(ptid >> 6), rg = pw & 3, mp = pw >> 2; const int b = strm * LB + (v >> 6), h = (v >> 3) & 7, qb = v & 7; const int q0 = MP + b * 1024 + qb * 128 + rg * 32;
                        const bf16_t* ck = cache + ((size_t)(0 * 2 + i) * 4 + b) * 256 * 1024 + h * 128; const bf16_t* cv = cache + ((size_t)(1 * 2 + i) * 4 + b) * 256 * 1024 + h * 128;
                        att::Seg sg{Kb + (size_t)(MP + b * 1024) * D + h * 128, Vb + (size_t)(MP + b * 1024) * D + h * 128, 16, ck, cv, 4};
                        att::attn_unit<true, false>(ptid, lds, Qb + (size_t)q0 * D + h * 128 + mp * 64, sg, Ob + (size_t)q0 * D + h * 128, 0, 0, 0, nullptr, lam, 1.f - linit, subg, nullptr, nullptr);
                    }
                } else {
                    for (int dup_ = 0; dup_ < DUP_ANP; ++dup_) {
                        CArgs A = args_ptr(); unsigned char* ws = A->ws; const int ptid = PTID(); const int pbx = PBX(); const bf16_t* Qb = (const bf16_t*)(ws + WS_Q); const bf16_t* Kb = (const bf16_t*)(ws + WS_K); const bf16_t* Vb = (const bf16_t*)(ws + WS_V); bf16_t* Ob = (bf16_t*)(ws + WS_O);
                        const int pw = __builtin_amdgcn_readfirstlane(ptid >> 6); const int b = strm * HB + (v >> 4), h = v & 15; const int q0 = b * 256 + pw * 32;
                        att::Seg sg{Kb + (size_t)(b * 256) * D + h * 64, Vb + (size_t)(b * 256) * D + h * 64, 4, nullptr, nullptr, 0};
                        float* fo = A->out + (size_t)(b * 2 + i) * 256 * 1024 + h * 64;
                        att::attn_unit<false, false>(ptid, lds, Qb + (size_t)q0 * D + h * 64, sg, Ob + (size_t)q0 * D + h * 64, 0, 0, 0, nullptr, 0.f, 0.f, nullptr, fo + OUT_NK, fo + OUT_NV);
                    }
                    for (int dup_ = 0; dup_ < DUP_ANL; ++dup_) {
                        CArgs A = args_ptr(); unsigned char* ws = A->ws; const int ptid = PTID(); const int pbx = PBX(); const bf16_t* Qb = (const bf16_t*)(ws + WS_Q); const bf16_t* Kb = (const bf16_t*)(ws + WS_K); const bf16_t* Vb = (const bf16_t*)(ws + WS_V); bf16_t* Ob = (bf16_t*)(ws + WS_O);
                        const bf16_t* cache = (const bf16_t*)(ws + WS_CACHE);
                        const int b = strm * LB + (v >> 6), h = (v >> 2) & 15, R = v & 3; const int pw = __builtin_amdgcn_readfirstlane(ptid >> 6); const int r_q = 4 * R + (pw >> 1), jj = pw & 1; const int q0 = MP + b * 1024 + r_q * 64 + jj * 32;
                        const int kr_lo = min(max(4 * R - 4, 0), 8), kr_hi = min(max(4 * R + 3 - 4, 0), 8) + 8;
                        const bf16_t* ck = cache + ((size_t)(2 * 2 + i) * 4 + b) * 256 * 1024 + h * 64; const bf16_t* cv = cache + ((size_t)(3 * 2 + i) * 4 + b) * 256 * 1024 + h * 64;
                        att::Seg sg{Kb + (size_t)(MP + b * 1024 + kr_lo * 64) * D + h * 64, Vb + (size_t)(MP + b * 1024 + kr_lo * 64) * D + h * 64, kr_hi - kr_lo, ck, cv, 4};
                        att::attn_unit<false, true>(ptid, lds, Qb + (size_t)q0 * D + h * 64, sg, Ob + (size_t)q0 * D + h * 64, kr_lo, r_q, jj, A->in[27] + ((size_t)i * 16 + h) * 465, 0.f, 0.f, nullptr, nullptr, nullptr);
                    }
                }
            }
        }
        SEAM(pb + 1);
        if (EN_O && IN(pb + 2)) for (int dup_ = 0; dup_ < DUP_O; ++dup_) {
            CArgs A = args_ptr(); unsigned char* ws = A->ws; const int ptid = PTID(); const int pbx = PBX(); float* out = A->out; float* outw = dup_ + 1 < DUP_O ? (float*)(ws + WS_Q) : out + OUT_Y;
            const float* modl = (const float*)(ws + WS_MOD) + (size_t)l * 5 * 6144;
            pg8::Gemm g{(const bf16_t*)(ws + WS_O), (const bf16_t*)(ws + WS_W + (size_t)l * W_LAYER + W_O), 1024, (unsigned long long*)(ws + 512)}; pg8::StaticOrder S; S.init(8, STRM(pbx), LBI(pbx));
            pg8::EpiResid E{l == 0 ? A->in[0] : out + OUT_Y, l == 0 ? A->in[1] : out + OUT_Y + (size_t)MP * D, outw, modl + 2 * 1024,
                            A->in[11] + l * 1024, modl + 4 * 1024, (bf16_t*)(ws + WS_XN), (float*)(ws + WS_SSQ)};
            pg8::gemm_phase_n1<pg8::EpiResid, true>(lds, g, S, E, ptid);
        }
        SEAMX(pb + 2);
        if (EN_FC1 && IN(pb + 3)) for (int dup_ = 0; dup_ < DUP_FC1; ++dup_) {
            CArgs A = args_ptr(); unsigned char* ws = A->ws; const int ptid = PTID(); const int pbx = PBX();
            pg8::Gemm g{(const bf16_t*)(ws + WS_XN), (const bf16_t*)(ws + WS_W + (size_t)l * W_LAYER + W_1), 1024, (unsigned long long*)(ws + 512)}; pg8::StaticOrder S; S.init(16, STRM(pbx), LBI(pbx));
            pg8::EpiRelu2 E{(bf16_t*)(ws + WS_H), (const float*)(ws + WS_SSQ), (const float*)(ws + WS_SW) + (size_t)l * 5 * 7168};
            pg8::gemm_phase<pg8::EpiRelu2, 2, true>(lds, g, S, E, ptid);
        }
        SEAMX(pb + 3);
#define FC2_BLOCK(SCRATCH, ABLV) { \
            CArgs A = args_ptr(); unsigned char* ws = A->ws; const int ptid = PTID(); const int pbx = PBX(); float* out = A->out; float* outw = (SCRATCH) ? (float*)(ws + WS_Q) : out + OUT_Y; \
            const float* modl = (const float*)(ws + WS_MOD) + (size_t)l * 5 * 6144; const bool more = l + 1 < DEPTH; \
            pg8::Gemm g{(const bf16_t*)(ws + WS_H), (const bf16_t*)(ws + WS_W + (size_t)l * W_LAYER + W_2), 4096, (unsigned long long*)(ws + 512)}; pg8::StaticOrder S; S.init(8, STRM(pbx), LBI(pbx)); \
            pg8::EpiResid E{out + OUT_Y, out + OUT_Y + (size_t)MP * D, outw, modl + 5 * 1024, \
                            A->in[10] + (l + 1) * 1024, modl + 5 * 6144 + 1 * 1024, more ? (bf16_t*)(ws + WS_XN) : nullptr, (float*)(ws + WS_SSQ)}; \
            pg8::gemm_phase_n1<pg8::EpiResid, true, ABLV>(lds, g, S, E, ptid); }
        if (EN_FC2 && IN(pb + 4)) {
#if DUP_FC2 > 1
            FC2_BLOCK(true, ABL_N1)
#endif
            FC2_BLOCK(false, 0)
        }
        SEAMX(pb + 4);
    }
    if (PROBE_PH >= 0) { if (PROBE_PH == 2 + 5 * DEPTH - 1 && PTID() == 0) pt1 = __builtin_amdgcn_s_memrealtime(); { MAKE_BAR(bq_, 0); xcd_barrier(bq_, PTID() == 0); }
        if (blockIdx.x == 0 && PTID() == 0) { CArgs A = args_ptr(); A->out[0] += (float)(pt1 - pt0) * 0.001f; } }
#undef IN
#undef SEAM
}

extern "C" void kernel_launch(void* const* d_in, const int* in_sizes, int n_in, void* d_out, int out_size, void* d_ws, size_t ws_size, hipStream_t stream) {
    static int grid = 0;
    if (grid == 0) {
        if (n_in != 28 || out_size != 41943040 || ws_size < WS_END) { fprintf(stderr, "kernel_launch: unexpected shapes (n_in %d, out %d, ws %zu); nothing launched\n", n_in, out_size, ws_size); grid = -1; return; }
        int dev = 0, cus = 0;
        if (hipGetDevice(&dev) != hipSuccess || hipDeviceGetAttribute(&cus, hipDeviceAttributeMultiprocessorCount, dev) != hipSuccess) { grid = -1; return; }
        if (hipFuncSetAttribute((const void*)fwd_kernel, hipFuncAttributeMaxDynamicSharedMemorySize, LDS_BYTES) != hipSuccess) { fprintf(stderr, "kernel_launch: hipFuncSetAttribute failed\n"); grid = -1; return; }
        int per_cu = 0;
        if (hipOccupancyMaxActiveBlocksPerMultiprocessor(&per_cu, (const void*)fwd_kernel, 512, LDS_BYTES) != hipSuccess || per_cu < 1) fprintf(stderr, "kernel_launch: occupancy query reports %d\n", per_cu);
        (void)hipGetLastError();
        grid = cus;
        if (grid != 256) { fprintf(stderr, "kernel_launch: built for a 256-CU device (stream geometry); found %d CUs; nothing launched\n", cus); grid = -1; return; }
    }
    if (grid < 0) return;
    (void)hipMemsetAsync((char*)d_ws + WS_CTL, 0, CTL_ZERO_BYTES, stream);
    Args a{};
    for (int i = 0; i < 28; ++i) a.in[i] = (const float*)d_in[i];
    a.out = (float*)d_out; a.ws = (unsigned char*)d_ws;
    constexpr int NPH = 2 + 5 * DEPTH;
#if MK_SINGLE
    a.ph_lo = 0; a.ph_hi = NPH;
    hipLaunchKernelGGL(fwd_kernel, dim3(grid), dim3(512), LDS_BYTES, stream, a);
#else
    for (int p = 0; p < NPH; ++p) { a.ph_lo = p; a.ph_hi = p + 1; hipLaunchKernelGGL(fwd_kernel, dim3(grid), dim3(512), LDS_BYTES, stream, a); }
#endif
}
```

```cpp
#include <hip/hip_runtime.h>
#include <cstdio>
#include <cstdint>

#ifndef MK_SINGLE
#define MK_SINGLE 1
#endif

#ifndef DUP_PRO
#define DUP_PRO 1
#endif
#ifndef DUP_NORM
#define DUP_NORM 1
#endif
#ifndef DUP_QKV
#define DUP_QKV 1
#endif
#ifndef DUP_ADP
#define DUP_ADP 1
#endif
#ifndef DUP_ADL
#define DUP_ADL 1
#endif
#ifndef DUP_ANP
#define DUP_ANP 1
#endif
#ifndef DUP_ANL
#define DUP_ANL 1
#endif
#ifndef DUP_FC1
#define DUP_FC1 1
#endif
#ifndef DUP_O
#define DUP_O 1
#endif
#ifndef DUP_FC2
#define DUP_FC2 1
#endif
#ifndef NS
#define NS 2
#endif
#ifndef STREAM_DELAY_US
#define STREAM_DELAY_US 0
#endif
#ifndef DUP_YST
#define DUP_YST 1
#endif
#ifndef XCC_MODE
#define XCC_MODE 1
#endif
#ifndef MICRO_PAT
#define MICRO_PAT 0
#endif
#ifndef MICRO_REP
#define MICRO_REP 4
#endif
#ifndef ABL_N1
#define ABL_N1 0
#endif
#ifndef KROT_ON
#define KROT_ON 0
#endif
#ifndef PROBE_KL
#define PROBE_KL 0
#endif
#ifndef PROBE_PH
#define PROBE_PH -1
#endif
#ifndef DUP_BAR
#define DUP_BAR 1
#endif
#ifndef EN_PRO
#define EN_PRO 1
#endif
#ifndef EN_NORM
#define EN_NORM 1
#endif
#ifndef EN_QKV
#define EN_QKV 1
#endif
#ifndef EN_ATT
#define EN_ATT 1
#endif
#ifndef EN_O
#define EN_O 1
#endif
#ifndef EN_FC1
#define EN_FC1 1
#endif
#ifndef EN_FC2
#define EN_FC2 1
#endif
#define LAS __attribute__((address_space(3)))
#define GAS __attribute__((address_space(1)))
typedef unsigned short bf16_t;
typedef short bf16x8 __attribute__((ext_vector_type(8)));
typedef short s16x4 __attribute__((ext_vector_type(4)));
typedef float f32x4 __attribute__((ext_vector_type(4)));
typedef float f32x2 __attribute__((ext_vector_type(2)));
typedef float f32x16 __attribute__((ext_vector_type(16)));
typedef unsigned u32x4 __attribute__((ext_vector_type(4)));
typedef unsigned u32x2 __attribute__((ext_vector_type(2)));
typedef __bf16 bf16x2_t __attribute__((ext_vector_type(2)));

constexpr int D = 1024, FF = 4096, DEPTH = 4;
constexpr int MP = 4096, M = 8192;
constexpr float EPS = 1e-6f;
constexpr float LOG2E = 1.4426950408889634f;
constexpr float C2 = 0.125f * LOG2E;
constexpr size_t OUT_Y = 0, OUT_DK = 8388608, OUT_DV = 16777216, OUT_NK = 25165824, OUT_NV = 33554432;

constexpr size_t MiB = 1u << 20;
constexpr size_t WS_CTL = 0, CTL_ZERO_BYTES = 128 * 1024;
constexpr size_t WS_MOD = 1 * MiB;
constexpr size_t WS_ROPE = WS_MOD + 512 * 1024;
constexpr size_t WS_LAM = WS_ROPE + 16 * 1024;
constexpr size_t WS_W = 2 * MiB;
constexpr size_t W_LAYER = 24 * MiB, W_QKV = 0, W_O = 6 * MiB, W_1 = 8 * MiB, W_2 = 16 * MiB;
constexpr size_t WS_CACHE = 98 * MiB;
constexpr size_t WS_XN = 114 * MiB, WS_Q = 130 * MiB, WS_K = 146 * MiB, WS_V = 162 * MiB, WS_O = 178 * MiB, WS_H = 194 * MiB, WS_SSQ = 258 * MiB  , WS_SW = 259 * MiB  , WS_END = 260 * MiB;
constexpr int CW_BAR = 1024, CW_XL = 16384;

constexpr int RING_BYTES = 147456;
constexpr int LDSCTL_OFF = RING_BYTES, MISC_OFF = LDSCTL_OFF + 320;
constexpr int LDS_BYTES = 148480;

__device__ __forceinline__ unsigned pk2(float lo, float hi) { f32x2 v = {lo, hi}; bf16x2_t b = __builtin_convertvector(v, bf16x2_t); return __builtin_bit_cast(unsigned, b); }
__device__ __forceinline__ float wave_sum(float v) {
#pragma unroll
    for (int o = 1; o < 64; o <<= 1) v += __shfl_xor(v, o);
    return v;
}
#ifndef WT_STORES
#define WT_STORES 0
#endif
__device__ __forceinline__ void st16(void* p, u32x4 v) {
#if WT_STORES
    asm volatile("global_store_dwordx4 %0, %1, off sc1\n\ts_nop 1" :: "v"(p), "v"(v) : "memory");
#else
    *(u32x4*)p = v;
#endif
}
__device__ __forceinline__ void st16f(void* p, f32x4 v) { st16(p, __builtin_bit_cast(u32x4, v)); }
__device__ __forceinline__ void st8(void* p, u32x2 v) {
#if WT_STORES
    asm volatile("global_store_dwordx2 %0, %1, off sc1\n\ts_nop 1" :: "v"(p), "v"(v) : "memory");
#else
    *(u32x2*)p = v;
#endif
}
__device__ __forceinline__ void st4f(float* p, float v) {
#if WT_STORES
    asm volatile("global_store_dword %0, %1, off sc1\n\ts_nop 1" :: "v"(p), "v"(v) : "memory");
#else
    *p = v;
#endif
}
#define LDS_WAIT() asm volatile("s_waitcnt lgkmcnt(0)" ::: "memory")
#define VM_WAIT() asm volatile("s_waitcnt vmcnt(0)" ::: "memory")

namespace pg8 {
constexpr int BM = 256, BK = 64, HALF = 128, HTB = HALF * BK * 2, NXCD = 8, WGM = 8;
__host__ __device__ __forceinline__ int lds_byte(int r, int c) { const int st = (r >> 4) * 2 + (c >> 5), rr = r & 15, cc = c & 31, ob = rr * 64 + cc * 2; return st * 1024 + (ob ^ (((ob >> 9) & 1) << 5)); }
__host__ __device__ __forceinline__ void stage_rc(int b, int& R, int& C) { const int st = b / 1024, sb = b % 1024, swz = sb ^ (((sb >> 9) & 1) << 5); R = (st >> 1) * 16 + swz / 64; C = (st & 1) * 32 + (swz % 64) / 2; }
__host__ __device__ __forceinline__ int perm32(int rho) { const int n = rho >> 4, i = rho & 15; return 8 * (i >> 2) + 4 * n + (i & 3); }

struct Unit { int pm, pn; };
struct Gemm { const bf16_t* A; const bf16_t* Bt; int K; unsigned long long* stamp; };

struct StaticOrder {
    int nN, half, pbase_p, pbase_s, lb;
    __device__ void init(int nN_, int strm, int lb_) { nN = nN_; half = 16 / NS; pbase_p = strm * half; pbase_s = 16 + strm * half; lb = lb_; }
    __device__ bool next(int i, Unit& u) const { const int pn = 8 * i + (lb & 7); if (pn >= nN) return false; const int pl = lb >> 3; u.pm = pl < half ? pbase_p + pl : pbase_s + (pl - half); u.pn = pn; return true; }
};

template <class Epi, int NB, bool ALIGN_EPI>
__device__ __forceinline__ void gemm_phase(LAS unsigned char* lds, const Gemm g, const StaticOrder& S, const Epi& E, const int tid) {
    const int wid = __builtin_amdgcn_readfirstlane(tid >> 6), lane = tid & 63, wr = wid >> 2, wc = wid & 3, fr = lane & 15, fq = lane >> 4;
    const int K = g.K, nt = K / BK;
    unsigned voffA[2], voffB[2];
#pragma unroll
    for (int i = 0; i < 2; ++i) { int R, C; stage_rc(tid * 16 + i * 8192, R, C); const int Rb = Epi::PERM ? ((R & ~31) + perm32(R & 31)) : R;
        voffA[i] = (unsigned)(R * K + C) * 2u; voffB[i] = (unsigned)(Rb * K + C) * 2u; }
    const size_t kstep = (size_t)(BK * 2);
    const size_t hstep = (size_t)HALF * K * 2;
    const size_t tstepA = 2 * hstep, tstepB = NB * hstep;
    const unsigned ldsw = (unsigned)wid * 1024u;
    const int aoff = lds_byte(wr * 64 + fr, fq * 8), boff = lds_byte(wc * 32 + fr, fq * 8);
#define PG8_SA(b, h) (((b) * 2 + (h)) * HTB)
#define PG8_SB(b, h) ((4 + (b) * 2 + (h)) * HTB)
#define PG8_STAGE(bufoff, gbase, voff) do { _Pragma("unroll") for (int _i = 0; _i < 2; ++_i) \
        __builtin_amdgcn_global_load_lds((const unsigned*)((const char*)(gbase) + (voff)[_i]), (LAS unsigned*)(lds + (bufoff) + ldsw + _i * 8192), 16, 0, 0); } while (0)
#define PG8_LDA(dst, b, h) do { _Pragma("unroll") for (int m = 0; m < 4; ++m) _Pragma("unroll") for (int k = 0; k < 2; ++k) dst[m][k] = *(const LAS bf16x8*)(lds + PG8_SA(b, h) + aoff + m * 2048 + k * 1024); } while (0)
#define PG8_LDB(dst, b, h) do { _Pragma("unroll") for (int n = 0; n < 2; ++n) _Pragma("unroll") for (int k = 0; k < 2; ++k) dst[n][k] = *(const LAS bf16x8*)(lds + PG8_SB(b, h) + boff + n * 2048 + k * 1024); } while (0)
#define PG8_MMA(ai, bj, At, Bt) do { __builtin_amdgcn_s_setprio(1); _Pragma("unroll") for (int m = 0; m < 4; ++m) _Pragma("unroll") for (int n = 0; n < 2; ++n) _Pragma("unroll") for (int k = 0; k < 2; ++k) \
        acc[ai][bj][m][n] = __builtin_amdgcn_mfma_f32_16x16x32_bf16(Bt[n][k], At[m][k], acc[ai][bj][m][n], 0, 0, 0); __builtin_amdgcn_s_setprio(0); } while (0)
#define PG8_WAIT_V(n) asm volatile("s_waitcnt vmcnt(" #n ")" ::: "memory")
#define PG8_WAIT_L(n) asm volatile("s_waitcnt lgkmcnt(" #n ")" ::: "memory")
#define PG8_BAR __builtin_amdgcn_s_barrier()
#define PG8_SCHED __builtin_amdgcn_sched_barrier(0)
    Unit cur, nxt; int ui = 0;
    if (!S.next(0, cur)) return;
    f32x4 acc[2][NB][4][2];
#pragma unroll
    for (int a = 0; a < 2; ++a)
#pragma unroll
        for (int b = 0; b < NB; ++b)
#pragma unroll
            for (int m = 0; m < 4; ++m)
#pragma unroll
                for (int n = 0; n < 2; ++n) acc[a][b][m][n] = (f32x4){0.f, 0.f, 0.f, 0.f};
    bf16x8 At[4][2], B0[2][2], B1[2][2];
    const char* cA = (const char*)g.A + (size_t)cur.pm * tstepA; const char* cB = (const char*)g.Bt + (size_t)cur.pn * tstepB;
    if constexpr (NB == 2) {
        PG8_STAGE(PG8_SB(0, 0), cB, voffB); PG8_STAGE(PG8_SB(0, 1), cB + hstep, voffB); PG8_STAGE(PG8_SA(0, 0), cA, voffA); PG8_STAGE(PG8_SA(0, 1), cA + hstep, voffA);
        if (wr == 1) PG8_BAR;
        PG8_WAIT_V(2); PG8_BAR;
        PG8_STAGE(PG8_SB(1, 0), cB + kstep, voffB); PG8_STAGE(PG8_SA(1, 0), cA + kstep, voffA); PG8_STAGE(PG8_SB(1, 1), cB + hstep + kstep, voffB);
        PG8_WAIT_V(6); PG8_BAR;
    } else {
        PG8_STAGE(PG8_SB(0, 0), cB, voffB); PG8_STAGE(PG8_SA(0, 0), cA, voffA); PG8_STAGE(PG8_SA(0, 1), cA + hstep, voffA);
        if (wr == 1) PG8_BAR;
        PG8_WAIT_V(2); PG8_BAR;
        PG8_STAGE(PG8_SB(1, 0), cB + kstep, voffB); PG8_STAGE(PG8_SA(1, 0), cA + kstep, voffA);
        PG8_WAIT_V(4); PG8_BAR;
    }
    for (;;) {
        const bool has_next = S.next(ui + 1, nxt);
        const char* nA = has_next ? (const char*)g.A + (size_t)nxt.pm * tstepA : cA; const char* nB = has_next ? (const char*)g.Bt + (size_t)nxt.pn * tstepB : cB;
        for (int t = 0; t < nt; t += 2) {
            const bool last = (t == nt - 2);
            const char* a1 = cA + (size_t)(t + 1) * kstep;
            const char* a2 = last ? nA : cA + (size_t)(t + 2) * kstep; const char* b2 = last ? nB : cB + (size_t)(t + 2) * kstep;
            const char* a3 = a2 + kstep; const char* b3 = b2 + kstep;
            if constexpr (NB == 2) {
            PG8_LDB(B0, 0, 0); PG8_LDB(B1, 0, 1); PG8_SCHED; PG8_LDA(At, 0, 0); PG8_STAGE(PG8_SA(1, 1), a1 + hstep, voffA);
            PG8_WAIT_V(8); PG8_WAIT_L(0); PG8_BAR; PG8_MMA(0, 0, At, B0); PG8_MMA(0, 1, At, B1); PG8_BAR; PG8_SCHED;
            PG8_LDA(At, 0, 1); PG8_STAGE(PG8_SB(0, 0), b2, voffB); PG8_STAGE(PG8_SB(0, 1), b2 + hstep, voffB); PG8_STAGE(PG8_SA(0, 0), a2, voffA);
            PG8_WAIT_V(8); PG8_WAIT_L(0); PG8_BAR; PG8_MMA(1, 0, At, B0); PG8_MMA(1, 1, At, B1); PG8_BAR; PG8_SCHED;
            PG8_LDB(B0, 1, 0); PG8_LDB(B1, 1, 1); PG8_SCHED; PG8_LDA(At, 1, 0); PG8_STAGE(PG8_SA(0, 1), a2 + hstep, voffA);
            PG8_WAIT_V(8); PG8_WAIT_L(0); PG8_BAR; PG8_MMA(0, 0, At, B0); PG8_MMA(0, 1, At, B1); PG8_BAR; PG8_SCHED;
            PG8_LDA(At, 1, 1); PG8_STAGE(PG8_SB(1, 0), b3, voffB); PG8_STAGE(PG8_SB(1, 1), b3 + hstep, voffB); PG8_STAGE(PG8_SA(1, 0), a3, voffA);
            PG8_WAIT_V(8); PG8_WAIT_L(0); PG8_BAR; PG8_MMA(1, 0, At, B0); PG8_MMA(1, 1, At, B1); PG8_BAR; PG8_SCHED;
            } else {
            PG8_LDB(B0, 0, 0); PG8_SCHED; PG8_LDA(At, 0, 0); PG8_STAGE(PG8_SA(1, 1), a1 + hstep, voffA);
            PG8_WAIT_V(6); PG8_WAIT_L(0); PG8_BAR; PG8_MMA(0, 0, At, B0); PG8_BAR; PG8_SCHED;
            PG8_LDA(At, 0, 1); PG8_STAGE(PG8_SB(0, 0), b2, voffB); PG8_STAGE(PG8_SA(0, 0), a2, voffA);
            PG8_WAIT_V(6); PG8_WAIT_L(0); PG8_BAR; PG8_MMA(1, 0, At, B0); PG8_BAR; PG8_SCHED;
            PG8_LDB(B0, 1, 0); PG8_SCHED; PG8_LDA(At, 1, 0); PG8_STAGE(PG8_SA(0, 1), a2 + hstep, voffA);
            PG8_WAIT_V(6); PG8_WAIT_L(0); PG8_BAR; PG8_MMA(0, 0, At, B0); PG8_BAR; PG8_SCHED;
            PG8_LDA(At, 1, 1); PG8_STAGE(PG8_SB(1, 0), b3, voffB); PG8_STAGE(PG8_SA(1, 0), a3, voffA);
            PG8_WAIT_V(6); PG8_WAIT_L(0); PG8_BAR; PG8_MMA(1, 0, At, B0); PG8_BAR; PG8_SCHED;
            }
        }
        if (PROBE_KL && blockIdx.x == 0 && tid == 0) *(volatile unsigned long long*)g.stamp = __builtin_amdgcn_s_memrealtime();
        if constexpr (ALIGN_EPI) { if (wr == 0) PG8_BAR; }
        E(acc, cur, wr, wc, fr, fq);
        if (!has_next) break;
#pragma unroll
        for (int a = 0; a < 2; ++a)
#pragma unroll
            for (int b = 0; b < NB; ++b)
#pragma unroll
                for (int m = 0; m < 4; ++m)
#pragma unroll
                    for (int n = 0; n < 2; ++n) acc[a][b][m][n] = (f32x4){0.f, 0.f, 0.f, 0.f};
        cur = nxt; cA = nA; cB = nB; ++ui;
        if constexpr (ALIGN_EPI) { if (wr == 1) PG8_BAR; }
    }
    PG8_WAIT_V(0);
    if constexpr (!ALIGN_EPI) { if (wr == 0) PG8_BAR; }
    PG8_BAR;
#undef PG8_SA
#undef PG8_SB
#undef PG8_STAGE
#undef PG8_LDA
#undef PG8_LDB
#undef PG8_MMA
#undef PG8_WAIT_V
#undef PG8_WAIT_L
#undef PG8_BAR
#undef PG8_SCHED
}

template <class Epi, bool ALIGN_EPI, int ABL = 0>
__device__ __forceinline__ void gemm_phase_n1(LAS unsigned char* lds, const Gemm g, const StaticOrder& S, const Epi& E, const int tid) {
    const int wid = __builtin_amdgcn_readfirstlane(tid >> 6), lane = tid & 63, wr = wid >> 2, wc = wid & 3, fr = lane & 15, fq = lane >> 4;
    const int K = g.K, nt = K / BK;
    unsigned voffA[2], voffB[2];
#pragma unroll
    for (int i = 0; i < 2; ++i) { int R, C; stage_rc(tid * 16 + i * 8192, R, C); const int Rb = Epi::PERM ? ((R & ~31) + perm32(R & 31)) : R;
        voffA[i] = (unsigned)(R * K + C) * 2u; voffB[i] = (unsigned)(Rb * K + C) * 2u; }
    const size_t kstep = (size_t)(BK * 2);
    const size_t hstep = (size_t)HALF * K * 2;
    const size_t tstepA = 2 * hstep, tstepB = hstep;
    const unsigned ldsw = (unsigned)wid * 1024u;
    const int aoff = lds_byte(wr * 64 + fr, fq * 8), boff = lds_byte(wc * 32 + fr, fq * 8);
    constexpr int BUF3 = 3 * HTB;
#define N1_STAGE1(bufoff, gbase, voff) do { _Pragma("unroll") for (int _i = 0; _i < 2; ++_i) \
        __builtin_amdgcn_global_load_lds((const unsigned*)((const char*)(gbase) + (voff)[_i]), (LAS unsigned*)(lds + (bufoff) + ldsw + _i * 8192), 16, 0, 0); } while (0)
#define N1_STAGE3(c, pa, pb) do { N1_STAGE1((c) * BUF3, pb, voffB); N1_STAGE1((c) * BUF3 + HTB, pa, voffA); N1_STAGE1((c) * BUF3 + 2 * HTB, (pa) + hstep, voffA); } while (0)
#define N1_LDA(dst, c, h) do { _Pragma("unroll") for (int m = 0; m < 4; ++m) _Pragma("unroll") for (int k = 0; k < 2; ++k) dst[m][k] = *(const LAS bf16x8*)(lds + (c) * BUF3 + (1 + (h)) * HTB + aoff + m * 2048 + k * 1024); } while (0)
#define N1_LDB(dst, c) do { _Pragma("unroll") for (int n = 0; n < 2; ++n) _Pragma("unroll") for (int k = 0; k < 2; ++k) dst[n][k] = *(const LAS bf16x8*)(lds + (c) * BUF3 + boff + n * 2048 + k * 1024); } while (0)
#define N1_MMA(ai, At, Bt) do { _Pragma("unroll") for (int m = 0; m < 4; ++m) _Pragma("unroll") for (int n = 0; n < 2; ++n) _Pragma("unroll") for (int k = 0; k < 2; ++k) \
        acc[ai][0][m][n] = __builtin_amdgcn_mfma_f32_16x16x32_bf16(Bt[n][k], At[m][k], acc[ai][0][m][n], 0, 0, 0); } while (0)
#define N1_WAIT_V(n) asm volatile("s_waitcnt vmcnt(" #n ")" ::: "memory")
#define N1_WAIT_L(n) asm volatile("s_waitcnt lgkmcnt(" #n ")" ::: "memory")
#define N1_BAR __builtin_amdgcn_s_barrier()
#define N1_SCHED __builtin_amdgcn_sched_barrier(0)
    Unit cur, nxt; int ui = 0;
    if (!S.next(0, cur)) return;
    f32x4 acc[2][1][4][2];
#pragma unroll
    for (int a = 0; a < 2; ++a)
#pragma unroll
        for (int m = 0; m < 4; ++m)
#pragma unroll
            for (int n = 0; n < 2; ++n) acc[a][0][m][n] = (f32x4){0.f, 0.f, 0.f, 0.f};
    bf16x8 At0[4][2], At1[4][2], B0[2][2];
    const char* cA = (const char*)g.A + (size_t)cur.pm * tstepA; const char* cB = (const char*)g.Bt + (size_t)cur.pn * tstepB;
    typename Epi::Pre pre; E.pre_load(pre, cur, wr, wc, fr, fq);
#define KROT(u) (KROT_ON ? ((((u).pn & 7) + 8 * ((u).pm & 3)) * nt / 32) : 0)
    int rot = KROT(cur);
    N1_STAGE3(0, cA + (size_t)(rot & (nt - 1)) * kstep, cB + (size_t)(rot & (nt - 1)) * kstep); N1_STAGE3(1, cA + (size_t)((rot + 1) & (nt - 1)) * kstep, cB + (size_t)((rot + 1) & (nt - 1)) * kstep);
    if (wr == 1) N1_BAR;
    N1_WAIT_V(6); N1_BAR;
    N1_BAR;
    int c0 = 0;
    for (;;) {
        const bool has_next = S.next(ui + 1, nxt);
        const char* nA = has_next ? (const char*)g.A + (size_t)nxt.pm * tstepA : cA; const char* nB = has_next ? (const char*)g.Bt + (size_t)nxt.pn * tstepB : cB;
        const int nrot = has_next ? KROT(nxt) : rot;
        for (int t = 0; t < nt; ++t) {
            const bool tail = (t + 2 >= nt);
            const int kt = tail ? ((t + 2 - nt + nrot) & (nt - 1)) : ((t + 2 + rot) & (nt - 1));
            const char* sa = (tail ? nA : cA) + (size_t)kt * kstep;
            const char* sb = (tail ? nB : cB) + (size_t)kt * kstep;
            const int c2 = (c0 == 0) ? 2 : c0 - 1;
            N1_LDB(B0, c0); N1_SCHED; N1_LDA(At0, c0, 0); if (!(ABL == 1)) { N1_LDA(At1, c0, 1); } if (ABL == 5) { N1_STAGE1((c2) * BUF3, sb, voffB); N1_STAGE1((c2) * BUF3 + HTB, sa, voffA); } else if (ABL == 6) { N1_STAGE1((c2) * BUF3, sb, voffB); } else if (ABL == 7) { } else if (ABL != 4) { N1_STAGE3(c2, sa, sb); } else { N1_STAGE1((c2) * BUF3, sb, voffB); N1_STAGE1((c2) * BUF3 + HTB, sa, voffA); N1_STAGE1((c2) * BUF3 + 2 * HTB, sa, voffA); }
            if (ABL == 5) N1_WAIT_V(4); else if (ABL == 6) N1_WAIT_V(2); else if (ABL == 7) N1_WAIT_V(0); else N1_WAIT_V(6); N1_WAIT_L(0); N1_BAR;
            __builtin_amdgcn_s_setprio(1); N1_MMA(0, At0, B0); if (ABL == 1) { N1_MMA(1, At0, B0); } else if (ABL != 3) { N1_MMA(1, At1, B0); } __builtin_amdgcn_s_setprio(0);
            N1_BAR; N1_SCHED;
            c0 = (c0 == 2) ? 0 : c0 + 1;
        }
        if (PROBE_KL && blockIdx.x == 0 && tid == 0) *(volatile unsigned long long*)g.stamp = __builtin_amdgcn_s_memrealtime();
        if constexpr (ALIGN_EPI) { if (wr == 0) N1_BAR; }
        E(acc, pre, cur, wr, wc, fr, fq);
        if (!has_next) break;
#pragma unroll
        for (int a = 0; a < 2; ++a)
#pragma unroll
            for (int m = 0; m < 4; ++m)
#pragma unroll
                for (int n = 0; n < 2; ++n) acc[a][0][m][n] = (f32x4){0.f, 0.f, 0.f, 0.f};
        cur = nxt; cA = nA; cB = nB; ++ui; rot = nrot;
        E.pre_load(pre, cur, wr, wc, fr, fq);
        if constexpr (ALIGN_EPI) { if (wr == 1) N1_BAR; }
    }
    N1_WAIT_V(0);
    if constexpr (!ALIGN_EPI) { if (wr == 0) N1_BAR; }
    N1_BAR;
#undef N1_STAGE1
#undef N1_STAGE3
#undef N1_LDA
#undef N1_LDB
#undef N1_MMA
#undef N1_WAIT_V
#undef N1_WAIT_L
#undef N1_BAR
#undef N1_SCHED
#undef KROT
}

__device__ __forceinline__ int cond_of_pm(int pm) { return pm < 16 ? 0 : 1 + ((pm - 16) >> 2); }
__device__ __forceinline__ void row_rstd8(float (&rr)[2][4], const float* ssq, int row0  , int fq) {
#pragma unroll
    for (int ai = 0; ai < 2; ++ai) {
        f32x4 a[4], b[4];
#pragma unroll
        for (int m = 0; m < 4; ++m) { const float* p = ssq + (size_t)(row0 + ai * HALF + m * 16) * 32 + 8 * fq; a[m] = *(const f32x4*)p; b[m] = *(const f32x4*)(p + 4); }
#pragma unroll
        for (int m = 0; m < 4; ++m) { float s = ((a[m][0] + a[m][1]) + (a[m][2] + a[m][3])) + ((b[m][0] + b[m][1]) + (b[m][2] + b[m][3]));
            s += __shfl_xor(s, 16); s += __shfl_xor(s, 32); rr[ai][m] = rsqrtf(s * (1.f / 1024.f) + EPS); }
        asm volatile("" ::: "memory");
    }
}
__device__ __forceinline__ float row_rstd(const float* ssq, int row, int fq) {
    const f32x4 a = *(const f32x4*)(ssq + (size_t)row * 32 + 8 * fq), b = *(const f32x4*)(ssq + (size_t)row * 32 + 8 * fq + 4);
    float s = ((a[0] + a[1]) + (a[2] + a[3])) + ((b[0] + b[1]) + (b[2] + b[3]));
    s += __shfl_xor(s, 16); s += __shfl_xor(s, 32);
    return rsqrtf(s * (1.f / 1024.f) + EPS);
}

struct EpiQK {
    static constexpr bool PERM = false;
    unsigned char* ws; const float* qg; const float* kg; float* outk; int layer; bool use_rope;
    __device__ __forceinline__ void operator()(const f32x4 (&acc)[2][2][4][2], const Unit& u, int wr, int wc, int fr, int fq) const {
        bf16_t* Q = (bf16_t*)(ws + WS_Q); bf16_t* Kb = (bf16_t*)(ws + WS_K); const float* rope = use_rope ? (const float*)(ws + WS_ROPE) : nullptr;
        const float* ssq = (const float*)(ws + WS_SSQ); const float* sw = (const float*)(ws + WS_SW) + (size_t)layer * 5 * 7168;
        const bool isk = u.pn >= 4; const int G = (u.pn & 3) * 4 + wc;
        const float* swp = sw + cond_of_pm(u.pm) * 7168 + u.pn * 256 + wc * 32 + 4 * fq;
        const float* g = isk ? kg : qg; bf16_t* dst = isk ? Kb : Q; const float sc = isk ? 1.f : C2;
        const bool prompt = u.pm < 16; const bool do_rope = (rope != nullptr) && !prompt;
        f32x4 gv[2][2];
#pragma unroll
        for (int bj = 0; bj < 2; ++bj)
#pragma unroll
            for (int n = 0; n < 2; ++n) gv[bj][n] = *(const f32x4*)(g + 32 * bj + 16 * n + 4 * fq);
        float rr[2][4]; row_rstd8(rr, ssq, u.pm * BM + wr * 64 + fr, fq);
#pragma unroll
        for (int ai = 0; ai < 2; ++ai)
#pragma unroll
            for (int m = 0; m < 4; ++m) {
                const int row = u.pm * BM + ai * HALF + wr * 64 + m * 16 + fr;
                const float rrow = rr[ai][m];
                f32x4 x[2][2];
                float ss = 0.f;
#pragma unroll
                for (int bj = 0; bj < 2; ++bj)
#pragma unroll
                    for (int n = 0; n < 2; ++n) { const f32x4 xx = acc[ai][bj][m][n] * rrow + *(const f32x4*)(swp + 128 * bj + 16 * n); x[bj][n] = xx; ss += (xx[0] * xx[0] + xx[1] * xx[1]) + (xx[2] * xx[2] + xx[3] * xx[3]); }
                ss += __shfl_xor(ss, 16); ss += __shfl_xor(ss, 32);
                const float rstd = rsqrtf(ss * (1.f / 64.f) + EPS);
#pragma unroll
                for (int bj = 0; bj < 2; ++bj)
#pragma unroll
                    for (int n = 0; n < 2; ++n) x[bj][n] = x[bj][n] * rstd * gv[bj][n];
                if (do_rope) {
                    const int t = (row - MP) & 1023;
#pragma unroll
                    for (int bj = 0; bj < 2; ++bj) {
                        const int pos = bj == 0 ? (t >> 6) : (t & 63);
                        const f32x4 cs01 = *(const f32x4*)(rope + (pos * 16 + 4 * fq) * 2), cs23 = *(const f32x4*)(rope + (pos * 16 + 4 * fq) * 2 + 4);
                        const float cc[4] = {cs01[0], cs01[2], cs23[0], cs23[2]}, sn[4] = {cs01[1], cs01[3], cs23[1], cs23[3]};
#pragma unroll
                        for (int e = 0; e < 4; ++e) { const float x0 = x[bj][0][e], x1 = x[bj][1][e]; x[bj][0][e] = x0 * cc[e] - x1 * sn[e]; x[bj][1][e] = x1 * cc[e] + x0 * sn[e]; }
                    }
                }
                bf16_t* rp = dst + (size_t)row * D + 64 * G + 8 * fq;
#pragma unroll
                for (int bj = 0; bj < 2; ++bj) { const f32x4 v0 = x[bj][0] * sc, v1 = x[bj][1] * sc;
                    u32x4 w; w.x = pk2(v0[0], v0[1]); w.y = pk2(v0[2], v0[3]); w.z = pk2(v1[0], v1[1]); w.w = pk2(v1[2], v1[3]);
                    st16(rp + 32 * bj, w); }
            }
    }
};
struct EpiV {
    static constexpr bool PERM = true;
    bf16_t* V; float* outv; const float* ssq; const float* sw;
    struct Pre {};
    __device__ __forceinline__ void pre_load(Pre&, const Unit&, int, int, int, int) const {}
    __device__ __forceinline__ void operator()(const f32x4 (&acc)[2][1][4][2], const Pre&, const Unit& u, int wr, int wc, int fr, int fq) const {
        const int col0 = u.pn * HALF + wc * 32 + 8 * fq; const bool prompt = u.pm < 16;
        const float* swp = sw + cond_of_pm(u.pm) * 7168 + 2048 + col0; const f32x4 s0 = *(const f32x4*)swp, s1 = *(const f32x4*)(swp + 4);
        float rr[2][4]; row_rstd8(rr, ssq, u.pm * BM + wr * 64 + fr, fq);
#pragma unroll
        for (int ai = 0; ai < 2; ++ai)
#pragma unroll
            for (int m = 0; m < 4; ++m) {
                const int row = u.pm * BM + ai * HALF + wr * 64 + m * 16 + fr;
                const float rrow = rr[ai][m];
                const f32x4 v0 = acc[ai][0][m][0] * rrow + s0, v1 = acc[ai][0][m][1] * rrow + s1;
                u32x4 w; w.x = pk2(v0[0], v0[1]); w.y = pk2(v0[2], v0[3]); w.z = pk2(v1[0], v1[1]); w.w = pk2(v1[2], v1[3]);
                st16(V + (size_t)row * D + col0, w);
            }
    }
};
struct EpiResid {
    static constexpr bool PERM = true;
    const float* resid_p; const float* resid_s; float* out; const float* gate;
    const float* gnorm; const float* scale; bf16_t* XN; float* ssq;
    struct Pre { f32x4 rv[4][2]; };
    __device__ __forceinline__ void pre_load(Pre& p, const Unit& u, int wr, int wc, int fr, int fq) const {
        const int col0 = u.pn * HALF + wc * 32 + 8 * fq;
        const float* src = u.pm < 16 ? resid_p + (size_t)u.pm * BM * D : resid_s + (size_t)(u.pm - 16) * BM * D;
#pragma unroll
        for (int m = 0; m < 4; ++m) { const size_t off = (size_t)(wr * 64 + m * 16 + fr) * D + col0; p.rv[m][0] = *(const f32x4*)(src + off); p.rv[m][1] = *(const f32x4*)(src + off + 4); }
    }
    __device__ __forceinline__ void operator()(const f32x4 (&acc)[2][1][4][2], const Pre& p, const Unit& u, int wr, int wc, int fr, int fq) const {
        const int col0 = u.pn * HALF + wc * 32 + 8 * fq; const int cond = cond_of_pm(u.pm);
        const float* gp = gate + cond * 6144 + col0;
        const f32x4 g0 = *(const f32x4*)gp, g1 = *(const f32x4*)(gp + 4);
        f32x4 gs0 = (f32x4){0.f, 0.f, 0.f, 0.f}, gs1 = gs0;
        if (XN) { const float* sp = scale + cond * 6144 + col0; gs0 = *(const f32x4*)(gnorm + col0) * (1.f + *(const f32x4*)sp); gs1 = *(const f32x4*)(gnorm + col0 + 4) * (1.f + *(const f32x4*)(sp + 4)); }
        float* dstb = out + (size_t)u.pm * BM * D;
        const float* src = u.pm < 16 ? resid_p + (size_t)u.pm * BM * D : resid_s + (size_t)(u.pm - 16) * BM * D;
        f32x4 rv1[4][2];
#pragma unroll
        for (int m = 0; m < 4; ++m) { const size_t off = (size_t)(HALF + wr * 64 + m * 16 + fr) * D + col0; rv1[m][0] = *(const f32x4*)(src + off); rv1[m][1] = *(const f32x4*)(src + off + 4); }
#pragma unroll
        for (int ai = 0; ai < 2; ++ai)
#pragma unroll
            for (int m = 0; m < 4; ++m) {
                const int rl = ai * HALF + wr * 64 + m * 16 + fr;
                const size_t off = (size_t)rl * D + col0;
                const f32x4 r0 = ai == 0 ? p.rv[m][0] : rv1[m][0], r1 = ai == 0 ? p.rv[m][1] : rv1[m][1];
                const f32x4 y0 = r0 + g0 * acc[ai][0][m][0], y1 = r1 + g1 * acc[ai][0][m][1];
                for (int d_ = 0; d_ < DUP_YST; ++d_) { st16f(dstb + off, y0); st16f(dstb + off + 4, y1); asm volatile("" ::: "memory"); }
                if (XN) {
                    const f32x4 a0 = y0 * gs0, a1 = y1 * gs1;
                    u32x4 w; w.x = pk2(a0[0], a0[1]); w.y = pk2(a0[2], a0[3]); w.z = pk2(a1[0], a1[1]); w.w = pk2(a1[2], a1[3]);
                    st16(XN + (size_t)u.pm * BM * D + off, w);
                    float ss = ((y0[0] * y0[0] + y0[1] * y0[1]) + (y0[2] * y0[2] + y0[3] * y0[3])) + ((y1[0] * y1[0] + y1[1] * y1[1]) + (y1[2] * y1[2] + y1[3] * y1[3]));
                    ss += __shfl_xor(ss, 16); ss += __shfl_xor(ss, 32);
                    if (fq == 0) st4f(ssq + (size_t)(u.pm * BM + rl) * 32 + u.pn * 4 + wc, ss);
                }
            }
    }
};
struct EpiRelu2 {
    static constexpr bool PERM = true;
    bf16_t* H; const float* ssq; const float* sw;
    __device__ __forceinline__ void operator()(const f32x4 (&acc)[2][2][4][2], const Unit& u, int wr, int wc, int fr, int fq) const {
        const int col0 = u.pn * BM + wc * 32 + 8 * fq;
        const float* swp = sw + cond_of_pm(u.pm) * 7168 + 3072 + col0;
        f32x4 sv[2][2];
#pragma unroll
        for (int bj = 0; bj < 2; ++bj) { sv[bj][0] = *(const f32x4*)(swp + bj * HALF); sv[bj][1] = *(const f32x4*)(swp + bj * HALF + 4); }
        float rr[2][4]; row_rstd8(rr, ssq, u.pm * BM + wr * 64 + fr, fq);
#pragma unroll
        for (int ai = 0; ai < 2; ++ai)
#pragma unroll
            for (int m = 0; m < 4; ++m) {
                const int row = u.pm * BM + ai * HALF + wr * 64 + m * 16 + fr;
                const float rrow = rr[ai][m];
                bf16_t* rp = H + (size_t)row * FF + col0;
#pragma unroll
                for (int bj = 0; bj < 2; ++bj) {
                    f32x4 v0 = acc[ai][bj][m][0] * rrow + sv[bj][0], v1 = acc[ai][bj][m][1] * rrow + sv[bj][1];
#pragma unroll
                    for (int e = 0; e < 4; ++e) { const float a = fmaxf(v0[e], 0.f), b = fmaxf(v1[e], 0.f); v0[e] = a * a; v1[e] = b * b; }
                    u32x4 w; w.x = pk2(v0[0], v0[1]); w.y = pk2(v0[2], v0[3]); w.z = pk2(v1[0], v1[1]); w.w = pk2(v1[2], v1[3]);
                    st16(rp + bj * HALF, w); }
            }
    }
};
}

namespace att {
constexpr float THR = 8.f, NEG = -1e30f;
__device__ __forceinline__ int crow(int r, int hi) { return (r & 3) + 8 * (r >> 2) + 4 * hi; }
__device__ __forceinline__ s16x4 vtr(const LAS char* p) { return __builtin_bit_cast(s16x4, __builtin_amdgcn_ds_read_tr16_b64_v4i16((LAS s16x4*)p)); }

struct Seg { const bf16_t* K1; const bf16_t* V1; int nt1; const bf16_t* K2; const bf16_t* V2; int nt2; };

template <bool DIFF, bool NA>
__device__ __forceinline__ void attn_unit(const int tid, LAS unsigned char* lds, const bf16_t* Qw  , const Seg sg, bf16_t* Ow  ,
                                          int kr_lo, int r_q, int jj, const float* relb  ,
                                          float lam, float post_scale, const float* subg,
                                          float* fk, float* fv) {
    constexpr int KW = DIFF ? 256 : 128, VW = DIFF ? 256 : 128, KS = KW + 16, VS = VW + 64, KBY = 64 * KS, VBY = 64 * VS;
    constexpr int DVB = DIFF ? 4 : 2, KC = DIFF ? 2 : 1;
    constexpr int VOFF = 2 * KBY, WSF_OFF = VOFF + 3 * VBY, BIAS_OFF = WSF_OFF + 2048, OST_OFF = BIAS_OFF + 2048;
    const int lane = tid & 63, l31 = lane & 31, hi = lane >> 5; const int wid = __builtin_amdgcn_readfirstlane(tid >> 6);
    const int mp = DIFF ? (wid >> 2) : 0; const bool grpB = wid >= 4;
    LAS float* wsf = (LAS float*)(lds + WSF_OFF) + wid * 64;
    LAS float* biasl = (LAS float*)(lds + BIAS_OFF);
    const int nt = sg.nt1 + sg.nt2;
    u32x4 st[KC];
#define SROW(i) ((tid + 512 * (i)) / (KW / 16))
#define SCH(i) ((tid + 512 * (i)) % (KW / 16))
#define ATT_LOADK(t) do { const bf16_t* kb_ = (t) < sg.nt1 ? sg.K1 + (size_t)(t) * 64 * D : sg.K2 + (size_t)((t) - sg.nt1) * 64 * D; \
        _Pragma("unroll") for (int i = 0; i < KC; ++i) st[i] = *(const u32x4*)(kb_ + (size_t)SROW(i) * D + SCH(i) * 8); } while (0)
#define ATT_LOADV(t) do { const bf16_t* vb_ = (t) < sg.nt1 ? sg.V1 + (size_t)(t) * 64 * D : sg.V2 + (size_t)((t) - sg.nt1) * 64 * D; \
        _Pragma("unroll") for (int i = 0; i < KC; ++i) st[i] = *(const u32x4*)(vb_ + (size_t)SROW(i) * D + SCH(i) * 8); } while (0)
#define BF2F_LO(w) __uint_as_float((w) << 16)
#define BF2F_HI(w) __uint_as_float((w) & 0xffff0000u)
#define ATT_STOREK(kb, tt) do { asm volatile("s_waitcnt vmcnt(0)" ::: "memory"); _Pragma("unroll") for (int i = 0; i < KC; ++i) *(LAS u32x4*)(lds + (kb) * KBY + SROW(i) * KS + SCH(i) * 16) = st[i]; \
        if (fk) { _Pragma("unroll") for (int i = 0; i < KC; ++i) { const int ch_ = SCH(i), c8_ = ch_ & 7; float* p_ = fk + (size_t)((tt) * 64 + SROW(i)) * 1024 + (ch_ >> 3) * 64 + 32 * (c8_ >> 2) + 4 * (c8_ & 3); \
            st16f(p_, (f32x4){BF2F_LO(st[i].x), BF2F_HI(st[i].x), BF2F_LO(st[i].y), BF2F_HI(st[i].y)}); st16f(p_ + 16, (f32x4){BF2F_LO(st[i].z), BF2F_HI(st[i].z), BF2F_LO(st[i].w), BF2F_HI(st[i].w)}); } } } while (0)
#define ATT_STOREV(vb, tt) do { asm volatile("s_waitcnt vmcnt(0)" ::: "memory"); _Pragma("unroll") for (int i = 0; i < KC; ++i) *(LAS u32x4*)(lds + VOFF + (vb) * VBY + SROW(i) * VS + SCH(i) * 16) = st[i]; \
        if (fv) { _Pragma("unroll") for (int i = 0; i < KC; ++i) { float* p_ = fv + (size_t)((tt) * 64 + SROW(i)) * 1024 + 8 * SCH(i); \
            st16f(p_, (f32x4){BF2F_LO(st[i].x), BF2F_HI(st[i].x), BF2F_LO(st[i].y), BF2F_HI(st[i].y)}); st16f(p_ + 4, (f32x4){BF2F_LO(st[i].z), BF2F_HI(st[i].z), BF2F_LO(st[i].w), BF2F_HI(st[i].w)}); } } } while (0)
#define ATT_BAR() do { asm volatile("s_waitcnt lgkmcnt(0)" ::: "memory"); __builtin_amdgcn_s_barrier(); asm volatile("" ::: "memory"); } while (0)
    ATT_LOADK(0);
    if (NA) { for (int i = tid; i < 465; i += 512) biasl[i] = relb[i] * LOG2E; }
    bf16x8 qf[4];
#pragma unroll
    for (int d0 = 0; d0 < 4; ++d0) qf[d0] = *(const bf16x8*)(Qw + (size_t)(NA ? ((l31 >> 4) * 64 + (l31 & 15)) : l31) * D + d0 * 16 + hi * 8);
    f32x16 o[DVB];
#pragma unroll
    for (int i = 0; i < DVB; ++i) o[i] = f32x16{};
    float mrun = NEG, lsum = 0.f;
    ATT_STOREK(0, 0); ATT_LOADV(0); ATT_STOREV(0, 0);
    ATT_BAR();
    const int rq_l = r_q + (l31 >> 4);
    const int rs_l = NA ? min(max(rq_l - 4, 0), 8) : 0;
    const int rs_w0 = NA ? min(max(r_q - 4, 0), 8) : 0, rs_w1 = NA ? min(max(r_q + 1 - 4, 0), 8) : 0;
    const int kbw = NA ? min(max(16 * jj - 8, 0), 32) : 0;
    const int cq = 16 * jj + (l31 & 15), cs = min(max(cq - 8, 0), 48);
    const int kvoff = VOFF + (4 * hi + ((lane & 15) >> 2)) * VS + ((lane >> 4) & 1) * 32 + (lane & 3) * 8;
    bf16x8 pa[2][2];
#define ATT_QKS(t) do { \
        const LAS unsigned char* kb = lds + ((t) & 1) * KBY + mp * 128 + l31 * KS + hi * 16; \
        f32x16 p0 = f32x16{}, p1 = f32x16{}; \
        _Pragma("unroll") for (int d0 = 0; d0 < 4; ++d0) { \
            const bf16x8 a0 = *(const LAS bf16x8*)(kb + d0 * 32), a1 = *(const LAS bf16x8*)(kb + 32 * KS + d0 * 32); \
            p0 = __builtin_amdgcn_mfma_f32_32x32x16_bf16(a0, qf[d0], p0, 0, 0, 0); \
            p1 = __builtin_amdgcn_mfma_f32_32x32x16_bf16(a1, qf[d0], p1, 0, 0, 0); } \
        if (false) { \
            const int kr = kr_lo + (t); const LAS float* brow = biasl + (kr - r_q + 7) * 31 + 15 - cq; \
            _Pragma("unroll") for (int r = 0; r < 16; ++r) { \
                const int k0 = crow(r, hi), k1 = k0 + 32; \
                const bool v0 = (k0 >= cs) && (k0 < cs + 16), v1 = (k1 >= cs) && (k1 < cs + 16); \
                const float b0 = brow[v0 ? k0 : cq], b1 = brow[v1 ? k1 : cq]; \
                p0[r] = v0 ? p0[r] + b0 : NEG; p1[r] = v1 ? p1[r] + b1 : NEG; } } \
        float tm = fmaxf(fmaxf(p0[0], p1[0]), fmaxf(p0[1], p1[1])); \
        _Pragma("unroll") for (int r = 2; r < 16; r += 2) tm = fmaxf(tm, fmaxf(fmaxf(p0[r], p1[r]), fmaxf(p0[r + 1], p1[r + 1]))); \
        { auto rr_ = __builtin_amdgcn_permlane32_swap(__float_as_uint(tm), __float_as_uint(tm), false, false); tm = fmaxf(__uint_as_float(rr_[0]), __uint_as_float(rr_[1])); } \
        if (__any(tm > mrun + THR)) { \
            const float mn = fmaxf(mrun, tm), al = __builtin_amdgcn_exp2f(mrun - mn); \
            lsum *= al; mrun = mn; \
            if (hi == 0) wsf[l31] = al; \
            LDS_WAIT(); \
            _Pragma("unroll") for (int r = 0; r < 16; ++r) { const float f = wsf[crow(r, hi)]; \
                _Pragma("unroll") for (int i = 0; i < DVB; ++i) o[i][r] *= f; } \
            LDS_WAIT(); } \
        f32x2 sacc = {0.f, 0.f}; \
        _Pragma("unroll") for (int r = 0; r < 16; r += 2) { \
            p0[r] = __builtin_amdgcn_exp2f(p0[r] - mrun); p0[r + 1] = __builtin_amdgcn_exp2f(p0[r + 1] - mrun); p1[r] = __builtin_amdgcn_exp2f(p1[r] - mrun); p1[r + 1] = __builtin_amdgcn_exp2f(p1[r + 1] - mrun); \
            sacc += (f32x2){p0[r], p0[r + 1]}; sacc += (f32x2){p1[r], p1[r + 1]}; } \
        lsum += sacc[0] + sacc[1]; \
        _Pragma("unroll") for (int s_ = 0; s_ < 2; ++s_) { \
            u32x4 w0, w1; \
            w0.x = pk2(p0[8 * s_ + 0], p0[8 * s_ + 1]); w0.y = pk2(p0[8 * s_ + 2], p0[8 * s_ + 3]); w0.z = pk2(p0[8 * s_ + 4], p0[8 * s_ + 5]); w0.w = pk2(p0[8 * s_ + 6], p0[8 * s_ + 7]); \
            w1.x = pk2(p1[8 * s_ + 0], p1[8 * s_ + 1]); w1.y = pk2(p1[8 * s_ + 2], p1[8 * s_ + 3]); w1.z = pk2(p1[8 * s_ + 4], p1[8 * s_ + 5]); w1.w = pk2(p1[8 * s_ + 6], p1[8 * s_ + 7]); \
            pa[0][s_] = __builtin_bit_cast(bf16x8, w0); pa[1][s_] = __builtin_bit_cast(bf16x8, w1); } \
    } while (0)
#define ATT_QKS_W(t) do { \
        const LAS unsigned char* kb = lds + ((t) & 1) * KBY + (kbw + l31) * KS + hi * 16; \
        f32x16 p0 = f32x16{}; \
        _Pragma("unroll") for (int d0 = 0; d0 < 4; ++d0) { const bf16x8 a0 = *(const LAS bf16x8*)(kb + d0 * 32); p0 = __builtin_amdgcn_mfma_f32_32x32x16_bf16(a0, qf[d0], p0, 0, 0, 0); } \
        { const int kr = kr_lo + (t); const bool rowok = (kr >= rs_l) && (kr < rs_l + 8); const LAS float* brow = biasl + (kr - rq_l + 7) * 31 + 15 - cq; \
          _Pragma("unroll") for (int r = 0; r < 16; ++r) { const int k0 = kbw + crow(r, hi); const bool v0 = rowok && (k0 >= cs) && (k0 < cs + 16); const float b0 = brow[v0 ? k0 : cq]; p0[r] = v0 ? p0[r] + b0 : -3.0e38f; } }   \
        float tm = fmaxf(fmaxf(p0[0], p0[1]), fmaxf(p0[2], p0[3])); \
        _Pragma("unroll") for (int r = 4; r < 16; r += 4) tm = fmaxf(tm, fmaxf(fmaxf(p0[r], p0[r + 1]), fmaxf(p0[r + 2], p0[r + 3]))); \
        { auto rr_ = __builtin_amdgcn_permlane32_swap(__float_as_uint(tm), __float_as_uint(tm), false, false); tm = fmaxf(__uint_as_float(rr_[0]), __uint_as_float(rr_[1])); } \
        if (__any(tm > mrun + THR)) { \
            const float mn = fmaxf(mrun, tm), al = __builtin_amdgcn_exp2f(mrun - mn); \
            lsum *= al; mrun = mn; \
            if (hi == 0) wsf[l31] = al; \
            LDS_WAIT(); \
            _Pragma("unroll") for (int r = 0; r < 16; ++r) { const float f = wsf[crow(r, hi)]; \
                _Pragma("unroll") for (int i = 0; i < DVB; ++i) o[i][r] *= f; } \
            LDS_WAIT(); } \
        f32x2 sacc = {0.f, 0.f}; \
        _Pragma("unroll") for (int r = 0; r < 16; r += 2) { p0[r] = __builtin_amdgcn_exp2f(p0[r] - mrun); p0[r + 1] = __builtin_amdgcn_exp2f(p0[r + 1] - mrun); sacc += (f32x2){p0[r], p0[r + 1]}; } \
        lsum += sacc[0] + sacc[1]; \
        _Pragma("unroll") for (int s_ = 0; s_ < 2; ++s_) { u32x4 w0; \
            w0.x = pk2(p0[8 * s_ + 0], p0[8 * s_ + 1]); w0.y = pk2(p0[8 * s_ + 2], p0[8 * s_ + 3]); w0.z = pk2(p0[8 * s_ + 4], p0[8 * s_ + 5]); w0.w = pk2(p0[8 * s_ + 6], p0[8 * s_ + 7]); \
            pa[0][s_] = __builtin_bit_cast(bf16x8, w0); } \
    } while (0)
#define ATT_PV_W(vb_) do { \
        const LAS char* vb = (const LAS char*)(lds + (vb_) * VBY + kvoff + kbw * VS); \
        _Pragma("unroll") for (int d0 = 0; d0 < DVB; ++d0) \
            _Pragma("unroll") for (int s_ = 0; s_ < 2; ++s_) { \
                const s16x4 lo = vtr(vb + (16 * s_) * VS + 64 * d0), hh = vtr(vb + (16 * s_ + 8) * VS + 64 * d0); \
                const bf16x8 vf = (bf16x8){lo[0], lo[1], lo[2], lo[3], hh[0], hh[1], hh[2], hh[3]}; \
                o[d0] = __builtin_amdgcn_mfma_f32_32x32x16_bf16(pa[0][s_], vf, o[d0], 0, 0, 0); } \
    } while (0)
#define ATT_PV(vb_) do { \
        const LAS char* vb = (const LAS char*)(lds + (vb_) * VBY + kvoff); \
        _Pragma("unroll") for (int d0 = 0; d0 < DVB; ++d0) { \
            _Pragma("unroll") for (int blk = 0; blk < 2; ++blk) \
                _Pragma("unroll") for (int s_ = 0; s_ < 2; ++s_) { \
                    const s16x4 lo = vtr(vb + (32 * blk + 16 * s_) * VS + 64 * d0), hh = vtr(vb + (32 * blk + 16 * s_ + 8) * VS + 64 * d0); \
                    const bf16x8 vf = (bf16x8){lo[0], lo[1], lo[2], lo[3], hh[0], hh[1], hh[2], hh[3]}; \
                    o[d0] = __builtin_amdgcn_mfma_f32_32x32x16_bf16(pa[blk][s_], vf, o[d0], 0, 0, 0); } \
            if (d0 & 1) __builtin_amdgcn_sched_barrier(0); } \
    } while (0)
#define ATT_ACTIVE(t) (!(NA && (t) < sg.nt1) || ((kr_lo + (t)) >= rs_w0 && (kr_lo + (t)) < rs_w1 + 8))
    int vcur = 0, vprev = 2;
    if constexpr (DIFF) {
        bool act_prev = false;
        for (int t = 0; t < nt; ++t) {
            const bool more = (t + 1 < nt);
            if (more) ATT_LOADK(t + 1);
            const bool act = ATT_ACTIVE(t);
            if (!grpB) { if (act) ATT_QKS(t); } else { if (act_prev) ATT_PV(vprev); }
            if (more) { ATT_STOREK((t + 1) & 1, t + 1); }
            ATT_BAR();
            if (more) ATT_LOADV(t + 1);
            if (!grpB) { if (act) ATT_PV(vcur); } else { if (act) ATT_QKS(t); }
            const int vnext = vcur == 2 ? 0 : vcur + 1;
            if (more) { ATT_STOREV(vnext, t + 1); }
            ATT_BAR();
            vprev = vcur; vcur = vnext; act_prev = act;
        }
        if (grpB && act_prev) ATT_PV(vprev);
        ATT_BAR();
    } else {
        for (int t = 0; t < nt; ++t) {
            const bool more = (t + 1 < nt);
            u32x4 st2[KC];
            if (more) { ATT_LOADK(t + 1); const bf16_t* vb_ = (t + 1) < sg.nt1 ? sg.V1 + (size_t)(t + 1) * 64 * D : sg.V2 + (size_t)((t + 1) - sg.nt1) * 64 * D;
#pragma unroll
                for (int i = 0; i < KC; ++i) st2[i] = *(const u32x4*)(vb_ + (size_t)SROW(i) * D + SCH(i) * 8); }
            if (ATT_ACTIVE(t)) { if (NA && t < sg.nt1) { ATT_QKS_W(t); ATT_PV_W(vcur); } else { ATT_QKS(t); ATT_PV(vcur); } }
            const int vnext = vcur == 2 ? 0 : vcur + 1;
            if (more) { ATT_STOREK((t + 1) & 1, t + 1);
#pragma unroll
                for (int i = 0; i < KC; ++i) { *(LAS u32x4*)(lds + VOFF + vnext * VBY + SROW(i) * VS + SCH(i) * 16) = st2[i];
                    if (fv) { float* p_ = fv + (size_t)((t + 1) * 64 + SROW(i)) * 1024 + 8 * SCH(i);
                        st16f(p_, (f32x4){BF2F_LO(st2[i].x), BF2F_HI(st2[i].x), BF2F_LO(st2[i].y), BF2F_HI(st2[i].y)}); st16f(p_ + 4, (f32x4){BF2F_LO(st2[i].z), BF2F_HI(st2[i].z), BF2F_LO(st2[i].w), BF2F_HI(st2[i].w)}); } } }
            ATT_BAR();
            vcur = vnext;
        }
    }
#undef ATT_LOADK
#undef ATT_LOADV
#undef ATT_STOREK
#undef ATT_STOREV
#undef BF2F_LO
#undef BF2F_HI
#undef SROW
#undef SCH
#undef ATT_QKS
#undef ATT_PV
#undef ATT_ACTIVE
#undef ATT_QKS_W
#undef ATT_PV_W
    { auto rr_ = __builtin_amdgcn_permlane32_swap(__float_as_uint(lsum), __float_as_uint(lsum), false, false); lsum = __uint_as_float(rr_[0]) + __uint_as_float(rr_[1]); }
    if (hi == 0) wsf[l31] = 1.f / lsum;
    LDS_WAIT();
    float inv[16];
#pragma unroll
    for (int r = 0; r < 16; ++r) inv[r] = wsf[crow(r, hi)];
    LDS_WAIT();
    if constexpr (!DIFF) {
        LAS bf16_t* stg = (LAS bf16_t*)(lds + OST_OFF) + wid * 2048;
#pragma unroll
        for (int r = 0; r < 16; ++r) { const int q = crow(r, hi);
#pragma unroll
            for (int d0 = 0; d0 < 2; ++d0) { const unsigned w = pk2(o[d0][r] * inv[r], 0.f); stg[q * 64 + d0 * 32 + l31] = (bf16_t)(w & 0xffffu); } }
        LDS_WAIT();
#pragma unroll
        for (int i = 0; i < 4; ++i) { const int row = i * 8 + (lane >> 3), ch = lane & 7; const u32x4 v = *(const LAS u32x4*)(stg + row * 64 + ch * 8); st16(Ow + (size_t)(NA ? ((row >> 4) * 64 + (row & 15)) : row) * D + ch * 8, v); }
        LDS_WAIT();
        ATT_BAR();
    } else {
        constexpr int RS = 132;
        LAS float* ex = (LAS float*)lds + (wid & 3) * 32 * RS;
        if (mp == 1) {
#pragma unroll
            for (int r = 0; r < 16; ++r) { const int q = crow(r, hi); const float f = inv[r] * lam;
#pragma unroll
                for (int d0 = 0; d0 < 4; ++d0) ex[q * RS + d0 * 32 + l31] = o[d0][r] * f; }
        }
        ATT_BAR();
        if (mp == 0) {
#pragma unroll
            for (int r = 0; r < 16; ++r) { const int q = crow(r, hi);
#pragma unroll
                for (int d0 = 0; d0 < 4; ++d0) { LAS float* p = ex + q * RS + d0 * 32 + l31; *p = o[d0][r] * inv[r] - *p; } }
            LDS_WAIT();
            { const LAS float* rp = ex + l31 * RS + hi * 64; float ss = 0.f;
#pragma unroll
              for (int j = 0; j < 16; ++j) { const f32x4 v = *(const LAS f32x4*)(rp + 4 * j); ss += (v[0] * v[0] + v[1] * v[1]) + (v[2] * v[2] + v[3] * v[3]); }
              { auto rr_ = __builtin_amdgcn_permlane32_swap(__float_as_uint(ss), __float_as_uint(ss), false, false); ss = __uint_as_float(rr_[0]) + __uint_as_float(rr_[1]); }
              if (hi == 0) wsf[l31] = rsqrtf(ss * (1.f / 128.f) + EPS) * post_scale; }
            LDS_WAIT();
            const int ch = lane & 15; const f32x4 g0 = *(const f32x4*)(subg + 8 * ch), g1 = *(const f32x4*)(subg + 8 * ch + 4);
#pragma unroll
            for (int i = 0; i < 8; ++i) { const int row = i * 4 + (lane >> 4); const float rstd = wsf[row];
                const f32x4 a = *(const LAS f32x4*)(ex + row * RS + 8 * ch) * rstd * g0, b = *(const LAS f32x4*)(ex + row * RS + 8 * ch + 4) * rstd * g1;
                u32x4 w; w.x = pk2(a[0], a[1]); w.y = pk2(a[2], a[3]); w.z = pk2(b[0], b[1]); w.w = pk2(b[2], b[3]);
                st16(Ow + (size_t)row * D + 8 * ch, w); }
        }
        LDS_WAIT();
        ATT_BAR();
    }
#undef ATT_BAR
}
}

#define XB_TMO      128
#define XB_XCNT(j)  (256  + 64 * (j))
#define XB_XSUB(j)  (1280 + 64 * (j))
#define XB_XGEN(j)  (2304 + 64 * (j))
#define XB_TOP      3328
#define XB_TOPGEN   3392
#define XCD_BAR_WORDS 3456
#define XB_SPIN_CAP (1u << 18)
__device__ __forceinline__ unsigned xb_ld(unsigned* p)              { return __hip_atomic_load(p, __ATOMIC_RELAXED, __HIP_MEMORY_SCOPE_AGENT); }
__device__ __forceinline__ unsigned xb_add(unsigned* p, unsigned v) { return __hip_atomic_fetch_add(p, v, __ATOMIC_RELAXED, __HIP_MEMORY_SCOPE_AGENT); }
__device__ __forceinline__ unsigned xb_xcc_id() { return (unsigned)__builtin_amdgcn_s_getreg((3 << 11) | 20) & 0xFu; }
#define XB_SPIN(cond, bar) do { unsigned _sp = 0; while (cond) { __builtin_amdgcn_s_sleep(1); \
    if ((++_sp & 255u) == 0u) { if (xb_ld(&(bar)[XB_TMO])) break; if (_sp > XB_SPIN_CAP) { atomicAdd(&(bar)[XB_TMO], 1u); break; } } } } while (0)
struct XcdBarrier { unsigned* bar; unsigned x; volatile LAS unsigned* st; unsigned n; };
__device__ __forceinline__ XcdBarrier xcd_barrier_post(unsigned* bar, volatile LAS unsigned* st, unsigned n) {
    XcdBarrier b; b.bar = bar; b.x = xb_xcc_id(); b.st = st; b.n = n;
    if (threadIdx.x == 0) (void)xb_add(&bar[XB_XCNT(b.x)], 1u);
    return b;
}
__device__ __forceinline__ void xcd_barrier_complete(unsigned* bar, unsigned x, unsigned G, unsigned& nloc, unsigned& nx) {
    unsigned sum, cnt, mine, sp = 0u;
    for (;;) {
        sum = 0u; cnt = 0u; mine = 0u;
#pragma unroll
        for (unsigned j = 0; j < 16; ++j) { const unsigned c = xb_ld(&bar[XB_XCNT(j)]); sum += c; cnt += (c > 0u) ? 1u : 0u; mine = (j == x) ? c : mine; }
        if (sum == G) break;
        __builtin_amdgcn_s_sleep(1);
        if ((++sp & 255u) == 0u) { if (xb_ld(&bar[XB_TMO])) break; if (sp > XB_SPIN_CAP) { atomicAdd(&bar[XB_TMO], 1u); break; } }
    }
    nloc = mine > 0u ? mine : 1u; nx = cnt > 0u ? cnt : 1u;
}
__device__ __forceinline__ void xcd_barrier(const XcdBarrier& b, const bool leader  ) {
    asm volatile("s_waitcnt vmcnt(0)" ::: "memory");
    __syncthreads();
    if (leader) {
        unsigned* bar = b.bar;
        __builtin_amdgcn_s_waitcnt(0);
        unsigned nloc = b.st[0], nx = b.st[1];
        if (nloc == 0u) { xcd_barrier_complete(bar, b.x, b.n, nloc, nx); b.st[0] = nloc; b.st[1] = nx; }
        const unsigned old = xb_add(&bar[XB_XSUB(b.x)], 1u);
        const unsigned gen = old / nloc;
        if (old + 1u == (gen + 1u) * nloc) {
            __builtin_amdgcn_fence(__ATOMIC_RELEASE, "agent");
            asm volatile("s_waitcnt vmcnt(0)" ::: "memory");
            const unsigned og = xb_add(&bar[XB_TOP], 1u);
            const unsigned tg = og / nx;
            if (og + 1u == (tg + 1u) * nx) xb_add(&bar[XB_TOPGEN], 1u);
            else XB_SPIN(xb_ld(&bar[XB_TOPGEN]) == tg, bar);
            __builtin_amdgcn_fence(__ATOMIC_ACQUIRE, "agent");
            xb_add(&bar[XB_XGEN(b.x)], 1u);
            asm volatile("s_waitcnt vmcnt(0)" ::: "memory");
        } else {
            XB_SPIN(xb_ld(&bar[XB_XGEN(b.x)]) == gen, bar);
            __builtin_amdgcn_fence(__ATOMIC_ACQUIRE, "agent");
            asm volatile("s_waitcnt vmcnt(0)" ::: "memory");
        }
    }
    __syncthreads();
}

__device__ __forceinline__ void xcc_barrier(unsigned* cnt, unsigned* tmo, const bool leader) {
    asm volatile("s_waitcnt vmcnt(0)" ::: "memory");
    __syncthreads();
    if (leader) {
        const unsigned old = xb_add(cnt, 1u); const unsigned target = (old / 32u + 1u) * 32u;
        unsigned sp = 0u;
        while (xb_ld(cnt) < target) { __builtin_amdgcn_s_sleep(1); if ((++sp & 255u) == 0u) { if (xb_ld(tmo)) break; if (sp > XB_SPIN_CAP) { atomicAdd(tmo, 1u); break; } } }
        __builtin_amdgcn_fence(__ATOMIC_ACQUIRE, "agent");
        asm volatile("s_waitcnt vmcnt(0)" ::: "memory");
    }
    __syncthreads();
}

struct Args { const float* in[28]; float* out; unsigned char* ws; int ph_lo, ph_hi; };
typedef const __attribute__((address_space(4))) Args* CArgs;
__device__ __forceinline__ CArgs args_ptr() { unsigned long long p = (unsigned long long)__builtin_amdgcn_kernarg_segment_ptr(); asm volatile("" : "+s"(p)); return (CArgs)p; }

template <bool QKVMAP>
__device__ __forceinline__ void transpose_item(const float* W, int K, int N, bf16_t* WT, int item, int lane, LAS unsigned char* tile) {
    const int nblk = N / 64, kb = item / nblk, nb = item % nblk, k0 = 64 * kb, n0 = 64 * nb;
    const int ng = lane & 15, q = lane >> 4;
    const float* src = W + (size_t)(k0 + 16 * q) * N + n0 + 4 * ng;
    f32x4 v[16];
#pragma unroll
    for (int j = 0; j < 16; ++j) v[j] = *(const f32x4*)(src + (size_t)j * N);
#pragma unroll
    for (int nn = 0; nn < 4; ++nn)
#pragma unroll
        for (int c = 0; c < 2; ++c) { u32x4 w; w.x = pk2(v[8 * c][nn], v[8 * c + 1][nn]); w.y = pk2(v[8 * c + 2][nn], v[8 * c + 3][nn]); w.z = pk2(v[8 * c + 4][nn], v[8 * c + 5][nn]); w.w = pk2(v[8 * c + 6][nn], v[8 * c + 7][nn]);
            *(LAS u32x4*)(tile + (4 * ng + nn) * 144 + (16 * q + 8 * c) * 2) = w; }
    LDS_WAIT(); asm volatile("" ::: "memory");
#pragma unroll
    for (int i = 0; i < 8; ++i) { const int r = 8 * i + (lane >> 3), ch = lane & 7; const u32x4 w = *(const LAS u32x4*)(tile + r * 144 + ch * 16);
        const int n = n0 + r; int nr = n;
        if (QKVMAP && n < 2048) { const int c = n & 255; nr = (n - c) + ((c & 63) >> 5) * 128 + (c >> 6) * 32 + (c & 31); }
        st16(WT + (size_t)nr * K + k0 + 8 * ch, w); }
    LDS_WAIT(); asm volatile("" ::: "memory");
}

__global__ void __launch_bounds__(512, 2) fwd_kernel(Args args_by_value_unused) {
    extern __shared__ __attribute__((aligned(16))) unsigned char lds_raw[];
    LAS unsigned char* lds = (LAS unsigned char*)lds_raw;
    const int tid = threadIdx.x, lane = tid & 63; const int wave = __builtin_amdgcn_readfirstlane(tid >> 6);
    constexpr int G = 256;
#define PBX() ({ int b_ = __builtin_amdgcn_readfirstlane((int)MISC[14]); asm volatile("" : "+s"(b_)); b_; })
#define PTID() ({ unsigned z_ = 0u; asm volatile("" : "+v"(z_)); (int)(wave * 64 + (int)__builtin_amdgcn_mbcnt_hi(~0u, __builtin_amdgcn_mbcnt_lo(~0u, z_))); })
#define VCU(b_) (((b_) & 7) * 32 + ((b_) >> 3))
    int lo, hi;
    volatile LAS unsigned* MISC = (volatile LAS unsigned*)(lds + MISC_OFF);
    for (int u = tid; u < (LDS_BYTES - LDSCTL_OFF) / 4; u += 512) ((LAS unsigned*)(lds + LDSCTL_OFF))[u] = 0u;
    __syncthreads();
#define STRM(b_) (((b_) & 7) / (8 / NS))
#define LBI(b_) ((((b_) & 7) % (8 / NS)) * 32 + ((b_) >> 3))
    { CArgs A = args_ptr(); lo = A->ph_lo; hi = A->ph_hi; unsigned* ctl = (unsigned*)(A->ws + WS_CTL);
      if (tid == 0) { MISC[14] = blockIdx.x; MISC[15] = 0u;
          if (MK_SINGLE) { const unsigned x = xb_xcc_id(); const unsigned idx = xb_add(&(ctl + CW_BAR)[XB_XCNT(x)], 1u); MISC[13] = idx * 8u + x; } }
      __syncthreads(); }
#define MAKE_BAR(bq_, k) XcdBarrier bq_; { CArgs Ab_ = args_ptr(); unsigned* ctl_ = (unsigned*)(Ab_->ws + WS_CTL); const bool glob_ = (k) <= 1; \
        bq_.bar = ctl_ + CW_BAR + (glob_ ? 0 : (1 + STRM(PBX())) * XCD_BAR_WORDS); bq_.x = xb_xcc_id(); bq_.st = MISC + (glob_ ? 8 : 10); bq_.n = (unsigned)(glob_ ? G : G / NS); }
#define IN(k) (lo <= (k) && (k) < hi)
#define SEAM(k) do { if (PROBE_KL == 2 && (k) == PROBE_PH && PTID() == 0) pt2 = __builtin_amdgcn_s_memrealtime(); if (PROBE_KL == 3 && (k) == PROBE_PH) { asm volatile("s_waitcnt vmcnt(0)" ::: "memory"); if (PTID() == 0) pt2 = __builtin_amdgcn_s_memrealtime(); } if (IN(k) && IN((k) + 1)) { MAKE_BAR(bq_, k); for (int d_ = 0; d_ < DUP_BAR; ++d_) xcd_barrier(bq_, PTID() == 0); } \
        if (PROBE_PH >= 0 && PTID() == 0) { if ((k) + 1 == PROBE_PH) pt0 = __builtin_amdgcn_s_memrealtime(); if ((k) == PROBE_PH) { pt1 = __builtin_amdgcn_s_memrealtime(); if (PROBE_KL >= 2) pt1 = pt2; if (PROBE_KL == 1) { CArgs A_ = args_ptr(); pt1 = __hip_atomic_load((unsigned long long*)(A_->ws + 512), __ATOMIC_RELAXED, __HIP_MEMORY_SCOPE_AGENT); } } } } while (0)
    constexpr int NGW = G * 8;
#define SEAMX(k) do { if (IN(k) && IN((k) + 1) && __builtin_amdgcn_readfirstlane((int)MISC[15])) { CArgs Ax_ = args_ptr(); unsigned* ctlx_ = (unsigned*)(Ax_->ws + WS_CTL); \
        xcc_barrier(ctlx_ + CW_XL + 64 * (xb_xcc_id() & 7u), ctlx_ + CW_BAR + XB_TMO, PTID() == 0); \
        if (PROBE_PH >= 0 && PTID() == 0) { if ((k) + 1 == PROBE_PH) pt0 = __builtin_amdgcn_s_memrealtime(); if ((k) == PROBE_PH) pt1 = __builtin_amdgcn_s_memrealtime(); } } else SEAM(k); } while (0)
    volatile LAS unsigned long long* PTS = (volatile LAS unsigned long long*)(lds + MISC_OFF + 64);
#define pt0 PTS[0]
#define pt1 PTS[1]
#define pt2 PTS[2]
    if (PROBE_PH >= 0 && tid == 0) pt0 = __builtin_amdgcn_s_memrealtime();

    if (EN_PRO && IN(0)) for (int dup_ = 0; dup_ < DUP_PRO; ++dup_) {
        const int bx = PBX(); const int gw = VCU(bx) * 8 + wave;
        {
            CArgs A = args_ptr();
            LAS float* sl = (LAS float*)lds;
            LAS f32x4* red = (LAS f32x4*)(lds + 20480);
            const float* c = A->in[6]; const float* cctx = A->in[7]; float* mod = (float*)(A->ws + WS_MOD);
            for (int idx = tid; idx < 5120; idx += 512) { const int n = idx >> 10, k = idx & 1023; const float x = n == 0 ? cctx[k] : c[(n - 1) * 1024 + k]; sl[idx] = x / (1.f + __expf(-x)); }
            __syncthreads();
            for (int wq = bx; wq < 256; wq += G) {
                const int l = wq >> 6, cb = (wq & 63) * 96;
                if (tid < 384) {
                    const int cg = tid % 24, ks = tid / 24;
                    const float* wp = A->in[8] + ((size_t)l * 1024 + ks * 64) * 6144 + cb + 4 * cg;
                    f32x4 a[5];
#pragma unroll
                    for (int n = 0; n < 5; ++n) a[n] = (f32x4){0.f, 0.f, 0.f, 0.f};
#pragma unroll 8
                    for (int k = 0; k < 64; ++k) { const f32x4 w4 = *(const f32x4*)(wp + (size_t)k * 6144);
#pragma unroll
                        for (int n = 0; n < 5; ++n) a[n] += sl[n * 1024 + ks * 64 + k] * w4; }
#pragma unroll
                    for (int n = 0; n < 5; ++n) red[(ks * 24 + cg) * 5 + n] = a[n];
                }
                __syncthreads();
                if (tid < 120) { const int cg = tid / 5, n = tid % 5; f32x4 s = *(const f32x4*)(A->in[9] + l * 6144 + cb + 4 * cg);
                    for (int ks = 0; ks < 16; ++ks) s += red[(ks * 24 + cg) * 5 + n];
                    *(f32x4*)(mod + ((size_t)l * 5 + n) * 6144 + cb + 4 * cg) = s; }
                __syncthreads();
            }
        }
        if (bx == 0) {
            CArgs A = args_ptr(); float* ropet = (float*)(A->ws + WS_ROPE);
            for (int idx = tid; idx < 1024; idx += 512) { const int pos = idx >> 4, j = idx & 15; const float fr = powf(10000.f, -(float)j / 16.f); const float ang = (float)pos * fr; ropet[2 * idx] = cosf(ang); ropet[2 * idx + 1] = sinf(ang); }
        }
        if (bx == 1 % G && wave < 2) {
            CArgs A = args_ptr(); float* lamv = (float*)(A->ws + WS_LAM);
            const int i = wave; const float a1 = A->in[18][i * 64 + lane] * A->in[19][i * 64 + lane], a2 = A->in[20][i * 64 + lane] * A->in[21][i * 64 + lane];
            const float s1 = wave_sum(a1), s2 = wave_sum(a2); const float linit = 0.8f - 0.6f * expf(-0.3f * (float)(2 * i));
            if (lane == 0) lamv[i] = expf(s1) - expf(s2) + linit;
        }
        {
            CArgs A = args_ptr(); bf16_t* cache = (bf16_t*)(A->ws + WS_CACHE);
            for (int ch = gw * 64 + lane; ch < 4 * 2 * 4 * 256 * 128; ch += NGW * 64) {
                const int c8 = ch & 127, t = (ch >> 7) & 255, b = (ch >> 15) & 3, i = (ch >> 17) & 1, kind = ch >> 18;
                const float* src = A->in[2 + kind] + (((size_t)(b * 2 + i) * 256 + t) * 1024);
                f32x4 v0, v1;
                if ((kind & 1) == 0) { const int Gh = c8 >> 3, p8 = c8 & 7, bj = p8 >> 2, fq = p8 & 3; const float* sp = src + 64 * Gh + 32 * bj + 4 * fq; v0 = *(const f32x4*)sp; v1 = *(const f32x4*)(sp + 16); }
                else { v0 = *(const f32x4*)(src + 8 * c8); v1 = *(const f32x4*)(src + 8 * c8 + 4); }
                u32x4 w; w.x = pk2(v0[0], v0[1]); w.y = pk2(v0[2], v0[3]); w.z = pk2(v1[0], v1[1]); w.w = pk2(v1[2], v1[3]);
                st16(cache + (size_t)ch * 8, w);
            }
        }
        {
            constexpr int I_QKV = 16 * 48, I_O = 16 * 16, I_1 = 16 * 64, I_2 = 64 * 16, I_L = I_QKV + I_O + I_1 + I_2;
            LAS unsigned char* ttile = lds + 65536 + wave * 9216;
            for (int it = gw; it < DEPTH * I_L; it += NGW) {
                CArgs A = args_ptr();
                const int l = it / I_L, i = l >> 1; int r = it % I_L;
                unsigned char* wl = A->ws + WS_W + (size_t)l * W_LAYER;
                if (r < I_QKV) { transpose_item<true>(A->in[(l & 1) ? 23 : 14] + (size_t)i * 1024 * 3072, 1024, 3072, (bf16_t*)(wl + W_QKV), r, lane, ttile); continue; } r -= I_QKV;
                if (r < I_O) { transpose_item<false>(A->in[(l & 1) ? 24 : 15] + (size_t)i * 1024 * 1024, 1024, 1024, (bf16_t*)(wl + W_O), r, lane, ttile); continue; } r -= I_O;
                if (r < I_1) { transpose_item<false>(A->in[12] + (size_t)l * 1024 * 4096, 1024, 4096, (bf16_t*)(wl + W_1), r, lane, ttile); continue; } r -= I_1;
                transpose_item<false>(A->in[13] + (size_t)l * 4096 * 1024, 4096, 1024, (bf16_t*)(wl + W_2), r, lane, ttile);
            }
        }
    }
    SEAM(0);
    if (MK_SINGLE && IN(0) && IN(1)) {
        if (PTID() == 0) { CArgs A = args_ptr(); unsigned* bar0 = (unsigned*)(A->ws + WS_CTL) + CW_BAR; bool ok = xb_xcc_id() < 8u;
#pragma unroll
            for (unsigned j = 0; j < 8; ++j) ok = ok && (xb_ld(&bar0[XB_XCNT(j)]) == 32u);
            if (XCC_MODE && ok) { MISC[14] = MISC[13]; MISC[15] = 1u; } }
        __syncthreads();
        if (PTID() == 0) { CArgs A = args_ptr(); unsigned* ctl = (unsigned*)(A->ws + WS_CTL); (void)xb_add(&(ctl + CW_BAR + (1 + STRM(PBX())) * XCD_BAR_WORDS)[XB_XCNT(xb_xcc_id())], 1u); }
    }
    if (EN_NORM && IN(1)) for (int dup_ = 0; dup_ < DUP_NORM; ++dup_) {
        {
            CArgs A = args_ptr(); const int ptid = PTID(); const int lane = ptid & 63; const int gwv = VCU(PBX()) * 8 + __builtin_amdgcn_readfirstlane(ptid >> 6);
            const float* gam = A->in[10]; const float* modl = (const float*)(A->ws + WS_MOD); bf16_t* XN = (bf16_t*)(A->ws + WS_XN); float* ssq = (float*)(A->ws + WS_SSQ);
            for (int rb = gwv * 4; rb < M; rb += NGW * 4) {
                const float* xr = rb < MP ? A->in[0] + (size_t)rb * D : A->in[1] + (size_t)(rb - MP) * D;
                const float* sc = modl + (rb < MP ? 0 : 1 + ((rb - MP) >> 10)) * 6144 + 1024;
                f32x4 v[4][4];
#pragma unroll
                for (int q = 0; q < 4; ++q)
#pragma unroll
                    for (int j = 0; j < 4; ++j) v[q][j] = *(const f32x4*)(xr + (size_t)q * D + 4 * lane + 256 * j);
                f32x4 gs[4];
#pragma unroll
                for (int j = 0; j < 4; ++j) { const int c = 4 * lane + 256 * j; gs[j] = *(const f32x4*)(gam + c) * (1.f + *(const f32x4*)(sc + c)); }
#pragma unroll
                for (int q = 0; q < 4; ++q) {
                    float ss = 0.f;
#pragma unroll
                    for (int j = 0; j < 4; ++j) ss += (v[q][j][0] * v[q][j][0] + v[q][j][1] * v[q][j][1]) + (v[q][j][2] * v[q][j][2] + v[q][j][3] * v[q][j][3]);
                    ss = wave_sum(ss);
#pragma unroll
                    for (int j = 0; j < 4; ++j) { const f32x4 h = v[q][j] * gs[j]; u32x2 w; w.x = pk2(h[0], h[1]); w.y = pk2(h[2], h[3]); st8(XN + (size_t)(rb + q) * D + 4 * lane + 256 * j, w); }
                    if (lane < 32) st4f(ssq + (size_t)(rb + q) * 32 + lane, ss * (1.f / 32.f));
                }
            }
        }
        {
            CArgs A = args_ptr(); const int ptid = PTID(); const int lane = ptid & 63; const int gwv = VCU(PBX()) * 8 + __builtin_amdgcn_readfirstlane(ptid >> 6);
            const float* mod = (const float*)(A->ws + WS_MOD); float* swt = (float*)(A->ws + WS_SW);
            for (int wk = gwv; wk < DEPTH * 448; wk += NGW) {
                const int l = wk / 448, r0 = (wk % 448) * 16;
                const bf16_t* wbase = r0 < 3072 ? (const bf16_t*)(A->ws + WS_W + (size_t)l * W_LAYER + W_QKV) + (size_t)r0 * 1024 : (const bf16_t*)(A->ws + WS_W + (size_t)l * W_LAYER + W_1) + (size_t)(r0 - 3072) * 1024;
                const float* sh = mod + (size_t)l * 5 * 6144 + (r0 < 3072 ? 0 : 3) * 1024 + 8 * lane;
                f32x4 sv[5][4];
#pragma unroll
                for (int n = 0; n < 5; ++n) { sv[n][0] = *(const f32x4*)(sh + n * 6144); sv[n][1] = *(const f32x4*)(sh + n * 6144 + 4); sv[n][2] = *(const f32x4*)(sh + n * 6144 + 512); sv[n][3] = *(const f32x4*)(sh + n * 6144 + 516); }
#pragma unroll 1
                for (int rq = 0; rq < 16; rq += 4) {
                    u32x4 w0[4], w1[4];
#pragma unroll
                    for (int q = 0; q < 4; ++q) { w0[q] = *(const u32x4*)(wbase + (size_t)(rq + q) * 1024 + 8 * lane); w1[q] = *(const u32x4*)(wbase + (size_t)(rq + q) * 1024 + 512 + 8 * lane); }
#pragma unroll
                    for (int q = 0; q < 4; ++q) {
                        float wf[16];
#pragma unroll
                        for (int j = 0; j < 4; ++j) { wf[2 * j] = __uint_as_float(w0[q][j] << 16); wf[2 * j + 1] = __uint_as_float(w0[q][j] & 0xffff0000u); wf[8 + 2 * j] = __uint_as_float(w1[q][j] << 16); wf[8 + 2 * j + 1] = __uint_as_float(w1[q][j] & 0xffff0000u); }
                        float a[5];
#pragma unroll
                        for (int n = 0; n < 5; ++n) {
                            a[n] = ((wf[0] * sv[n][0][0] + wf[1] * sv[n][0][1]) + (wf[2] * sv[n][0][2] + wf[3] * sv[n][0][3])) + ((wf[4] * sv[n][1][0] + wf[5] * sv[n][1][1]) + (wf[6] * sv[n][1][2] + wf[7] * sv[n][1][3]))
                                 + ((wf[8] * sv[n][2][0] + wf[9] * sv[n][2][1]) + (wf[10] * sv[n][2][2] + wf[11] * sv[n][2][3])) + ((wf[12] * sv[n][3][0] + wf[13] * sv[n][3][1]) + (wf[14] * sv[n][3][2] + wf[15] * sv[n][3][3]));
                            a[n] = wave_sum(a[n]); }
                        if (lane < 5) { const float v = lane == 0 ? a[0] : lane == 1 ? a[1] : lane == 2 ? a[2] : lane == 3 ? a[3] : a[4]; swt[((size_t)l * 5 + lane) * 7168 + r0 + rq + q] = v; }
                    }
                }
            }
        }
    }
    if (MICRO_PAT && IN(1)) {
        CArgs A = args_ptr(); const int ptid = PTID(); const int lane = ptid & 63; const int gwv = VCU(PBX()) * 8 + __builtin_amdgcn_readfirstlane(ptid >> 6);
        unsigned char* base = A->ws + WS_H + (size_t)gwv * 32768;
        const u32x4 val = {1u, 2u, 3u, (unsigned)lane};
        for (int rep = 0; rep < MICRO_REP; ++rep)
#pragma unroll 8
            for (int it = 0; it < 32; ++it) {
                unsigned char* p;
                if (MICRO_PAT == 1) p = base + it * 1024 + lane * 16;
                else if (MICRO_PAT == 2) p = base + (it >> 1) * 2048 + lane * 32 + (it & 1) * 16;
                else if (MICRO_PAT == 3) p = base + (lane >> 2) * 2048 + (it) * 64 + (lane & 3) * 16;
                else p = base + lane * 512 + it * 16;
                *(u32x4*)p = val; }
    }
    SEAM(1);
    if (NS > 1 && STREAM_DELAY_US > 0 && IN(1) && IN(2)) { const int strm = STRM(blockIdx.x); const unsigned long long t0_ = __builtin_amdgcn_s_memrealtime(); while (__builtin_amdgcn_s_memrealtime() - t0_ < (unsigned long long)(strm * STREAM_DELAY_US * 100)) __builtin_amdgcn_s_sleep(32); }

    for (int l = 0; l < DEPTH; ++l) {
        const int pb = 2 + 5 * l, i = l >> 1; const bool diff = (l & 1) == 0;
        if (EN_QKV && IN(pb + 0)) for (int dup_ = 0; dup_ < DUP_QKV; ++dup_) {
            {
                CArgs A = args_ptr(); unsigned char* ws = A->ws; const int ptid = PTID(); const int pbx = PBX(); const bf16_t* wq = (const bf16_t*)(ws + WS_W + (size_t)l * W_LAYER + W_QKV);
                pg8::Gemm g{(const bf16_t*)(ws + WS_XN), wq, 1024, (unsigned long long*)(ws + 512)}; pg8::StaticOrder S; S.init(8, STRM(pbx), LBI(pbx));
                pg8::EpiQK E{ws, A->in[diff ? 16 : 25] + i * 64, A->in[diff ? 17 : 26] + i * 64, A->out + (diff ? OUT_DK : OUT_NK) + (size_t)i * 256 * 1024, l, diff};
                pg8::gemm_phase<pg8::EpiQK, 2, true>(lds, g, S, E, ptid);
            }
            {
                CArgs A = args_ptr(); unsigned char* ws = A->ws; const int ptid = PTID(); const int pbx = PBX(); const bf16_t* wq = (const bf16_t*)(ws + WS_W + (size_t)l * W_LAYER + W_QKV);
                pg8::Gemm g{(const bf16_t*)(ws + WS_XN), wq + (size_t)2048 * 1024, 1024, (unsigned long long*)(ws + 512)}; pg8::StaticOrder S; S.init(8, STRM(pbx), LBI(pbx));
                pg8::EpiV E{(bf16_t*)(ws + WS_V), A->out + (diff ? OUT_DV : OUT_NV) + (size_t)i * 256 * 1024, (const float*)(ws + WS_SSQ), (const float*)(ws + WS_SW) + (size_t)l * 5 * 7168};
                pg8::gemm_phase_n1<pg8::EpiV, true>(lds, g, S, E, ptid);
            }
        }
        SEAM(pb + 0);
        if (EN_ATT && IN(pb + 1)) {
            { const int abx = PBX(); const int v = LBI(abx), strm = STRM(abx); constexpr int HB = 16 / NS, LB = 4 / NS;
                if (diff) {
                    const float linit = 0.8f - 0.6f * expf(-0.3f * (float)l);
                    for (int dup_ = 0; dup_ < DUP_ADP; ++dup_) {
                        CArgs A = args_ptr(); unsigned char* ws = A->ws; const int ptid = PTID(); const int pbx = PBX(); const bf16_t* Qb = (const bf16_t*)(ws + WS_Q); const bf16_t* Kb = (const bf16_t*)(ws + WS_K); const bf16_t* Vb = (const bf16_t*)(ws + WS_V); bf16_t* Ob = (bf16_t*)(ws + WS_O);
                        const float lam = ((const float*)(ws + WS_LAM))[i]; const float* subg = A->in[22] + i * 128;
                        const int pw = __builtin_amdgcn_readfirstlane(ptid >> 6), rg = pw & 3, mp = pw >> 2; const int b = strm * HB + (v >> 4), h = (v >> 1) & 7, qb = v & 1; const int q0 = b * 256 + qb * 128 + rg * 32;
                        att::Seg sg{Kb + (size_t)(b * 256) * D + h * 128, Vb + (size_t)(b * 256) * D + h * 128, 4, nullptr, nullptr, 0};
                        float* fo = A->out + (size_t)(b * 2 + i) * 256 * 1024 + h * 128;
                        att::attn_unit<true, false>(ptid, lds, Qb + (size_t)q0 * D + h * 128 + mp * 64, sg, Ob + (size_t)q0 * D + h * 128, 0, 0, 0, nullptr, lam, 1.f - linit, subg, qb == 0 ? fo + OUT_DK : nullptr, qb == 1 ? fo + OUT_DV : nullptr);
                    }
                    for (int dup_ = 0; dup_ < DUP_ADL; ++dup_) {
                        CArgs A = args_ptr(); unsigned char* ws = A->ws; const int ptid = PTID(); const int pbx = PBX(); const bf16_t* Qb = (const bf16_t*)(ws + WS_Q); const bf16_t* Kb = (const bf16_t*)(ws + WS_K); const bf16_t* Vb = (const bf16_t*)(ws + WS_V); bf16_t* Ob = (bf16_t*)(ws + WS_O);
                        const bf16_t* cache = (const bf16_t*)(ws + WS_CACHE);
                        const float lam = ((const float*)(ws + WS_LAM))[i]; const float* subg = A->in[22] + i * 128;
                        const int pw = __builtin_amdgcn_readfirstlane(ptid >> 6), rg = pw & 3, mp = pw >> 2; const int b = strm * LB + (v >> 6), h = (v >> 3) & 7, qb = v & 7; const int q0 = MP + b * 1024 + qb * 128 + rg * 32;
                        const bf16_t* ck = cache + ((size_t)(0 * 2 + i) * 4 + b) * 256 * 1024 + h * 128; const bf16_t* cv = cache + ((size_t)(1 * 2 + i) * 4 + b) * 256 * 1024 + h * 128;
                        att::Seg sg{Kb + (size_t)(MP + b * 1024) * D + h * 128, Vb + (size_t)(MP + b * 1024) * D + h * 128, 16, ck, cv, 4};
                        att::attn_unit<true, false>(ptid, lds, Qb + (size_t)q0 * D + h * 128 + mp * 64, sg, Ob + (size_t)q0 * D + h * 128, 0, 0, 0, nullptr, lam, 1.f - linit, subg, nullptr, nullptr);
                    }
                } else {
                    for (int dup_ = 0; dup_ < DUP_ANP; ++dup_) {
                        CArgs A = args_ptr(); unsigned char* ws = A->ws; const int ptid = PTID(); const int pbx = PBX(); const bf16_t* Qb = (const bf16_t*)(ws + WS_Q); const bf16_t* Kb = (const bf16_t*)(ws + WS_K); const bf16_t* Vb = (const bf16_t*)(ws + WS_V); bf16_t* Ob = (bf16_t*)(ws + WS_O);
                        const int pw = __builtin_amdgcn_readfirstlane(ptid >> 6); const int b = strm * HB + (v >> 4), h = v & 15; const int q0 = b * 256 + pw * 32;
                        att::Seg sg{Kb + (size_t)(b * 256) * D + h * 64, Vb + (size_t)(b * 256) * D + h * 64, 4, nullptr, nullptr, 0};
                        float* fo = A->out + (size_t)(b * 2 + i) * 256 * 1024 + h * 64;
                        att::attn_unit<false, false>(ptid, lds, Qb + (size_t)q0 * D + h * 64, sg, Ob + (size_t)q0 * D + h * 64, 0, 0, 0, nullptr, 0.f, 0.f, nullptr, fo + OUT_NK, fo + OUT_NV);
                    }
                    for (int dup_ = 0; dup_ < DUP_ANL; ++dup_) {
                        CArgs A = args_ptr(); unsigned char* ws = A->ws; const int ptid = PTID(); const int pbx = PBX(); const bf16_t* Qb = (const bf16_t*)(ws + WS_Q); const bf16_t* Kb = (const bf16_t*)(ws + WS_K); const bf16_t* Vb = (const bf16_t*)(ws + WS_V); bf16_t* Ob = (bf16_t*)(ws + WS_O);
                        const bf16_t* cache = (const bf16_t*)(ws + WS_CACHE);
                        const int b = strm * LB + (v >> 6), h = (v >> 2) & 15, R = v & 3; const int pw = __builtin_amdgcn_readfirstlane(ptid >> 6); const int r_q = 4 * R + 2 * (pw >> 2), jj = pw & 3; const int q0 = MP + b * 1024 + r_q * 64 + jj * 16;
                        const int kr_lo = min(max(4 * R - 4, 0), 8), kr_hi = min(max(4 * R + 3 - 4, 0), 8) + 8;
                        const bf16_t* ck = cache + ((size_t)(2 * 2 + i) * 4 + b) * 256 * 1024 + h * 64; const bf16_t* cv = cache + ((size_t)(3 * 2 + i) * 4 + b) * 256 * 1024 + h * 64;
                        att::Seg sg{Kb + (size_t)(MP + b * 1024 + kr_lo * 64) * D + h * 64, Vb + (size_t)(MP + b * 1024 + kr_lo * 64) * D + h * 64, kr_hi - kr_lo, ck, cv, 4};
                        att::attn_unit<false, true>(ptid, lds, Qb + (size_t)q0 * D + h * 64, sg, Ob + (size_t)q0 * D + h * 64, kr_lo, r_q, jj, A->in[27] + ((size_t)i * 16 + h) * 465, 0.f, 0.f, nullptr, nullptr, nullptr);
                    }
                }
            }
        }
        SEAM(pb + 1);
        if (EN_O && IN(pb + 2)) for (int dup_ = 0; dup_ < DUP_O; ++dup_) {
            CArgs A = args_ptr(); unsigned char* ws = A->ws; const int ptid = PTID(); const int pbx = PBX(); float* out = A->out; float* outw = dup_ + 1 < DUP_O ? (float*)(ws + WS_Q) : out + OUT_Y;
            const float* modl = (const float*)(ws + WS_MOD) + (size_t)l * 5 * 6144;
            pg8::Gemm g{(const bf16_t*)(ws + WS_O), (const bf16_t*)(ws + WS_W + (size_t)l * W_LAYER + W_O), 1024, (unsigned long long*)(ws + 512)}; pg8::StaticOrder S; S.init(8, STRM(pbx), LBI(pbx));
            pg8::EpiResid E{l == 0 ? A->in[0] : out + OUT_Y, l == 0 ? A->in[1] : out + OUT_Y + (size_t)MP * D, outw, modl + 2 * 1024,
                            A->in[11] + l * 1024, modl + 4 * 1024, (bf16_t*)(ws + WS_XN), (float*)(ws + WS_SSQ)};
            pg8::gemm_phase_n1<pg8::EpiResid, true>(lds, g, S, E, ptid);
        }
        SEAMX(pb + 2);
        if (EN_FC1 && IN(pb + 3)) for (int dup_ = 0; dup_ < DUP_FC1; ++dup_) {
            CArgs A = args_ptr(); unsigned char* ws = A->ws; const int ptid = PTID(); const int pbx = PBX();
            pg8::Gemm g{(const bf16_t*)(ws + WS_XN), (const bf16_t*)(ws + WS_W + (size_t)l * W_LAYER + W_1), 1024, (unsigned long long*)(ws + 512)}; pg8::StaticOrder S; S.init(16, STRM(pbx), LBI(pbx));
            pg8::EpiRelu2 E{(bf16_t*)(ws + WS_H), (const float*)(ws + WS_SSQ), (const float*)(ws + WS_SW) + (size_t)l * 5 * 7168};
            pg8::gemm_phase<pg8::EpiRelu2, 2, true>(lds, g, S, E, ptid);
        }
        SEAMX(pb + 3);
#define FC2_BLOCK(SCRATCH, ABLV) { \
            CArgs A = args_ptr(); unsigned char* ws = A->ws; const int ptid = PTID(); const int pbx = PBX(); float* out = A->out; float* outw = (SCRATCH) ? (float*)(ws + WS_Q) : out + OUT_Y; \
            const float* modl = (const float*)(ws + WS_MOD) + (size_t)l * 5 * 6144; const bool more = l + 1 < DEPTH; \
            pg8::Gemm g{(const bf16_t*)(ws + WS_H), (const bf16_t*)(ws + WS_W + (size_t)l * W_LAYER + W_2), 4096, (unsigned long long*)(ws + 512)}; pg8::StaticOrder S; S.init(8, STRM(pbx), LBI(pbx)); \
            pg8::EpiResid E{out + OUT_Y, out + OUT_Y + (size_t)MP * D, outw, modl + 5 * 1024, \
                            A->in[10] + (l + 1) * 1024, modl + 5 * 6144 + 1 * 1024, more ? (bf16_t*)(ws + WS_XN) : nullptr, (float*)(ws + WS_SSQ)}; \
            pg8::gemm_phase_n1<pg8::EpiResid, true, ABLV>(lds, g, S, E, ptid); }
        if (EN_FC2 && IN(pb + 4)) {
#if DUP_FC2 > 1
            FC2_BLOCK(true, ABL_N1)
#endif
            FC2_BLOCK(false, 0)
        }
        SEAMX(pb + 4);
    }
    if (PROBE_PH >= 0) { if (PROBE_PH == 2 + 5 * DEPTH - 1 && PTID() == 0) pt1 = __builtin_amdgcn_s_memrealtime(); { MAKE_BAR(bq_, 0); xcd_barrier(bq_, PTID() == 0); }
        if (blockIdx.x == 0 && PTID() == 0) { CArgs A = args_ptr(); A->out[0] += (float)(pt1 - pt0) * 0.001f; } }
#undef IN
#undef SEAM
}

extern "C" void kernel_launch(void* const* d_in, const int* in_sizes, int n_in, void* d_out, int out_size, void* d_ws, size_t ws_size, hipStream_t stream) {
    static int grid = 0;
    if (grid == 0) {
        if (n_in != 28 || out_size != 41943040 || ws_size < WS_END) { fprintf(stderr, "kernel_launch: unexpected shapes (n_in %d, out %d, ws %zu); nothing launched\n", n_in, out_size, ws_size); grid = -1; return; }
        int dev = 0, cus = 0;
        if (hipGetDevice(&dev) != hipSuccess || hipDeviceGetAttribute(&cus, hipDeviceAttributeMultiprocessorCount, dev) != hipSuccess) { grid = -1; return; }
        if (hipFuncSetAttribute((const void*)fwd_kernel, hipFuncAttributeMaxDynamicSharedMemorySize, LDS_BYTES) != hipSuccess) { fprintf(stderr, "kernel_launch: hipFuncSetAttribute failed\n"); grid = -1; return; }
        int per_cu = 0;
        if (hipOccupancyMaxActiveBlocksPerMultiprocessor(&per_cu, (const void*)fwd_kernel, 512, LDS_BYTES) != hipSuccess || per_cu < 1) fprintf(stderr, "kernel_launch: occupancy query reports %d\n", per_cu);
        (void)hipGetLastError();
        grid = cus;
        if (grid != 256) { fprintf(stderr, "kernel_launch: built for a 256-CU device (stream geometry); found %d CUs; nothing launched\n", cus); grid = -1; return; }
    }
    if (grid < 0) return;
    (void)hipMemsetAsync((char*)d_ws + WS_CTL, 0, CTL_ZERO_BYTES, stream);
    Args a{};
    for (int i = 0; i < 28; ++i) a.in[i] = (const float*)d_in[i];
    a.out = (float*)d_out; a.ws = (unsigned char*)d_ws;
    constexpr int NPH = 2 + 5 * DEPTH;
#if MK_SINGLE
    a.ph_lo = 0; a.ph_hi = NPH;
    hipLaunchKernelGGL(fwd_kernel, dim3(grid), dim3(512), LDS_BYTES, stream, a);
#else
    for (int p = 0; p < NPH; ++p) { a.ph_lo = p; a.ph_hi = p + 1; hipLaunchKernelGGL(fwd_kernel, dim3(grid), dim3(512), LDS_BYTES, stream, a); }
#endif
}
```

```cpp
#include <hip/hip_runtime.h>
#include <cstdio>
#include <cstdint>
#include <type_traits>

#ifndef MK_SINGLE
#define MK_SINGLE 1
#endif

#ifndef DUP_PRO
#define DUP_PRO 1
#endif
#ifndef DUP_NORM
#define DUP_NORM 1
#endif
#ifndef DUP_QKV
#define DUP_QKV 1
#endif
#ifndef DUP_ADP
#define DUP_ADP 1
#endif
#ifndef DUP_ADL
#define DUP_ADL 1
#endif
#ifndef DUP_ANP
#define DUP_ANP 1
#endif
#ifndef DUP_ANL
#define DUP_ANL 1
#endif
#ifndef DUP_FC1
#define DUP_FC1 1
#endif
#ifndef DUP_O
#define DUP_O 1
#endif
#ifndef DUP_FC2
#define DUP_FC2 1
#endif
#ifndef NS
#define NS 4
#endif
#ifndef STREAM_DELAY_US
#define STREAM_DELAY_US 0
#endif
#ifndef DUP_YST
#define DUP_YST 1
#endif
#ifndef XCC_MODE
#define XCC_MODE 1
#endif
#ifndef MICRO_PAT
#define MICRO_PAT 0
#endif
#ifndef MICRO_REP
#define MICRO_REP 4
#endif
#ifndef ABL_N1
#define ABL_N1 0
#endif
#ifndef KROT_ON
#define KROT_ON 4
#endif
#ifndef NT_P0
#define NT_P0 1
#endif
#ifndef NT_P0S
#define NT_P0S 0
#endif
#ifndef FASTSM
#define FASTSM 1
#endif
#ifndef NT_QKV
#define NT_QKV 0
#endif
#ifndef NT_O
#define NT_O 0
#endif
#ifndef NT_H
#define NT_H 0
#endif
#ifndef NT_IN
#define NT_IN 1
#endif
#ifndef NT_Y
#define NT_Y 1
#endif
#ifndef NT_YS
#define NT_YS 0
#endif
#ifndef NT_XN
#define NT_XN 0
#endif
#ifndef EARLY_INV
#define EARLY_INV 1
#endif
#ifndef PROBE_KL
#define PROBE_KL 0
#endif
#ifndef PROBE_PH
#define PROBE_PH -1
#endif
#ifndef DUP_BAR
#define DUP_BAR 1
#endif
#ifndef EN_PRO
#define EN_PRO 1
#endif
#ifndef EN_NORM
#define EN_NORM 1
#endif
#ifndef EN_QKV
#define EN_QKV 1
#endif
#ifndef EN_ATT
#define EN_ATT 1
#endif
#ifndef EN_O
#define EN_O 1
#endif
#ifndef EN_FC1
#define EN_FC1 1
#endif
#ifndef EN_FC2
#define EN_FC2 1
#endif
#define LAS __attribute__((address_space(3)))
#define GAS __attribute__((address_space(1)))
typedef unsigned short bf16_t;
typedef short bf16x8 __attribute__((ext_vector_type(8)));
typedef short s16x4 __attribute__((ext_vector_type(4)));
typedef float f32x4 __attribute__((ext_vector_type(4)));
typedef float f32x2 __attribute__((ext_vector_type(2)));
typedef float f32x16 __attribute__((ext_vector_type(16)));
typedef unsigned u32x4 __attribute__((ext_vector_type(4)));
typedef unsigned u32x2 __attribute__((ext_vector_type(2)));
typedef __bf16 bf16x2_t __attribute__((ext_vector_type(2)));

constexpr int D = 1024, FF = 4096, DEPTH = 4;
constexpr int MP = 4096, M = 8192;
constexpr float EPS = 1e-6f;
constexpr float LOG2E = 1.4426950408889634f;
constexpr float C2 = 0.125f * LOG2E;
constexpr size_t OUT_Y = 0, OUT_DK = 8388608, OUT_DV = 16777216, OUT_NK = 25165824, OUT_NV = 33554432;

constexpr size_t MiB = 1u << 20;
constexpr int SWQ = 4 * 5 * 7168;
constexpr size_t WS_CTL = 0, CTL_ZERO_BYTES = 128 * 1024;
constexpr size_t WS_MOD = 1 * MiB;
constexpr size_t WS_ROPE = WS_MOD + 512 * 1024;
constexpr size_t WS_LAM = WS_ROPE + 16 * 1024;
constexpr size_t WS_W = 116 * MiB;
constexpr size_t W_LAYER = 24 * MiB, W_QKV = 0, W_O = 6 * MiB, W_1 = 8 * MiB, W_2 = 16 * MiB;
constexpr size_t WS_CACHE = 100 * MiB;
constexpr size_t WS_XN = 2 * MiB, WS_Q = 18 * MiB, WS_K = 34 * MiB, WS_V = 50 * MiB, WS_O = WS_Q  , WS_H = WS_Q  , WS_SSQ = 82 * MiB  , WS_SW = 83 * MiB  , WS_YB = 84 * MiB  , WS_SW4 = 212 * MiB  , WS_END = 216 * MiB;
constexpr int CW_BAR = 1024, CW_XL = 24576;

constexpr int RING_BYTES = 147456;
constexpr int LDSCTL_OFF = RING_BYTES, MISC_OFF = LDSCTL_OFF + 320;
constexpr int ROPE_LDS = 152064;
constexpr int LDS_BYTES = 148480 + 256 + 1024 + 2048 + 256 + 8192, PF_SINK = 148480, RSTD_LDS = 148736, SWL_LDS = 149760  , GNL_LDS = 151808  ;

__device__ __forceinline__ unsigned pk2(float lo, float hi) { f32x2 v = {lo, hi}; bf16x2_t b = __builtin_convertvector(v, bf16x2_t); return __builtin_bit_cast(unsigned, b); }
__device__ __forceinline__ float wave_max(float v) {
#pragma unroll
    for (int o = 1; o < 64; o <<= 1) v = fmaxf(v, __shfl_xor(v, o));
    return v;
}
__device__ __forceinline__ float wave_sum(float v) {
#pragma unroll
    for (int o = 1; o < 64; o <<= 1) v += __shfl_xor(v, o);
    return v;
}
#ifndef WT_STORES
#define WT_STORES 0
#endif
__device__ __forceinline__ void st16(void* p, u32x4 v) {
#if WT_STORES
    asm volatile("global_store_dwordx4 %0, %1, off sc1\n\ts_nop 1" :: "v"(p), "v"(v) : "memory");
#else
    *(u32x4*)p = v;
#endif
}
__device__ __forceinline__ void st16f(void* p, f32x4 v) { st16(p, __builtin_bit_cast(u32x4, v)); }
__device__ __forceinline__ void st16_nt(void* p, u32x4 v) { __builtin_nontemporal_store(v, (u32x4*)p); }
__device__ __forceinline__ void st16f_nt(void* p, f32x4 v) { __builtin_nontemporal_store(v, (f32x4*)p); }
__device__ __forceinline__ void st8(void* p, u32x2 v) {
#if WT_STORES
    asm volatile("global_store_dwordx2 %0, %1, off sc1\n\ts_nop 1" :: "v"(p), "v"(v) : "memory");
#else
    *(u32x2*)p = v;
#endif
}
__device__ __forceinline__ void st4f(float* p, float v) {
#if WT_STORES
    asm volatile("global_store_dword %0, %1, off sc1\n\ts_nop 1" :: "v"(p), "v"(v) : "memory");
#else
    *p = v;
#endif
}
#define LDS_WAIT() asm volatile("s_waitcnt lgkmcnt(0)" ::: "memory")
#define VM_WAIT() asm volatile("s_waitcnt vmcnt(0)" ::: "memory")

namespace pg8 {
constexpr int BM = 256, BK = 64, HALF = 128, HTB = HALF * BK * 2, NXCD = 8, WGM = 8;
__host__ __device__ __forceinline__ int lds_byte(int r, int c) { const int st = (r >> 4) * 2 + (c >> 5), rr = r & 15, cc = c & 31, ob = rr * 64 + cc * 2; return st * 1024 + (ob ^ (((ob >> 9) & 1) << 5)); }
__host__ __device__ __forceinline__ void stage_rc(int b, int& R, int& C) { const int st = b / 1024, sb = b % 1024, swz = sb ^ (((sb >> 9) & 1) << 5); R = (st >> 1) * 16 + swz / 64; C = (st & 1) * 32 + (swz % 64) / 2; }
__host__ __device__ __forceinline__ int perm32(int rho) { const int n = rho >> 4, i = rho & 15; return 8 * (i >> 2) + 4 * n + (i & 3); }

struct Unit { int pm, pn; };
struct Gemm { const bf16_t* A; const bf16_t* Bt; int K; unsigned long long* stamp; bool hmap = false; };
static_assert(NS == 4, "the H panel map assumes four streams of 4 prompt + 4 latent panels");
__host__ __device__ __forceinline__ size_t h_panel_off(int pm) { const int s = (pm & 15) >> 2, j = pm & 3; return (size_t)j * (16u << 20) + (pm < 16 ? (size_t)0 : (size_t)(8u << 20)) + (size_t)s * (2u << 20); }

struct StaticOrder {
    int nN, half, pbase_p, pbase_s, lb;
    __device__ void init(int nN_, int strm, int lb_) { nN = nN_; half = 16 / NS; pbase_p = strm * half; pbase_s = 16 + strm * half; lb = lb_; }
    __device__ bool next(int i, Unit& u) const { const int pn = 8 * i + (lb & 7); if (pn >= nN) return false; const int pl = lb >> 3; u.pm = pl < half ? pbase_p + pl : pbase_s + (pl - half); u.pn = pn; return true; }
};

template <class Epi, int NB, bool ALIGN_EPI>
__device__ __forceinline__ void gemm_phase(LAS unsigned char* lds, const Gemm g, const StaticOrder& S, const Epi& E, const int tid) {
    const int wid = __builtin_amdgcn_readfirstlane(tid >> 6), lane = tid & 63, wr = wid >> 2, wc = wid & 3, fr = lane & 15, fq = lane >> 4;
    const int K = g.K, nt = K / BK;
    unsigned voffA[2], voffB[2];
#pragma unroll
    for (int i = 0; i < 2; ++i) { int R, C; stage_rc(tid * 16 + i * 8192, R, C); const int Rb = Epi::PERM ? ((R & ~31) + perm32(R & 31)) : R;
        voffA[i] = (unsigned)(R * K + C) * 2u; voffB[i] = (unsigned)(Rb * K + C) * 2u; }
    const size_t kstep = (size_t)(BK * 2);
    const size_t hstep = (size_t)HALF * K * 2;
    const size_t tstepA = 2 * hstep, tstepB = NB * hstep;
    const unsigned ldsw = (unsigned)wid * 1024u;
    const int aoff = lds_byte(wr * 64 + fr, fq * 8), boff = lds_byte(wc * 32 + fr, fq * 8);
#define PG8_SA(b, h) (((b) * 2 + (h)) * HTB)
#define PG8_SB(b, h) ((4 + (b) * 2 + (h)) * HTB)
#define PG8_STAGE(bufoff, gbase, voff) do { _Pragma("unroll") for (int _i = 0; _i < 2; ++_i) \
        __builtin_amdgcn_global_load_lds((const unsigned*)((const char*)(gbase) + (voff)[_i]), (LAS unsigned*)(lds + (bufoff) + ldsw + _i * 8192), 16, 0, 0); } while (0)
#define PG8_LDA(dst, b, h) do { _Pragma("unroll") for (int m = 0; m < 4; ++m) _Pragma("unroll") for (int k = 0; k < 2; ++k) dst[m][k] = *(const LAS bf16x8*)(lds + PG8_SA(b, h) + aoff + m * 2048 + k * 1024); } while (0)
#define PG8_LDB(dst, b, h) do { _Pragma("unroll") for (int n = 0; n < 2; ++n) _Pragma("unroll") for (int k = 0; k < 2; ++k) dst[n][k] = *(const LAS bf16x8*)(lds + PG8_SB(b, h) + boff + n * 2048 + k * 1024); } while (0)
#define PG8_MMA(ai, bj, At, Bt) do { __builtin_amdgcn_s_setprio(1); _Pragma("unroll") for (int m = 0; m < 4; ++m) _Pragma("unroll") for (int n = 0; n < 2; ++n) _Pragma("unroll") for (int k = 0; k < 2; ++k) \
        acc[ai][bj][m][n] = __builtin_amdgcn_mfma_f32_16x16x32_bf16(Bt[n][k], At[m][k], acc[ai][bj][m][n], 0, 0, 0); __builtin_amdgcn_s_setprio(0); } while (0)
#define PG8_WAIT_V(n) asm volatile("s_waitcnt vmcnt(" #n ")" ::: "memory")
#define PG8_WAIT_L(n) asm volatile("s_waitcnt lgkmcnt(" #n ")" ::: "memory")
#define PG8_BAR __builtin_amdgcn_s_barrier()
#define PG8_SCHED __builtin_amdgcn_sched_barrier(0)
    Unit cur, nxt; int ui = 0;
    if (!S.next(0, cur)) return;
    f32x4 acc[2][NB][4][2];
#pragma unroll
    for (int a = 0; a < 2; ++a)
#pragma unroll
        for (int b = 0; b < NB; ++b)
#pragma unroll
            for (int m = 0; m < 4; ++m)
#pragma unroll
                for (int n = 0; n < 2; ++n) acc[a][b][m][n] = (f32x4){0.f, 0.f, 0.f, 0.f};
    bf16x8 At[4][2], B0[2][2], B1[2][2];
    const char* cA = (const char*)g.A + (g.hmap ? h_panel_off(cur.pm) : (size_t)cur.pm * tstepA); const char* cB = (const char*)g.Bt + (size_t)cur.pn * tstepB;
    if constexpr (NB == 2) {
        PG8_STAGE(PG8_SB(0, 0), cB, voffB); PG8_STAGE(PG8_SB(0, 1), cB + hstep, voffB); PG8_STAGE(PG8_SA(0, 0), cA, voffA); PG8_STAGE(PG8_SA(0, 1), cA + hstep, voffA);
        E.phase_pre(lds, S, cur.pm, tid);
        if (wr == 1) PG8_BAR;
        PG8_WAIT_V(2); PG8_BAR;
        PG8_STAGE(PG8_SB(1, 0), cB + kstep, voffB); PG8_STAGE(PG8_SA(1, 0), cA + kstep, voffA); PG8_STAGE(PG8_SB(1, 1), cB + hstep + kstep, voffB);
        PG8_WAIT_V(6); PG8_BAR;
    } else {
        PG8_STAGE(PG8_SB(0, 0), cB, voffB); PG8_STAGE(PG8_SA(0, 0), cA, voffA); PG8_STAGE(PG8_SA(0, 1), cA + hstep, voffA);
        if (wr == 1) PG8_BAR;
        PG8_WAIT_V(2); PG8_BAR;
        PG8_STAGE(PG8_SB(1, 0), cB + kstep, voffB); PG8_STAGE(PG8_SA(1, 0), cA + kstep, voffA);
        PG8_WAIT_V(4); PG8_BAR;
    }
    for (;;) {
        const bool has_next = S.next(ui + 1, nxt);
        const char* nA = has_next ? (const char*)g.A + (g.hmap ? h_panel_off(nxt.pm) : (size_t)nxt.pm * tstepA) : cA; const char* nB = has_next ? (const char*)g.Bt + (size_t)nxt.pn * tstepB : cB;
        for (int t = 0; t < nt; t += 2) {
            const bool last = (t == nt - 2);
            const char* a1 = cA + (size_t)(t + 1) * kstep;
            const char* a2 = last ? nA : cA + (size_t)(t + 2) * kstep; const char* b2 = last ? nB : cB + (size_t)(t + 2) * kstep;
            const char* a3 = a2 + kstep; const char* b3 = b2 + kstep;
            if constexpr (NB == 2) {
            PG8_LDB(B0, 0, 0); PG8_LDB(B1, 0, 1); PG8_SCHED; PG8_LDA(At, 0, 0); PG8_STAGE(PG8_SA(1, 1), a1 + hstep, voffA);
            PG8_WAIT_V(8); PG8_WAIT_L(0); PG8_BAR; PG8_MMA(0, 0, At, B0); PG8_MMA(0, 1, At, B1); PG8_BAR; PG8_SCHED;
            PG8_LDA(At, 0, 1); PG8_STAGE(PG8_SB(0, 0), b2, voffB); PG8_STAGE(PG8_SB(0, 1), b2 + hstep, voffB); PG8_STAGE(PG8_SA(0, 0), a2, voffA);
            PG8_WAIT_V(8); PG8_WAIT_L(0); PG8_BAR; PG8_MMA(1, 0, At, B0); PG8_MMA(1, 1, At, B1); PG8_BAR; PG8_SCHED;
            PG8_LDB(B0, 1, 0); PG8_LDB(B1, 1, 1); PG8_SCHED; PG8_LDA(At, 1, 0); PG8_STAGE(PG8_SA(0, 1), a2 + hstep, voffA);
            PG8_WAIT_V(8); PG8_WAIT_L(0); PG8_BAR; PG8_MMA(0, 0, At, B0); PG8_MMA(0, 1, At, B1); PG8_BAR; PG8_SCHED;
            PG8_LDA(At, 1, 1); PG8_STAGE(PG8_SB(1, 0), b3, voffB); PG8_STAGE(PG8_SB(1, 1), b3 + hstep, voffB); PG8_STAGE(PG8_SA(1, 0), a3, voffA);
            PG8_WAIT_V(8); PG8_WAIT_L(0); PG8_BAR; PG8_MMA(1, 0, At, B0); PG8_MMA(1, 1, At, B1); PG8_BAR; PG8_SCHED;
            } else {
            PG8_LDB(B0, 0, 0); PG8_SCHED; PG8_LDA(At, 0, 0); PG8_STAGE(PG8_SA(1, 1), a1 + hstep, voffA);
            PG8_WAIT_V(6); PG8_WAIT_L(0); PG8_BAR; PG8_MMA(0, 0, At, B0); PG8_BAR; PG8_SCHED;
            PG8_LDA(At, 0, 1); PG8_STAGE(PG8_SB(0, 0), b2, voffB); PG8_STAGE(PG8_SA(0, 0), a2, voffA);
            PG8_WAIT_V(6); PG8_WAIT_L(0); PG8_BAR; PG8_MMA(1, 0, At, B0); PG8_BAR; PG8_SCHED;
            PG8_LDB(B0, 1, 0); PG8_SCHED; PG8_LDA(At, 1, 0); PG8_STAGE(PG8_SA(0, 1), a2 + hstep, voffA);
            PG8_WAIT_V(6); PG8_WAIT_L(0); PG8_BAR; PG8_MMA(0, 0, At, B0); PG8_BAR; PG8_SCHED;
            PG8_LDA(At, 1, 1); PG8_STAGE(PG8_SB(1, 0), b3, voffB); PG8_STAGE(PG8_SA(1, 0), a3, voffA);
            PG8_WAIT_V(6); PG8_WAIT_L(0); PG8_BAR; PG8_MMA(1, 0, At, B0); PG8_BAR; PG8_SCHED;
            }
        }
        if (PROBE_KL && blockIdx.x == 0 && tid == 0) *(volatile unsigned long long*)g.stamp = __builtin_amdgcn_s_memrealtime();
        if constexpr (ALIGN_EPI) { if (wr == 0) PG8_BAR; }
        E(acc, cur, wr, wc, fr, fq);
        if (!has_next) break;
#pragma unroll
        for (int a = 0; a < 2; ++a)
#pragma unroll
            for (int b = 0; b < NB; ++b)
#pragma unroll
                for (int m = 0; m < 4; ++m)
#pragma unroll
                    for (int n = 0; n < 2; ++n) acc[a][b][m][n] = (f32x4){0.f, 0.f, 0.f, 0.f};
        cur = nxt; cA = nA; cB = nB; ++ui;
        if constexpr (ALIGN_EPI) { if (wr == 1) PG8_BAR; }
    }
    PG8_WAIT_V(0);
    if constexpr (!ALIGN_EPI) { if (wr == 0) PG8_BAR; }
    PG8_BAR;
#undef PG8_SA
#undef PG8_SB
#undef PG8_STAGE
#undef PG8_LDA
#undef PG8_LDB
#undef PG8_MMA
#undef PG8_WAIT_V
#undef PG8_WAIT_L
#undef PG8_BAR
#undef PG8_SCHED
}

template <class Epi, bool ALIGN_EPI>
__device__ __forceinline__ void gemm_phase_n1(LAS unsigned char* lds, const Gemm g, const StaticOrder& S, const Epi& E, const int tid) {
    const int wid = __builtin_amdgcn_readfirstlane(tid >> 6), lane = tid & 63, wr = wid >> 2, wri = (wid >> 1) & 1, wc2 = wid & 1, fr = lane & 15, fq = lane >> 4;
    const int K = g.K, nt = K / BK;
    unsigned voffA[2], voffB[2];
#pragma unroll
    for (int i = 0; i < 2; ++i) { int R, C; stage_rc(tid * 16 + i * 8192, R, C); const int Rb = Epi::PERM ? ((R & ~31) + perm32(R & 31)) : R;
        voffA[i] = (unsigned)(R * K + C) * 2u; voffB[i] = (unsigned)(Rb * K + C) * 2u; }
    const size_t kstep = (size_t)(BK * 2);
    const size_t hstep = (size_t)HALF * K * 2;
    const size_t tstepA = 2 * hstep, tstepB = hstep;
    const unsigned ldsw = (unsigned)wid * 1024u;
    const int aoff = (1 + wr) * HTB + lds_byte(wri * 64 + fr, fq * 8), boff = lds_byte(wc2 * 64 + fr, fq * 8);
    const int rb = wr * HALF + wri * 64, wc0 = 2 * wc2;
    constexpr int BUF3 = 3 * HTB;
#define N1_STAGE1(bufoff, gbase, voff) do { _Pragma("unroll") for (int _i = 0; _i < 2; ++_i) \
        __builtin_amdgcn_global_load_lds((const unsigned*)((const char*)(gbase) + (voff)[_i]), (LAS unsigned*)(lds + (bufoff) + ldsw + _i * 8192), 16, 0, 0); } while (0)
#define N1_STAGE3(c, pa, pb) do { N1_STAGE1((c) * BUF3, pb, voffB); N1_STAGE1((c) * BUF3 + HTB, pa, voffA); N1_STAGE1((c) * BUF3 + 2 * HTB, (pa) + hstep, voffA); } while (0)
#define N1_LDA(dst, c) do { _Pragma("unroll") for (int m = 0; m < 4; ++m) _Pragma("unroll") for (int k = 0; k < 2; ++k) dst[m][k] = *(const LAS bf16x8*)(lds + (c) * BUF3 + aoff + m * 2048 + k * 1024); } while (0)
#define N1_LDB(dst, c) do { _Pragma("unroll") for (int n = 0; n < 4; ++n) _Pragma("unroll") for (int k = 0; k < 2; ++k) dst[n][k] = *(const LAS bf16x8*)(lds + (c) * BUF3 + boff + n * 2048 + k * 1024); } while (0)
#define N1_MMA(At, Bt) do { _Pragma("unroll") for (int k = 0; k < 2; ++k) _Pragma("unroll") for (int m = 0; m < 4; ++m) _Pragma("unroll") for (int x = 0; x < 2; ++x) _Pragma("unroll") for (int n = 0; n < 2; ++n) \
        acc[x][0][m][n] = __builtin_amdgcn_mfma_f32_16x16x32_bf16(Bt[2 * x + n][k], At[m][k], acc[x][0][m][n], 0, 0, 0); } while (0)
#define N1_WAIT_V(n) asm volatile("s_waitcnt vmcnt(" #n ")" ::: "memory")
#define N1_WAIT_L(n) asm volatile("s_waitcnt lgkmcnt(" #n ")" ::: "memory")
#define N1_BAR __builtin_amdgcn_s_barrier()
#define N1_SCHED __builtin_amdgcn_sched_barrier(0)
    Unit cur, nxt; int ui = 0;
    if (!S.next(0, cur)) return;
    f32x4 acc[2][1][4][2];
#pragma unroll
    for (int a = 0; a < 2; ++a)
#pragma unroll
        for (int m = 0; m < 4; ++m)
#pragma unroll
            for (int n = 0; n < 2; ++n) acc[a][0][m][n] = (f32x4){0.f, 0.f, 0.f, 0.f};
    bf16x8 At0[4][2], B0[4][2];
    const char* cA = (const char*)g.A + (g.hmap ? h_panel_off(cur.pm) : (size_t)cur.pm * tstepA); const char* cB = (const char*)g.Bt + (size_t)cur.pn * tstepB;
    typename Epi::Pre pre; E.pre_load(pre, cur, rb, wc0, fr, fq);
#define KROT(u) (KROT_ON ? (nt == 64 ? KROT_ON * 8 : 0) : 0)
    int rot = KROT(cur);
    N1_STAGE3(0, cA + (size_t)(rot & (nt - 1)) * kstep, cB + (size_t)(rot & (nt - 1)) * kstep); N1_STAGE3(1, cA + (size_t)((rot + 1) & (nt - 1)) * kstep, cB + (size_t)((rot + 1) & (nt - 1)) * kstep);
    E.phase_pre(lds, cur, tid);
    if (wr == 1) N1_BAR;
    N1_WAIT_V(6); N1_BAR;
    N1_BAR;
    int c0 = 0;
    for (;;) {
        const bool has_next = S.next(ui + 1, nxt);
        const char* nA = has_next ? (const char*)g.A + (g.hmap ? h_panel_off(nxt.pm) : (size_t)nxt.pm * tstepA) : cA; const char* nB = has_next ? (const char*)g.Bt + (size_t)nxt.pn * tstepB : cB;
        const int nrot = has_next ? KROT(nxt) : rot;
        for (int t = 0; t < nt; ++t) {
            const bool tail = (t + 2 >= nt);
            const int kt = tail ? ((t + 2 - nt + nrot) & (nt - 1)) : ((t + 2 + rot) & (nt - 1));
            const char* sa = (tail ? nA : cA) + (size_t)kt * kstep;
            const char* sb = (tail ? nB : cB) + (size_t)kt * kstep;
            const int c2 = (c0 == 0) ? 2 : c0 - 1;
            N1_LDB(B0, c0); N1_SCHED; N1_LDA(At0, c0); N1_STAGE3(c2, sa, sb);
            N1_WAIT_V(6); N1_WAIT_L(0); N1_BAR;
            __builtin_amdgcn_s_setprio(1); N1_MMA(At0, B0); __builtin_amdgcn_s_setprio(0);
            N1_BAR; N1_SCHED;
            c0 = (c0 == 2) ? 0 : c0 + 1;
        }
        if (PROBE_KL && blockIdx.x == 0 && tid == 0) *(volatile unsigned long long*)g.stamp = __builtin_amdgcn_s_memrealtime();
        if constexpr (ALIGN_EPI) { if (wr == 0) N1_BAR; }
        E(acc, pre, cur, rb, wc0, fr, fq);
        if (!has_next) break;
#pragma unroll
        for (int a = 0; a < 2; ++a)
#pragma unroll
            for (int m = 0; m < 4; ++m)
#pragma unroll
                for (int n = 0; n < 2; ++n) acc[a][0][m][n] = (f32x4){0.f, 0.f, 0.f, 0.f};
        cur = nxt; cA = nA; cB = nB; ++ui; rot = nrot;
        E.pre_load(pre, cur, rb, wc0, fr, fq);
        if constexpr (ALIGN_EPI) { if (wr == 1) N1_BAR; }
    }
    N1_WAIT_V(0);
    if constexpr (!ALIGN_EPI) { if (wr == 0) N1_BAR; }
    N1_BAR;
#undef N1_STAGE1
#undef N1_STAGE3
#undef N1_LDA
#undef N1_LDB
#undef N1_MMA
#undef N1_WAIT_V
#undef N1_WAIT_L
#undef N1_BAR
#undef N1_SCHED
#undef KROT
}

__device__ __forceinline__ f32x4 sw_ld4(const float* p) { return *(const f32x4*)p; }
__device__ __forceinline__ int cond_of_pm(int pm) { return pm < 16 ? 0 : 1 + ((pm - 16) >> 2); }
__device__ __forceinline__ void row_rstd8(float (&rr)[2][4], const float* ssq, int row0  , int fq) {
#pragma unroll
    for (int ai = 0; ai < 2; ++ai) {
        f32x4 a[4], b[4];
#pragma unroll
        for (int m = 0; m < 4; ++m) { const float* p = ssq + (size_t)(row0 + ai * HALF + m * 16) * 32 + 8 * fq; a[m] = *(const f32x4*)p; b[m] = *(const f32x4*)(p + 4); }
#pragma unroll
        for (int m = 0; m < 4; ++m) { float s = ((a[m][0] + a[m][1]) + (a[m][2] + a[m][3])) + ((b[m][0] + b[m][1]) + (b[m][2] + b[m][3]));
            s += __shfl_xor(s, 16); s += __shfl_xor(s, 32); rr[ai][m] = rsqrtf(s * (1.f / 1024.f) + EPS); }
        asm volatile("" ::: "memory");
    }
}
__device__ __forceinline__ void row_rstd4(float (&rr)[4], const float* ssq, int row0  , int fq) {
    f32x4 a[4], b[4];
#pragma unroll
    for (int m = 0; m < 4; ++m) { const float* p = ssq + (size_t)(row0 + m * 16) * 32 + 8 * fq; a[m] = *(const f32x4*)p; b[m] = *(const f32x4*)(p + 4); }
#pragma unroll
    for (int m = 0; m < 4; ++m) { float s = ((a[m][0] + a[m][1]) + (a[m][2] + a[m][3])) + ((b[m][0] + b[m][1]) + (b[m][2] + b[m][3]));
        s += __shfl_xor(s, 16); s += __shfl_xor(s, 32); rr[m] = rsqrtf(s * (1.f / 1024.f) + EPS); }
}
__device__ __forceinline__ void panel_rstd_to_lds(LAS unsigned char* lds, const float* ssq, int pm, int tid) {
    const float* p = ssq + (size_t)(pm * BM + (tid >> 1)) * 32 + (tid & 1) * 16;
    const f32x4 a = *(const f32x4*)p, b = *(const f32x4*)(p + 4), c = *(const f32x4*)(p + 8), d = *(const f32x4*)(p + 12);
    float s = (((a[0] + a[1]) + (a[2] + a[3])) + ((b[0] + b[1]) + (b[2] + b[3]))) + (((c[0] + c[1]) + (c[2] + c[3])) + ((d[0] + d[1]) + (d[2] + d[3])));
    s += __shfl_xor(s, 1);
    if ((tid & 1) == 0) ((LAS float*)(lds + RSTD_LDS))[tid >> 1] = rsqrtf(s * (1.f / 1024.f) + EPS);
}
__device__ __forceinline__ float row_rstd(const float* ssq, int row, int fq) {
    const f32x4 a = *(const f32x4*)(ssq + (size_t)row * 32 + 8 * fq), b = *(const f32x4*)(ssq + (size_t)row * 32 + 8 * fq + 4);
    float s = ((a[0] + a[1]) + (a[2] + a[3])) + ((b[0] + b[1]) + (b[2] + b[3]));
    s += __shfl_xor(s, 16); s += __shfl_xor(s, 32);
    return rsqrtf(s * (1.f / 1024.f) + EPS);
}

struct EpiQK {
    static constexpr bool PERM = false;
    unsigned char* ws; const float* qg; const float* kg; float* outk; int layer; bool use_rope; LAS unsigned char* ldsr;
    __device__ __forceinline__ void phase_pre(LAS unsigned char* lds, const StaticOrder& S, int pm, int tid) const {
        panel_rstd_to_lds(lds, (const float*)(ws + WS_SSQ), pm, tid);
        Unit u0; (void)S.next(0, u0);
        if (tid < 256) ((LAS float*)(lds + SWL_LDS))[tid] = ((const float*)(ws + WS_SW4) + (size_t)layer * 5 * 7168)[cond_of_pm(pm) * 7168 + u0.pn * 256 + tid];
        else if (tid < 320) ((LAS float*)(lds + GNL_LDS))[tid - 256] = (u0.pn >= 4 ? kg : qg)[tid - 256];
        else if (tid < 448) ((LAS float*)(lds + SWL_LDS))[256 + tid - 320] = ((const float*)(ws + WS_SW4) + (size_t)layer * 5 * 7168)[cond_of_pm(pm) * 7168 + 2048 + u0.pn * HALF + (tid - 320)];
        if (use_rope) *(LAS f32x4*)(lds + ROPE_LDS + tid * 16) = *(const f32x4*)((const float*)(ws + WS_ROPE) + tid * 4);
    }
    __device__ __forceinline__ void operator()(const f32x4 (&acc)[2][2][4][2], const Unit& u, int wr, int wc, int fr, int fq) const {
        bf16_t* Q = (bf16_t*)(ws + WS_Q); bf16_t* Kb = (bf16_t*)(ws + WS_K); const float* rope = use_rope ? (const float*)(ws + WS_ROPE) : nullptr;
        const float* ssq = (const float*)(ws + WS_SSQ); const float* sw = (const float*)(ws + WS_SW4) + (size_t)layer * 5 * 7168;
        const bool isk = u.pn >= 4; const int G = (u.pn & 3) * 4 + wc;
        const float* swp = sw + cond_of_pm(u.pm) * 7168 + u.pn * 256 + wc * 32 + 4 * fq;
        const float* g = isk ? kg : qg; bf16_t* dst = isk ? Kb : Q; const float sc = isk ? 1.f : C2;
        const bool prompt = u.pm < 16; const bool do_rope = (rope != nullptr) && !prompt;
        f32x4 gv[2][2];
#pragma unroll
        for (int bj = 0; bj < 2; ++bj)
#pragma unroll
            for (int n = 0; n < 2; ++n) gv[bj][n] = *(const LAS f32x4*)((const LAS float*)(ldsr + GNL_LDS) + 32 * bj + 16 * n + 4 * fq);
        f32x4 swv[2][2];
#pragma unroll
        for (int bj = 0; bj < 2; ++bj)
#pragma unroll
            for (int n = 0; n < 2; ++n) swv[bj][n] = *(const LAS f32x4*)((const LAS float*)(ldsr + SWL_LDS) + wc * 32 + 4 * fq + 128 * bj + 16 * n);
        float rr[2][4];
#pragma unroll
        for (int ai = 0; ai < 2; ++ai)
#pragma unroll
            for (int m = 0; m < 4; ++m) rr[ai][m] = ((const LAS float*)(ldsr + RSTD_LDS))[ai * HALF + wr * 64 + m * 16 + fr];
#pragma unroll
        for (int ai = 0; ai < 2; ++ai)
#pragma unroll
            for (int m = 0; m < 4; ++m) {
                const int row = u.pm * BM + ai * HALF + wr * 64 + m * 16 + fr;
                const float rrow = rr[ai][m];
                f32x4 x[2][2];
                float ss = 0.f;
#pragma unroll
                for (int bj = 0; bj < 2; ++bj)
#pragma unroll
                    for (int n = 0; n < 2; ++n) { const f32x4 xx = acc[ai][bj][m][n] * rrow + swv[bj][n]; x[bj][n] = xx; ss += (xx[0] * xx[0] + xx[1] * xx[1]) + (xx[2] * xx[2] + xx[3] * xx[3]); }
                ss += __shfl_xor(ss, 16); ss += __shfl_xor(ss, 32);
                const float rstd = rsqrtf(ss * (1.f / 64.f) + EPS);
#pragma unroll
                for (int bj = 0; bj < 2; ++bj)
#pragma unroll
                    for (int n = 0; n < 2; ++n) x[bj][n] = x[bj][n] * rstd * gv[bj][n];
                if (do_rope) {
                    const int t = (row - MP) & 1023;
#pragma unroll
                    for (int bj = 0; bj < 2; ++bj) {
                        const int pos = bj == 0 ? (t >> 6) : (t & 63);
                        const LAS float* rl_ = (const LAS float*)(ldsr + ROPE_LDS) + (pos * 16 + 4 * fq) * 2; const f32x4 cs01 = *(const LAS f32x4*)rl_, cs23 = *(const LAS f32x4*)(rl_ + 4);
                        const float cc[4] = {cs01[0], cs01[2], cs23[0], cs23[2]}, sn[4] = {cs01[1], cs01[3], cs23[1], cs23[3]};
#pragma unroll
                        for (int e = 0; e < 4; ++e) { const float x0 = x[bj][0][e], x1 = x[bj][1][e]; x[bj][0][e] = x0 * cc[e] - x1 * sn[e]; x[bj][1][e] = x1 * cc[e] + x0 * sn[e]; }
                    }
                }
                bf16_t* rp = dst + (size_t)row * D + 64 * G + 8 * fq;
#pragma unroll
                for (int bj = 0; bj < 2; ++bj) { const f32x4 v0 = x[bj][0] * sc, v1 = x[bj][1] * sc;
                    u32x4 w; w.x = pk2(v0[0], v0[1]); w.y = pk2(v0[2], v0[3]); w.z = pk2(v1[0], v1[1]); w.w = pk2(v1[2], v1[3]);
                    if (NT_QKV) st16_nt(rp + 32 * bj, w); else st16(rp + 32 * bj, w); }
            }
    }
};
struct EpiV {
    static constexpr bool PERM = true;
    bf16_t* V; float* outv; const float* ssq; const float* sw; LAS unsigned char* ldsr;
    struct Pre {};
    __device__ __forceinline__ void pre_load(Pre&, const Unit&, int, int, int, int) const {}
    __device__ __forceinline__ void phase_pre(LAS unsigned char*, const Unit&, int) const {}
    __device__ __forceinline__ void operator()(const f32x4 (&acc)[2][1][4][2], const Pre&, const Unit& u, int rb, int wc0, int fr, int fq) const {
        float rr[4];
#pragma unroll
        for (int m = 0; m < 4; ++m) rr[m] = ((const LAS float*)(ldsr + RSTD_LDS))[rb + m * 16 + fr];
#pragma unroll
        for (int x = 0; x < 2; ++x) {
            const int col0 = u.pn * HALF + (wc0 + x) * 32 + 8 * fq;
            const LAS float* swl_ = (const LAS float*)(ldsr + SWL_LDS) + 256 + (wc0 + x) * 32 + 8 * fq; const f32x4 s0 = *(const LAS f32x4*)swl_, s1 = *(const LAS f32x4*)(swl_ + 4);
#pragma unroll
            for (int m = 0; m < 4; ++m) {
                const int row = u.pm * BM + rb + m * 16 + fr;
                const float rrow = rr[m];
                const f32x4 v0 = acc[x][0][m][0] * rrow + s0, v1 = acc[x][0][m][1] * rrow + s1;
                u32x4 w; w.x = pk2(v0[0], v0[1]); w.y = pk2(v0[2], v0[3]); w.z = pk2(v1[0], v1[1]); w.w = pk2(v1[2], v1[3]);
                if (NT_QKV) st16_nt(V + (size_t)row * D + col0, w); else st16(V + (size_t)row * D + col0, w);
            }
        }
    }
};
struct EpiResid {
    static constexpr bool PERM = true;
    const bf16_t* yin; bf16_t* yout; float* out_f32;
    const float* gate;
    const float* gnorm; const float* scale; bf16_t* XN; float* ssq;
    LAS unsigned char* ldsr;
    __device__ __forceinline__ void phase_pre(LAS unsigned char* lds, const Unit& u, int tid) const {
        const int cond = cond_of_pm(u.pm), c = tid & 127, col = u.pn * HALF + c;
        if (tid < 128) ((LAS float*)(lds + SWL_LDS))[c] = gate[cond * 6144 + col];
        else if (tid < 256) ((LAS float*)(lds + SWL_LDS))[128 + c] = XN ? gnorm[col] * (1.f + scale[cond * 6144 + col]) : 0.f;
    }
    struct Pre { u32x4 rv[2][4]; };
    __device__ __forceinline__ void pre_load(Pre& p, const Unit& u, int rb, int wc0, int fr, int fq) const {
        const bf16_t* src = yin + (size_t)(u.pm * BM + rb + fr) * D + u.pn * HALF + wc0 * 32 + 8 * fq;
#pragma unroll
        for (int x = 0; x < 2; ++x)
#pragma unroll
            for (int m = 0; m < 4; ++m) p.rv[x][m] = NT_Y ? __builtin_nontemporal_load((const u32x4*)(src + (size_t)(m * 16) * D + x * 32)) : *(const u32x4*)(src + (size_t)(m * 16) * D + x * 32);
    }
    __device__ __forceinline__ void operator()(const f32x4 (&acc)[2][1][4][2], const Pre& p, const Unit& u, int rb, int wc0, int fr, int fq) const {
        const int cond = cond_of_pm(u.pm);
#pragma unroll
        for (int x = 0; x < 2; ++x) {
            const int col0 = u.pn * HALF + (wc0 + x) * 32 + 8 * fq;
            const LAS float* gl_ = (const LAS float*)(ldsr + SWL_LDS) + (wc0 + x) * 32 + 8 * fq;
            const f32x4 g0 = *(const LAS f32x4*)gl_, g1 = *(const LAS f32x4*)(gl_ + 4), gs0 = *(const LAS f32x4*)(gl_ + 128), gs1 = *(const LAS f32x4*)(gl_ + 132);
#pragma unroll
            for (int m = 0; m < 4; ++m) {
                const int rl = rb + m * 16 + fr;
                const size_t off = (size_t)(u.pm * BM + rl) * D + col0;
                const u32x4 rw = p.rv[x][m];
                const f32x4 r0 = {__uint_as_float(rw.x << 16), __uint_as_float(rw.x & 0xffff0000u), __uint_as_float(rw.y << 16), __uint_as_float(rw.y & 0xffff0000u)};
                const f32x4 r1 = {__uint_as_float(rw.z << 16), __uint_as_float(rw.z & 0xffff0000u), __uint_as_float(rw.w << 16), __uint_as_float(rw.w & 0xffff0000u)};
                const f32x4 y0 = r0 + g0 * acc[x][0][m][0], y1 = r1 + g1 * acc[x][0][m][1];
                if (out_f32) { st16f_nt(out_f32 + off, y0); st16f_nt(out_f32 + off + 4, y1); }
                else { u32x4 w; w.x = pk2(y0[0], y0[1]); w.y = pk2(y0[2], y0[3]); w.z = pk2(y1[0], y1[1]); w.w = pk2(y1[2], y1[3]); if (NT_YS) st16_nt(yout + off, w); else st16(yout + off, w); }
                if (XN) {
                    const f32x4 a0 = y0 * gs0, a1 = y1 * gs1;
                    u32x4 w; w.x = pk2(a0[0], a0[1]); w.y = pk2(a0[2], a0[3]); w.z = pk2(a1[0], a1[1]); w.w = pk2(a1[2], a1[3]);
                    if (NT_XN) st16_nt(XN + off, w); else st16(XN + off, w);
                    float ss = ((y0[0] * y0[0] + y0[1] * y0[1]) + (y0[2] * y0[2] + y0[3] * y0[3])) + ((y1[0] * y1[0] + y1[1] * y1[1]) + (y1[2] * y1[2] + y1[3] * y1[3]));
                    ss += __shfl_xor(ss, 16); ss += __shfl_xor(ss, 32);
                    if (fq == 0) st4f(ssq + (size_t)(u.pm * BM + rl) * 32 + u.pn * 4 + wc0 + x, ss);
                }
            }
        }
    }
};
struct EpiRelu2 {
    static constexpr bool PERM = true;
    bf16_t* H; const float* ssq; const float* sw; LAS unsigned char* ldsr;
    __device__ __forceinline__ void phase_pre(LAS unsigned char* lds, const StaticOrder& S, int pm, int tid) const {
        panel_rstd_to_lds(lds, ssq, pm, tid);
        Unit uu; if (S.next(tid >> 8, uu)) ((LAS float*)(lds + SWL_LDS))[tid] = sw[cond_of_pm(pm) * 7168 + 3072 + uu.pn * BM + (tid & 255)];
    }
    __device__ __forceinline__ void operator()(const f32x4 (&acc)[2][2][4][2], const Unit& u, int wr, int wc, int fr, int fq) const {
        const int col0 = u.pn * BM + wc * 32 + 8 * fq;
        const float* swp = sw + cond_of_pm(u.pm) * 7168 + 3072 + col0;
        f32x4 sv[2][2];
#pragma unroll
        for (int bj = 0; bj < 2; ++bj) { const LAS float* sl_ = (const LAS float*)(ldsr + SWL_LDS) + (u.pn >> 3) * 256 + wc * 32 + 8 * fq + bj * HALF; sv[bj][0] = *(const LAS f32x4*)sl_; sv[bj][1] = *(const LAS f32x4*)(sl_ + 4); }
        float rr[2][4];
#pragma unroll
        for (int ai = 0; ai < 2; ++ai)
#pragma unroll
            for (int m = 0; m < 4; ++m) rr[ai][m] = ((const LAS float*)(ldsr + RSTD_LDS))[ai * HALF + wr * 64 + m * 16 + fr];
#pragma unroll
        for (int ai = 0; ai < 2; ++ai)
#pragma unroll
            for (int m = 0; m < 4; ++m) {
                const int row = u.pm * BM + ai * HALF + wr * 64 + m * 16 + fr;
                const float rrow = rr[ai][m];
                bf16_t* rp = (bf16_t*)((unsigned char*)H + h_panel_off(u.pm)) + (size_t)(row - u.pm * BM) * FF + col0;
#pragma unroll
                for (int bj = 0; bj < 2; ++bj) {
                    f32x4 v0 = acc[ai][bj][m][0] * rrow + sv[bj][0], v1 = acc[ai][bj][m][1] * rrow + sv[bj][1];
#pragma unroll
                    for (int e = 0; e < 4; ++e) { const float a = fmaxf(v0[e], 0.f), b = fmaxf(v1[e], 0.f); v0[e] = a * a; v1[e] = b * b; }
                    u32x4 w; w.x = pk2(v0[0], v0[1]); w.y = pk2(v0[2], v0[3]); w.z = pk2(v1[0], v1[1]); w.w = pk2(v1[2], v1[3]);
                    if (NT_H) st16_nt(rp + bj * HALF, w); else st16(rp + bj * HALF, w); }
            }
    }
};
}

namespace att {
constexpr float THR = 8.f, NEG = -1e30f;
__device__ __forceinline__ int crow(int r, int hi) { return (r & 3) + 8 * (r >> 2) + 4 * hi; }
__device__ __forceinline__ s16x4 vtr(const LAS char* p) { return __builtin_bit_cast(s16x4, __builtin_amdgcn_ds_read_tr16_b64_v4i16((LAS s16x4*)p)); }

struct Seg { const bf16_t* K1; const bf16_t* V1; int nt1; const bf16_t* K2; const bf16_t* V2; int nt2; };

template <bool DIFF, bool NA, bool fastsm>
__device__ __forceinline__ void attn_unit(const int tid, LAS unsigned char* lds, const bf16_t* Qw  , const Seg sg, bf16_t* Ow  ,
                                          int kr_lo, int r_q, int jj, const float* relb  ,
                                          float lam, int layer_l  , const float* subg,
                                          float* fk, float* fv) {
    constexpr int KW = DIFF ? 256 : 128, VW = DIFF ? 256 : 128, KS = KW + 16, VS = VW + 64, KBY = 64 * KS, VBY = 64 * VS;
    constexpr int DVB = DIFF ? 4 : 2, KC = DIFF ? 2 : 1;
    constexpr int VOFF = 2 * KBY, WSF_OFF = VOFF + 3 * VBY, BIAS_OFF = WSF_OFF + 2048, OST_OFF = BIAS_OFF + 2048;
    const int lane = tid & 63, l31 = lane & 31, hi = lane >> 5; const int wid = __builtin_amdgcn_readfirstlane(tid >> 6);
    const int mp = DIFF ? (wid >> 2) : 0; const bool grpB = wid >= 4;
    LAS float* wsf = (LAS float*)(lds + WSF_OFF) + wid * 64;
    LAS float* biasl = (LAS float*)(lds + BIAS_OFF);
    const int nt = sg.nt1 + sg.nt2;
    u32x4 st[KC];
#define SROW(i) ((tid + 512 * (i)) / (KW / 16))
#define SCH(i) ((tid + 512 * (i)) % (KW / 16))
#define ATT_LOADK(t) do { const bf16_t* kb_ = (t) < sg.nt1 ? sg.K1 + (size_t)(t) * 64 * D : sg.K2 + (size_t)((t) - sg.nt1) * 64 * D; \
        _Pragma("unroll") for (int i = 0; i < KC; ++i) st[i] = *(const u32x4*)(kb_ + (size_t)SROW(i) * D + SCH(i) * 8); } while (0)
#define ATT_LOADV(t) do { const bf16_t* vb_ = (t) < sg.nt1 ? sg.V1 + (size_t)(t) * 64 * D : sg.V2 + (size_t)((t) - sg.nt1) * 64 * D; \
        _Pragma("unroll") for (int i = 0; i < KC; ++i) st[i] = *(const u32x4*)(vb_ + (size_t)SROW(i) * D + SCH(i) * 8); } while (0)
#define BF2F_LO(w) __uint_as_float((w) << 16)
#define BF2F_HI(w) __uint_as_float((w) & 0xffff0000u)
#define ATT_STOREK(kb, tt) do { asm volatile("s_waitcnt vmcnt(0)" ::: "memory"); _Pragma("unroll") for (int i = 0; i < KC; ++i) *(LAS u32x4*)(lds + (kb) * KBY + SROW(i) * KS + SCH(i) * 16) = st[i]; \
        if (fk) { _Pragma("unroll") for (int i = 0; i < KC; ++i) { const int ch_ = SCH(i), c8_ = ch_ & 7; float* p_ = fk + (size_t)((tt) * 64 + SROW(i)) * 1024 + (ch_ >> 3) * 64 + 32 * (c8_ >> 2) + 4 * (c8_ & 3); \
            st16f_nt(p_, (f32x4){BF2F_LO(st[i].x), BF2F_HI(st[i].x), BF2F_LO(st[i].y), BF2F_HI(st[i].y)}); st16f_nt(p_ + 16, (f32x4){BF2F_LO(st[i].z), BF2F_HI(st[i].z), BF2F_LO(st[i].w), BF2F_HI(st[i].w)}); } } } while (0)
#define ATT_STOREV(vb, tt) do { asm volatile("s_waitcnt vmcnt(0)" ::: "memory"); _Pragma("unroll") for (int i = 0; i < KC; ++i) *(LAS u32x4*)(lds + VOFF + (vb) * VBY + SROW(i) * VS + SCH(i) * 16) = st[i]; \
        if (fv) { _Pragma("unroll") for (int i = 0; i < KC; ++i) { float* p_ = fv + (size_t)((tt) * 64 + SROW(i)) * 1024 + 8 * SCH(i); \
            st16f_nt(p_, (f32x4){BF2F_LO(st[i].x), BF2F_HI(st[i].x), BF2F_LO(st[i].y), BF2F_HI(st[i].y)}); st16f_nt(p_ + 4, (f32x4){BF2F_LO(st[i].z), BF2F_HI(st[i].z), BF2F_LO(st[i].w), BF2F_HI(st[i].w)}); } } } while (0)
#define ATT_BAR() do { asm volatile("s_waitcnt lgkmcnt(0)" ::: "memory"); __builtin_amdgcn_s_barrier(); asm volatile("" ::: "memory"); } while (0)
    ATT_LOADK(0);
    if (NA) { for (int i = tid; i < 465; i += 512) biasl[i] = relb[i] * LOG2E; }
    bf16x8 qf[4];
#pragma unroll
    for (int d0 = 0; d0 < 4; ++d0) qf[d0] = *(const bf16x8*)(Qw + (size_t)(NA ? ((l31 >> 4) * 64 + (l31 & 15)) : l31) * D + d0 * 16 + hi * 8);
    f32x16 o[DVB];
#pragma unroll
    for (int i = 0; i < DVB; ++i) o[i] = f32x16{};
    float mrun = (DIFF && fastsm) ? 0.f : NEG, lsum = 0.f;
    ATT_STOREK(0, 0); ATT_LOADV(0); ATT_STOREV(0, 0);
    ATT_BAR();
    const int rq_l = r_q + (l31 >> 4);
    const int rs_l = NA ? min(max(rq_l - 4, 0), 8) : 0;
    const int rs_w0 = NA ? min(max(r_q - 4, 0), 8) : 0, rs_w1 = NA ? min(max(r_q + 1 - 4, 0), 8) : 0;
    const int kbw = NA ? min(max(16 * jj - 8, 0), 32) : 0;
    const int cq = 16 * jj + (l31 & 15), cs = min(max(cq - 8, 0), 48);
    const int kvoff = VOFF + (4 * hi + ((lane & 15) >> 2)) * VS + ((lane >> 4) & 1) * 32 + (lane & 3) * 8;
    bf16x8 pa[2][2];
#define ATT_QKS(t) ATT_QKS2(t, fastsm)
#define ATT_QKS2(t, FQ) do { \
        const LAS unsigned char* kb = lds + ((t) & 1) * KBY + mp * 128 + l31 * KS + hi * 16; \
        f32x16 p0 = f32x16{}, p1 = f32x16{}; \
        _Pragma("unroll") for (int d0 = 0; d0 < 4; ++d0) { \
            const bf16x8 a0 = *(const LAS bf16x8*)(kb + d0 * 32), a1 = *(const LAS bf16x8*)(kb + 32 * KS + d0 * 32); \
            p0 = __builtin_amdgcn_mfma_f32_32x32x16_bf16(a0, qf[d0], p0, 0, 0, 0); \
            p1 = __builtin_amdgcn_mfma_f32_32x32x16_bf16(a1, qf[d0], p1, 0, 0, 0); } \
        if (false) { \
            const int kr = kr_lo + (t); const LAS float* brow = biasl + (kr - r_q + 7) * 31 + 15 - cq; \
            _Pragma("unroll") for (int r = 0; r < 16; ++r) { \
                const int k0 = crow(r, hi), k1 = k0 + 32; \
                const bool v0 = (k0 >= cs) && (k0 < cs + 16), v1 = (k1 >= cs) && (k1 < cs + 16); \
                const float b0 = brow[v0 ? k0 : cq], b1 = brow[v1 ? k1 : cq]; \
                p0[r] = v0 ? p0[r] + b0 : NEG; p1[r] = v1 ? p1[r] + b1 : NEG; } } \
        f32x2 sacc = {0.f, 0.f}; \
        if (FQ) { \
            _Pragma("unroll") for (int r = 0; r < 16; r += 2) { \
                p0[r] = __builtin_amdgcn_exp2f(p0[r]); p0[r + 1] = __builtin_amdgcn_exp2f(p0[r + 1]); p1[r] = __builtin_amdgcn_exp2f(p1[r]); p1[r + 1] = __builtin_amdgcn_exp2f(p1[r + 1]); \
                sacc += (f32x2){p0[r], p0[r + 1]}; sacc += (f32x2){p1[r], p1[r + 1]}; } \
        } else { \
        float tm = fmaxf(fmaxf(p0[0], p1[0]), fmaxf(p0[1], p1[1])); \
        _Pragma("unroll") for (int r = 2; r < 16; r += 2) tm = fmaxf(tm, fmaxf(fmaxf(p0[r], p1[r]), fmaxf(p0[r + 1], p1[r + 1]))); \
        { auto rr_ = __builtin_amdgcn_permlane32_swap(__float_as_uint(tm), __float_as_uint(tm), false, false); tm = fmaxf(__uint_as_float(rr_[0]), __uint_as_float(rr_[1])); } \
        if (__any(tm > mrun + THR)) { \
            const float mn = fmaxf(mrun, tm), al = __builtin_amdgcn_exp2f(mrun - mn); \
            lsum *= al; mrun = mn; \
            if (hi == 0) wsf[l31] = al; \
            LDS_WAIT(); \
            _Pragma("unroll") for (int r = 0; r < 16; ++r) { const float f = wsf[crow(r, hi)]; \
                _Pragma("unroll") for (int i = 0; i < DVB; ++i) o[i][r] *= f; } \
            LDS_WAIT(); } \
        _Pragma("unroll") for (int r = 0; r < 16; r += 2) { \
            p0[r] = __builtin_amdgcn_exp2f(p0[r] - mrun); p0[r + 1] = __builtin_amdgcn_exp2f(p0[r + 1] - mrun); p1[r] = __builtin_amdgcn_exp2f(p1[r] - mrun); p1[r + 1] = __builtin_amdgcn_exp2f(p1[r + 1] - mrun); \
            sacc += (f32x2){p0[r], p0[r + 1]}; sacc += (f32x2){p1[r], p1[r + 1]}; } \
        } \
        lsum += sacc[0] + sacc[1]; \
        _Pragma("unroll") for (int s_ = 0; s_ < 2; ++s_) { \
            u32x4 w0, w1; \
            w0.x = pk2(p0[8 * s_ + 0], p0[8 * s_ + 1]); w0.y = pk2(p0[8 * s_ + 2], p0[8 * s_ + 3]); w0.z = pk2(p0[8 * s_ + 4], p0[8 * s_ + 5]); w0.w = pk2(p0[8 * s_ + 6], p0[8 * s_ + 7]); \
            w1.x = pk2(p1[8 * s_ + 0], p1[8 * s_ + 1]); w1.y = pk2(p1[8 * s_ + 2], p1[8 * s_ + 3]); w1.z = pk2(p1[8 * s_ + 4], p1[8 * s_ + 5]); w1.w = pk2(p1[8 * s_ + 6], p1[8 * s_ + 7]); \
            pa[0][s_] = __builtin_bit_cast(bf16x8, w0); pa[1][s_] = __builtin_bit_cast(bf16x8, w1); } \
    } while (0)
#define ATT_QKS_W(t) do { \
        const LAS unsigned char* kb = lds + ((t) & 1) * KBY + (kbw + l31) * KS + hi * 16; \
        f32x16 p0 = f32x16{}; \
        _Pragma("unroll") for (int d0 = 0; d0 < 4; ++d0) { const bf16x8 a0 = *(const LAS bf16x8*)(kb + d0 * 32); p0 = __builtin_amdgcn_mfma_f32_32x32x16_bf16(a0, qf[d0], p0, 0, 0, 0); } \
        { const int kr = kr_lo + (t); const bool rowok = (kr >= rs_l) && (kr < rs_l + 8); const LAS float* brow = biasl + (kr - rq_l + 7) * 31 + 15 - cq; \
          _Pragma("unroll") for (int r = 0; r < 16; ++r) { const int k0 = kbw + crow(r, hi); const bool v0 = rowok && (k0 >= cs) && (k0 < cs + 16); const float b0 = brow[v0 ? k0 : cq]; p0[r] = v0 ? p0[r] + b0 : -3.0e38f; } }   \
        f32x2 sacc = {0.f, 0.f}; \
        if (fastsm) { \
            _Pragma("unroll") for (int r = 0; r < 16; r += 2) { p0[r] = __builtin_amdgcn_exp2f(p0[r]); p0[r + 1] = __builtin_amdgcn_exp2f(p0[r + 1]); sacc += (f32x2){p0[r], p0[r + 1]}; } \
        } else { \
        float tm = fmaxf(fmaxf(p0[0], p0[1]), fmaxf(p0[2], p0[3])); \
        _Pragma("unroll") for (int r = 4; r < 16; r += 4) tm = fmaxf(tm, fmaxf(fmaxf(p0[r], p0[r + 1]), fmaxf(p0[r + 2], p0[r + 3]))); \
        { auto rr_ = __builtin_amdgcn_permlane32_swap(__float_as_uint(tm), __float_as_uint(tm), false, false); tm = fmaxf(__uint_as_float(rr_[0]), __uint_as_float(rr_[1])); } \
        if (__any(tm > mrun + THR)) { \
            const float mn = fmaxf(mrun, tm), al = __builtin_amdgcn_exp2f(mrun - mn); \
            lsum *= al; mrun = mn; \
            if (hi == 0) wsf[l31] = al; \
            LDS_WAIT(); \
            _Pragma("unroll") for (int r = 0; r < 16; ++r) { const float f = wsf[crow(r, hi)]; \
                _Pragma("unroll") for (int i = 0; i < DVB; ++i) o[i][r] *= f; } \
            LDS_WAIT(); } \
        _Pragma("unroll") for (int r = 0; r < 16; r += 2) { p0[r] = __builtin_amdgcn_exp2f(p0[r] - mrun); p0[r + 1] = __builtin_amdgcn_exp2f(p0[r + 1] - mrun); sacc += (f32x2){p0[r], p0[r + 1]}; } \
        } \
        lsum += sacc[0] + sacc[1]; \
        _Pragma("unroll") for (int s_ = 0; s_ < 2; ++s_) { u32x4 w0; \
            w0.x = pk2(p0[8 * s_ + 0], p0[8 * s_ + 1]); w0.y = pk2(p0[8 * s_ + 2], p0[8 * s_ + 3]); w0.z = pk2(p0[8 * s_ + 4], p0[8 * s_ + 5]); w0.w = pk2(p0[8 * s_ + 6], p0[8 * s_ + 7]); \
            pa[0][s_] = __builtin_bit_cast(bf16x8, w0); } \
    } while (0)
#define ATT_PV_W(vb_) do { \
        const LAS char* vb = (const LAS char*)(lds + (vb_) * VBY + kvoff + kbw * VS); \
        _Pragma("unroll") for (int d0 = 0; d0 < DVB; ++d0) \
            _Pragma("unroll") for (int s_ = 0; s_ < 2; ++s_) { \
                const s16x4 lo = vtr(vb + (16 * s_) * VS + 64 * d0), hh = vtr(vb + (16 * s_ + 8) * VS + 64 * d0); \
                const bf16x8 vf = (bf16x8){lo[0], lo[1], lo[2], lo[3], hh[0], hh[1], hh[2], hh[3]}; \
                o[d0] = __builtin_amdgcn_mfma_f32_32x32x16_bf16(pa[0][s_], vf, o[d0], 0, 0, 0); } \
    } while (0)
#define ATT_PV(vb_) do { \
        const LAS char* vb = (const LAS char*)(lds + (vb_) * VBY + kvoff); \
        _Pragma("unroll") for (int d0 = 0; d0 < DVB; ++d0) { \
            _Pragma("unroll") for (int blk = 0; blk < 2; ++blk) \
                _Pragma("unroll") for (int s_ = 0; s_ < 2; ++s_) { \
                    const s16x4 lo = vtr(vb + (32 * blk + 16 * s_) * VS + 64 * d0), hh = vtr(vb + (32 * blk + 16 * s_ + 8) * VS + 64 * d0); \
                    const bf16x8 vf = (bf16x8){lo[0], lo[1], lo[2], lo[3], hh[0], hh[1], hh[2], hh[3]}; \
                    o[d0] = __builtin_amdgcn_mfma_f32_32x32x16_bf16(pa[blk][s_], vf, o[d0], 0, 0, 0); } \
            if (d0 & 1) __builtin_amdgcn_sched_barrier(0); } \
    } while (0)
#define ATT_ACTIVE(t) (!(NA && (t) < sg.nt1) || ((kr_lo + (t)) >= rs_w0 && (kr_lo + (t)) < rs_w1 + 8))
    int vcur = 0, vprev = 2;
    if constexpr (DIFF) {
        bool act_prev = false;
#define DIFF_TILES(T0, T1, FQ) \
        for (int t = (T0); t < (T1); ++t) { \
            const bool more = (t + 1 < nt); \
            if (more) ATT_LOADK(t + 1); \
            const bool act = ATT_ACTIVE(t); \
            if (!grpB) { if (act) ATT_QKS2(t, FQ); } else { if (act_prev) ATT_PV(vprev); } \
            if (more) { ATT_STOREK((t + 1) & 1, t + 1); } \
            ATT_BAR(); \
            if (more) ATT_LOADV(t + 1); \
            if (!grpB) { if (act) ATT_PV(vcur); } else { if (act) ATT_QKS2(t, FQ); } \
            const int vnext = vcur == 2 ? 0 : vcur + 1; \
            if (more) { ATT_STOREV(vnext, t + 1); } \
            ATT_BAR(); \
            vprev = vcur; vcur = vnext; act_prev = act; \
        }
        if constexpr (fastsm) { DIFF_TILES(0, sg.nt1, true) DIFF_TILES(sg.nt1, nt, false) }
        else { DIFF_TILES(0, nt, false) }
#undef DIFF_TILES
        if (grpB && act_prev) ATT_PV(vprev);
        ATT_BAR();
    } else {
        for (int t = 0; t < nt; ++t) {
            const bool more = (t + 1 < nt);
            u32x4 st2[KC];
            if (more) { ATT_LOADK(t + 1); const bf16_t* vb_ = (t + 1) < sg.nt1 ? sg.V1 + (size_t)(t + 1) * 64 * D : sg.V2 + (size_t)((t + 1) - sg.nt1) * 64 * D;
#pragma unroll
                for (int i = 0; i < KC; ++i) st2[i] = *(const u32x4*)(vb_ + (size_t)SROW(i) * D + SCH(i) * 8); }
            if (ATT_ACTIVE(t)) { if (NA && t < sg.nt1) { ATT_QKS_W(t); ATT_PV_W(vcur); } else { ATT_QKS(t); ATT_PV(vcur); } }
            const int vnext = vcur == 2 ? 0 : vcur + 1;
            if (more) { ATT_STOREK((t + 1) & 1, t + 1);
#pragma unroll
                for (int i = 0; i < KC; ++i) { *(LAS u32x4*)(lds + VOFF + vnext * VBY + SROW(i) * VS + SCH(i) * 16) = st2[i];
                    if (fv) { float* p_ = fv + (size_t)((t + 1) * 64 + SROW(i)) * 1024 + 8 * SCH(i);
                        st16f_nt(p_, (f32x4){BF2F_LO(st2[i].x), BF2F_HI(st2[i].x), BF2F_LO(st2[i].y), BF2F_HI(st2[i].y)}); st16f_nt(p_ + 4, (f32x4){BF2F_LO(st2[i].z), BF2F_HI(st2[i].z), BF2F_LO(st2[i].w), BF2F_HI(st2[i].w)}); } } }
            ATT_BAR();
            vcur = vnext;
        }
    }
#undef ATT_LOADK
#undef ATT_LOADV
#undef ATT_STOREK
#undef ATT_STOREV
#undef BF2F_LO
#undef BF2F_HI
#undef SROW
#undef SCH
#undef ATT_QKS
#undef ATT_QKS2
#undef ATT_PV
#undef ATT_ACTIVE
#undef ATT_QKS_W
#undef ATT_PV_W
    { auto rr_ = __builtin_amdgcn_permlane32_swap(__float_as_uint(lsum), __float_as_uint(lsum), false, false); lsum = __uint_as_float(rr_[0]) + __uint_as_float(rr_[1]); }
    if (hi == 0) wsf[l31] = 1.f / lsum;
    LDS_WAIT();
    float inv[16];
#pragma unroll
    for (int r = 0; r < 16; ++r) inv[r] = wsf[crow(r, hi)];
    LDS_WAIT();
    if constexpr (!DIFF) {
        LAS bf16_t* stg = (LAS bf16_t*)(lds + OST_OFF) + wid * 2048;
#pragma unroll
        for (int r = 0; r < 16; ++r) { const int q = crow(r, hi);
#pragma unroll
            for (int d0 = 0; d0 < 2; ++d0) { const unsigned w = pk2(o[d0][r] * inv[r], 0.f); stg[q * 64 + d0 * 32 + l31] = (bf16_t)(w & 0xffffu); } }
        LDS_WAIT();
#pragma unroll
        for (int i = 0; i < 4; ++i) { const int row = i * 8 + (lane >> 3), ch = lane & 7; const u32x4 v = *(const LAS u32x4*)(stg + row * 64 + ch * 8); { if (NT_O) st16_nt(Ow + (size_t)(NA ? ((row >> 4) * 64 + (row & 15)) : row) * D + ch * 8, v); else st16(Ow + (size_t)(NA ? ((row >> 4) * 64 + (row & 15)) : row) * D + ch * 8, v); } }
        LDS_WAIT();
        ATT_BAR();
    } else {
        constexpr int RS = 132;
        LAS float* ex = (LAS float*)lds + (wid & 3) * 32 * RS;
        if (mp == 1) {
#pragma unroll
            for (int r = 0; r < 16; ++r) { const int q = crow(r, hi); const float f = inv[r] * lam;
#pragma unroll
                for (int d0 = 0; d0 < 4; ++d0) ex[q * RS + d0 * 32 + l31] = o[d0][r] * f; }
        }
        ATT_BAR();
        if (mp == 0) {
#pragma unroll
            for (int r = 0; r < 16; ++r) { const int q = crow(r, hi);
#pragma unroll
                for (int d0 = 0; d0 < 4; ++d0) { LAS float* p = ex + q * RS + d0 * 32 + l31; *p = o[d0][r] * inv[r] - *p; } }
            LDS_WAIT();
            { const LAS float* rp = ex + l31 * RS + hi * 64; float ss = 0.f;
#pragma unroll
              for (int j = 0; j < 16; ++j) { const f32x4 v = *(const LAS f32x4*)(rp + 4 * j); ss += (v[0] * v[0] + v[1] * v[1]) + (v[2] * v[2] + v[3] * v[3]); }
              { auto rr_ = __builtin_amdgcn_permlane32_swap(__float_as_uint(ss), __float_as_uint(ss), false, false); ss = __uint_as_float(rr_[0]) + __uint_as_float(rr_[1]); }
              if (hi == 0) wsf[l31] = rsqrtf(ss * (1.f / 128.f) + EPS) * (1.f - (0.8f - 0.6f * expf(-0.3f * (float)layer_l))); }
            LDS_WAIT();
            const int ch = lane & 15; const f32x4 g0 = *(const f32x4*)(subg + 8 * ch), g1 = *(const f32x4*)(subg + 8 * ch + 4);
#pragma unroll
            for (int i = 0; i < 8; ++i) { const int row = i * 4 + (lane >> 4); const float rstd = wsf[row];
                const f32x4 a = *(const LAS f32x4*)(ex + row * RS + 8 * ch) * rstd * g0, b = *(const LAS f32x4*)(ex + row * RS + 8 * ch + 4) * rstd * g1;
                u32x4 w; w.x = pk2(a[0], a[1]); w.y = pk2(a[2], a[3]); w.z = pk2(b[0], b[1]); w.w = pk2(b[2], b[3]);
                if (NT_O) st16_nt(Ow + (size_t)row * D + 8 * ch, w); else st16(Ow + (size_t)row * D + 8 * ch, w); }
        }
        LDS_WAIT();
        ATT_BAR();
    }
#undef ATT_BAR
}
}

#ifndef WS_TOP
#define WS_TOP 1
#endif
#ifndef PF_ON
#define PF_ON 0
#endif
__device__ __forceinline__ void warm_lines(LAS unsigned char* lds, const unsigned char* p, unsigned n, int gw, int lane, unsigned nw = 2048u) {
    for (unsigned base = (unsigned)gw * 64u; base < n; base += nw * 64u) {
        const unsigned line = base + (unsigned)lane;
        if (line < n) __builtin_amdgcn_global_load_lds((const unsigned*)(p + (size_t)line * 128), (LAS unsigned*)(lds + PF_SINK), 4, 0, 0);
    }
}
struct Warm { const unsigned char* p; unsigned n; int wv, vcu, lane; LAS unsigned char* lds; };
#ifndef PF_BAR
#define PF_BAR 1
#endif
#define XB_TMO      128
#define XB_XCNT(j)  (256  + 64 * (j))
#define XB_XSUB(j)  (1280 + 64 * (j))
#define XB_XGEN(j)  (2304 + 64 * (j))
#define XB_TOP      3328
#define XB_TOPGEN   3392
#define XCD_BAR_WORDS 3456
#define XB_SPIN_CAP (1u << 18)
__device__ __forceinline__ unsigned xb_ld(unsigned* p)              { return __hip_atomic_load(p, __ATOMIC_RELAXED, __HIP_MEMORY_SCOPE_AGENT); }
__device__ __forceinline__ unsigned xb_add(unsigned* p, unsigned v) { return __hip_atomic_fetch_add(p, v, __ATOMIC_RELAXED, __HIP_MEMORY_SCOPE_AGENT); }
__device__ __forceinline__ unsigned xb_xcc_id() { return (unsigned)__builtin_amdgcn_s_getreg((3 << 11) | 20) & 0xFu; }
#define XB_SPIN(cond, bar) do { unsigned _sp = 0; while (cond) { __builtin_amdgcn_s_sleep(1); \
    if ((++_sp & 255u) == 0u) { if (xb_ld(&(bar)[XB_TMO])) break; if (_sp > XB_SPIN_CAP) { atomicAdd(&(bar)[XB_TMO], 1u); break; } } } } while (0)
struct XcdBarrier { unsigned* bar; unsigned x; volatile LAS unsigned* st; unsigned n; };
__device__ __forceinline__ XcdBarrier xcd_barrier_post(unsigned* bar, volatile LAS unsigned* st, unsigned n) {
    XcdBarrier b; b.bar = bar; b.x = xb_xcc_id(); b.st = st; b.n = n;
    if (threadIdx.x == 0) (void)xb_add(&bar[XB_XCNT(b.x)], 1u);
    return b;
}
__device__ __forceinline__ void xcd_barrier_complete(unsigned* bar, unsigned x, unsigned G, unsigned& nloc, unsigned& nx) {
    unsigned sum, cnt, mine, sp = 0u;
    for (;;) {
        sum = 0u; cnt = 0u; mine = 0u;
#pragma unroll
        for (unsigned j = 0; j < 16; ++j) { const unsigned c = xb_ld(&bar[XB_XCNT(j)]); sum += c; cnt += (c > 0u) ? 1u : 0u; mine = (j == x) ? c : mine; }
        if (sum == G) break;
        __builtin_amdgcn_s_sleep(1);
        if ((++sp & 255u) == 0u) { if (xb_ld(&bar[XB_TMO])) break; if (sp > XB_SPIN_CAP) { atomicAdd(&bar[XB_TMO], 1u); break; } }
    }
    nloc = mine > 0u ? mine : 1u; nx = cnt > 0u ? cnt : 1u;
}
__device__ __forceinline__ void xcd_barrier(const XcdBarrier& b, const bool leader  , const Warm w = Warm{nullptr, 0u, 0, 0, 0, nullptr}) {
    asm volatile("s_waitcnt vmcnt(0)" ::: "memory");
    __syncthreads();
    if (w.n && w.wv) warm_lines(w.lds, w.p, w.n, w.vcu * 7 + (w.wv - 1), w.lane, 1792u);
    if (leader) {
        unsigned* bar = b.bar;
        __builtin_amdgcn_s_waitcnt(0);
        unsigned nloc = b.st[0], nx = b.st[1];
        if (nloc == 0u) { xcd_barrier_complete(bar, b.x, b.n, nloc, nx); b.st[0] = nloc; b.st[1] = nx; }
        const unsigned old = xb_add(&bar[XB_XSUB(b.x)], 1u);
        const unsigned gen = old / nloc;
        if (old + 1u == (gen + 1u) * nloc) {
            __builtin_amdgcn_fence(__ATOMIC_RELEASE, "agent");
            asm volatile("s_waitcnt vmcnt(0)" ::: "memory");
            const unsigned og = xb_add(&bar[XB_TOP], 1u);
            const unsigned tg = og / nx;
            if (EARLY_INV) asm volatile("buffer_inv sc1" ::: "memory");
            if (og + 1u == (tg + 1u) * nx) xb_add(&bar[XB_TOPGEN], 1u);
            else XB_SPIN(xb_ld(&bar[XB_TOPGEN]) == tg, bar);
            if (!EARLY_INV) __builtin_amdgcn_fence(__ATOMIC_ACQUIRE, "agent");
            xb_add(&bar[XB_XGEN(b.x)], 1u);
            asm volatile("s_waitcnt vmcnt(0)" ::: "memory");
        } else {
            if (EARLY_INV) asm volatile("buffer_inv sc1" ::: "memory");
            XB_SPIN(xb_ld(&bar[XB_XGEN(b.x)]) == gen, bar);
            if (!EARLY_INV) __builtin_amdgcn_fence(__ATOMIC_ACQUIRE, "agent");
            asm volatile("s_waitcnt vmcnt(0)" ::: "memory");
        }
    }
    if (w.n) { __builtin_amdgcn_s_barrier(); asm volatile("" ::: "memory"); }
    else __syncthreads();
}
__device__ __forceinline__ void xcc_barrier(unsigned* cnt, unsigned* tmo, const bool leader, const Warm w = Warm{nullptr, 0u, 0, 0, 0, nullptr}) {
    asm volatile("s_waitcnt vmcnt(0)" ::: "memory");
    __syncthreads();
    if (w.n && w.wv) warm_lines(w.lds, w.p, w.n, w.vcu * 7 + (w.wv - 1), w.lane, 1792u);
    if (leader) {
        const unsigned old = xb_add(cnt, 1u); const unsigned target = (old / 32u + 1u) * 32u;
        if (EARLY_INV) asm volatile("buffer_inv sc1" ::: "memory");
        unsigned sp = 0u;
        while (xb_ld(cnt) < target) { __builtin_amdgcn_s_sleep(1); if ((++sp & 255u) == 0u) { if (xb_ld(tmo)) break; if (sp > XB_SPIN_CAP) { atomicAdd(tmo, 1u); break; } } }
        if (!EARLY_INV) __builtin_amdgcn_fence(__ATOMIC_ACQUIRE, "agent");
        asm volatile("s_waitcnt vmcnt(0)" ::: "memory");
    }
    if (w.n) { __builtin_amdgcn_s_barrier(); asm volatile("" ::: "memory"); }
    else __syncthreads();
}

struct Args { const float* in[28]; float* out; unsigned char* ws; int ph_lo, ph_hi; };
typedef const __attribute__((address_space(4))) Args* CArgs;
__device__ __forceinline__ CArgs args_ptr() { unsigned long long p = (unsigned long long)__builtin_amdgcn_kernarg_segment_ptr(); asm volatile("" : "+s"(p)); return (CArgs)p; }

template <bool QKVMAP>
__device__ __forceinline__ void transpose_item(const float* W, int K, int N, bf16_t* WT, int item, int lane, LAS unsigned char* tile) {
    const int nblk = N / 64, kb = item / nblk, nb = item % nblk, k0 = 64 * kb, n0 = 64 * nb;
    const int ng = lane & 15, q = lane >> 4;
    const float* src = W + (size_t)(k0 + 16 * q) * N + n0 + 4 * ng;
    f32x4 v[16];
#pragma unroll
    for (int j = 0; j < 16; ++j) v[j] = NT_P0 ? __builtin_nontemporal_load((const f32x4*)(src + (size_t)j * N)) : *(const f32x4*)(src + (size_t)j * N);
#pragma unroll
    for (int nn = 0; nn < 4; ++nn)
#pragma unroll
        for (int c = 0; c < 2; ++c) { u32x4 w; w.x = pk2(v[8 * c][nn], v[8 * c + 1][nn]); w.y = pk2(v[8 * c + 2][nn], v[8 * c + 3][nn]); w.z = pk2(v[8 * c + 4][nn], v[8 * c + 5][nn]); w.w = pk2(v[8 * c + 6][nn], v[8 * c + 7][nn]);
            *(LAS u32x4*)(tile + (4 * ng + nn) * 144 + (16 * q + 8 * c) * 2) = w; }
    LDS_WAIT(); asm volatile("" ::: "memory");
#pragma unroll
    for (int i = 0; i < 8; ++i) { const int r = 8 * i + (lane >> 3), ch = lane & 7; const u32x4 w = *(const LAS u32x4*)(tile + r * 144 + ch * 16);
        const int n = n0 + r; int nr = n;
        if (QKVMAP && n < 2048) { const int c = n & 255; nr = (n - c) + ((c & 63) >> 5) * 128 + (c >> 6) * 32 + (c & 31); }
        if (NT_P0S) st16_nt(WT + (size_t)nr * K + k0 + 8 * ch, w); else st16(WT + (size_t)nr * K + k0 + 8 * ch, w); }
    LDS_WAIT(); asm volatile("" ::: "memory");
}

template <bool QKVMAP>
__device__ __forceinline__ void transpose_item_sw(const float* W, int K, int N, bf16_t* WT, int item, int lane, LAS unsigned char* tile, const float* shl  , float (&acc)[8][5]) {
    const int nblk = N / 64, kb = item / nblk, nb = item % nblk, k0 = 64 * kb, n0 = 64 * nb;
    const int ng = lane & 15, q = lane >> 4;
    const float* src = W + (size_t)(k0 + 16 * q) * N + n0 + 4 * ng;
    {
        f32x4 v[16];
#pragma unroll
        for (int j = 0; j < 16; ++j) v[j] = NT_P0 ? __builtin_nontemporal_load((const f32x4*)(src + (size_t)j * N)) : *(const f32x4*)(src + (size_t)j * N);
#pragma unroll
        for (int nn = 0; nn < 4; ++nn)
#pragma unroll
            for (int c = 0; c < 2; ++c) { u32x4 w; w.x = pk2(v[8 * c][nn], v[8 * c + 1][nn]); w.y = pk2(v[8 * c + 2][nn], v[8 * c + 3][nn]); w.z = pk2(v[8 * c + 4][nn], v[8 * c + 5][nn]); w.w = pk2(v[8 * c + 6][nn], v[8 * c + 7][nn]);
                *(LAS u32x4*)(tile + (4 * ng + nn) * 144 + (16 * q + 8 * c) * 2) = w; }
    }
    LDS_WAIT(); asm volatile("" ::: "memory");
    const int ch = lane & 7;
    f32x4 sh[5][2];
#pragma unroll
    for (int cd = 0; cd < 5; ++cd) { sh[cd][0] = *(const f32x4*)(shl + (size_t)cd * 6144 + k0 + 8 * ch); sh[cd][1] = *(const f32x4*)(shl + (size_t)cd * 6144 + k0 + 8 * ch + 4); }
#pragma unroll
    for (int i = 0; i < 8; ++i) { const int r = 8 * i + (lane >> 3); const u32x4 w = *(const LAS u32x4*)(tile + r * 144 + ch * 16);
        const int n = n0 + r; int nr = n;
        if (QKVMAP && n < 2048) { const int c = n & 255; nr = (n - c) + ((c & 63) >> 5) * 128 + (c >> 6) * 32 + (c & 31); }
        if (NT_P0S) st16_nt(WT + (size_t)nr * K + k0 + 8 * ch, w); else st16(WT + (size_t)nr * K + k0 + 8 * ch, w);
        const float w0 = __uint_as_float(w.x << 16), w1 = __uint_as_float(w.x & 0xffff0000u), w2 = __uint_as_float(w.y << 16), w3 = __uint_as_float(w.y & 0xffff0000u);
        const float w4 = __uint_as_float(w.z << 16), w5 = __uint_as_float(w.z & 0xffff0000u), w6 = __uint_as_float(w.w << 16), w7 = __uint_as_float(w.w & 0xffff0000u);
#pragma unroll
        for (int cd = 0; cd < 5; ++cd) acc[i][cd] += ((sh[cd][0][0] * w0 + sh[cd][0][1] * w1) + (sh[cd][0][2] * w2 + sh[cd][0][3] * w3)) + ((sh[cd][1][0] * w4 + sh[cd][1][1] * w5) + (sh[cd][1][2] * w6 + sh[cd][1][3] * w7)); }
    LDS_WAIT(); asm volatile("" ::: "memory");
}

__global__ void __launch_bounds__(512, 2) fwd_kernel(Args args_by_value_unused) {
    extern __shared__ __attribute__((aligned(16))) unsigned char lds_raw[];
    LAS unsigned char* lds = (LAS unsigned char*)lds_raw;
    const int tid = threadIdx.x, lane = tid & 63; const int wave = __builtin_amdgcn_readfirstlane(tid >> 6);
    constexpr int G = 256;
#define PBX() ({ int b_ = __builtin_amdgcn_readfirstlane((int)MISC[14]); asm volatile("" : "+s"(b_)); b_; })
#define PTID() ({ unsigned z_ = 0u; asm volatile("" : "+v"(z_)); (int)(wave * 64 + (int)__builtin_amdgcn_mbcnt_hi(~0u, __builtin_amdgcn_mbcnt_lo(~0u, z_))); })
#define VCU(b_) (((b_) & 7) * 32 + ((b_) >> 3))
    int lo, hi;
    volatile LAS unsigned* MISC = (volatile LAS unsigned*)(lds + MISC_OFF);
    for (int u = tid; u < (LDS_BYTES - LDSCTL_OFF) / 4; u += 512) ((LAS unsigned*)(lds + LDSCTL_OFF))[u] = 0u;
    __syncthreads();
#define STRM(b_) (((b_) & 7) / (8 / NS))
#define LBI(b_) ((((b_) & 7) % (8 / NS)) * 32 + ((b_) >> 3))
    { CArgs A = args_ptr(); lo = A->ph_lo; hi = A->ph_hi; unsigned* ctl = (unsigned*)(A->ws + WS_CTL);
      if (tid == 0) { MISC[14] = blockIdx.x; MISC[15] = 0u;
          if (MK_SINGLE) { const unsigned x = xb_xcc_id(); const unsigned idx = xb_add(&(ctl + CW_BAR)[XB_XCNT(x)], 1u); MISC[13] = idx * 8u + x; } }
      __syncthreads(); }
#define MAKE_BAR(bq_, k) XcdBarrier bq_; { CArgs Ab_ = args_ptr(); unsigned* ctl_ = (unsigned*)(Ab_->ws + WS_CTL); const bool glob_ = (k) <= 1; \
        bq_.bar = ctl_ + CW_BAR + (glob_ ? 0 : (1 + STRM(PBX())) * XCD_BAR_WORDS); bq_.x = xb_xcc_id(); bq_.st = MISC + (glob_ ? 8 : 10); bq_.n = (unsigned)(glob_ ? G : G / NS); }
#define IN(k) (lo <= (k) && (k) < hi)
#define SEAMW_(k, WJ) do { if (PROBE_KL == 2 && (k) == PROBE_PH && PTID() == 0) pt2 = __builtin_amdgcn_s_memrealtime(); if (PROBE_KL == 3 && (k) == PROBE_PH) { asm volatile("s_waitcnt vmcnt(0)" ::: "memory"); if (PTID() == 0) pt2 = __builtin_amdgcn_s_memrealtime(); } if (IN(k) && IN((k) + 1)) { MAKE_BAR(bq_, k); for (int d_ = 0; d_ < DUP_BAR; ++d_) xcd_barrier(bq_, PTID() == 0, WJ); } \
        if (PROBE_PH >= 0 && PTID() == 0) { if ((k) + 1 == PROBE_PH) pt0 = __builtin_amdgcn_s_memrealtime(); if ((k) == PROBE_PH) { pt1 = __builtin_amdgcn_s_memrealtime(); if (PROBE_KL >= 2) pt1 = pt2; if (PROBE_KL == 1) { CArgs A_ = args_ptr(); pt1 = __hip_atomic_load((unsigned long long*)(A_->ws + 512), __ATOMIC_RELAXED, __HIP_MEMORY_SCOPE_AGENT); } } } } while (0)
    constexpr int NGW = G * 8;
#define SEAM(k) SEAMW_(k, (Warm{nullptr, 0u, 0, 0, 0, nullptr}))
#define MAKE_WARM(ptr_, n_) ({ const int pt_ = PTID(); Warm{(ptr_), (unsigned)(n_), __builtin_amdgcn_readfirstlane(pt_ >> 6), VCU(PBX()), pt_ & 63, lds}; })
#define SEAMXW_(k, WJ) do { if (IN(k) && IN((k) + 1) && __builtin_amdgcn_readfirstlane((int)MISC[15])) { CArgs Ax_ = args_ptr(); unsigned* ctlx_ = (unsigned*)(Ax_->ws + WS_CTL); \
        xcc_barrier(ctlx_ + CW_XL + 64 * (xb_xcc_id() & 7u), ctlx_ + CW_BAR + XB_TMO, PTID() == 0, WJ); \
        if (PROBE_PH >= 0 && PTID() == 0) { if ((k) + 1 == PROBE_PH) pt0 = __builtin_amdgcn_s_memrealtime(); if ((k) == PROBE_PH) pt1 = __builtin_amdgcn_s_memrealtime(); } } else SEAMW_(k, WJ); } while (0)
#define SEAMX(k) SEAMXW_(k, (Warm{nullptr, 0u, 0, 0, 0, nullptr}))
    volatile LAS unsigned long long* PTS = (volatile LAS unsigned long long*)(lds + MISC_OFF + 64);
#define pt0 PTS[0]
#define pt1 PTS[1]
#define pt2 PTS[2]
    if (PROBE_PH >= 0 && tid == 0) pt0 = __builtin_amdgcn_s_memrealtime();

    if (EN_PRO && IN(0)) for (int dup_ = 0; dup_ < DUP_PRO; ++dup_) {
        const int bx = PBX(); const int gw = VCU(bx) * 8 + wave;
        {
            CArgs A = args_ptr();
            LAS float* sl = (LAS float*)lds;
            LAS f32x4* red = (LAS f32x4*)(lds + 20480);
            const float* c = A->in[6]; const float* cctx = A->in[7]; float* mod = (float*)(A->ws + WS_MOD);
            for (int idx = tid; idx < 5120; idx += 512) { const int n = idx >> 10, k = idx & 1023; const float x = n == 0 ? cctx[k] : c[(n - 1) * 1024 + k]; sl[idx] = x / (1.f + __expf(-x)); }
            __syncthreads();
            for (int wq = bx; wq < 256; wq += G) {
                const int l = wq >> 6, cb = (wq & 63) * 96;
                if (tid < 384) {
                    const int cg = tid % 24, ks = tid / 24;
                    const float* wp = A->in[8] + ((size_t)l * 1024 + ks * 64) * 6144 + cb + 4 * cg;
                    f32x4 a[5];
#pragma unroll
                    for (int n = 0; n < 5; ++n) a[n] = (f32x4){0.f, 0.f, 0.f, 0.f};
#pragma unroll 8
                    for (int k = 0; k < 64; ++k) { const f32x4 w4 = NT_P0 ? __builtin_nontemporal_load((const f32x4*)(wp + (size_t)k * 6144)) : *(const f32x4*)(wp + (size_t)k * 6144);
#pragma unroll
                        for (int n = 0; n < 5; ++n) a[n] += sl[n * 1024 + ks * 64 + k] * w4; }
#pragma unroll
                    for (int n = 0; n < 5; ++n) red[(ks * 24 + cg) * 5 + n] = a[n];
                }
                __syncthreads();
                if (tid < 120) { const int cg = tid / 5, n = tid % 5; f32x4 s = *(const f32x4*)(A->in[9] + l * 6144 + cb + 4 * cg);
                    for (int ks = 0; ks < 16; ++ks) s += red[(ks * 24 + cg) * 5 + n];
                    *(f32x4*)(mod + ((size_t)l * 5 + n) * 6144 + cb + 4 * cg) = s; }
                __syncthreads();
            }
        }
        if (bx == 0) {
            CArgs A = args_ptr(); float* ropet = (float*)(A->ws + WS_ROPE);
            for (int idx = tid; idx < 1024; idx += 512) { const int pos = idx >> 4, j = idx & 15; const float fr = powf(10000.f, -(float)j / 16.f); const float ang = (float)pos * fr; ropet[2 * idx] = cosf(ang); ropet[2 * idx + 1] = sinf(ang); }
        }
        if (bx == 1 % G && wave < 2) {
            CArgs A = args_ptr(); float* lamv = (float*)(A->ws + WS_LAM);
            const int i = wave; const float a1 = A->in[18][i * 64 + lane] * A->in[19][i * 64 + lane], a2 = A->in[20][i * 64 + lane] * A->in[21][i * 64 + lane];
            const float s1 = wave_sum(a1), s2 = wave_sum(a2); const float linit = 0.8f - 0.6f * expf(-0.3f * (float)(2 * i));
            if (lane == 0) lamv[i] = expf(s1) - expf(s2) + linit;
        }
        {
            CArgs A = args_ptr(); bf16_t* cache = (bf16_t*)(A->ws + WS_CACHE);
            for (int ch0 = gw * 64 + lane; ch0 < 4 * 2 * 4 * 256 * 128; ch0 += 4 * NGW * 64) {
                f32x4 v0[4], v1[4];
#pragma unroll
                for (int u = 0; u < 4; ++u) { const int ch = ch0 + u * NGW * 64;
                    const int c8 = ch & 127, t = (ch >> 7) & 255, b = (ch >> 15) & 3, i = (ch >> 17) & 1, kind = ch >> 18;
                    const float* src = A->in[2 + kind] + (((size_t)(b * 2 + i) * 256 + t) * 1024);
                    if ((kind & 1) == 0) { const int Gh = c8 >> 3, p8 = c8 & 7, bj = p8 >> 2, fq = p8 & 3; const float* sp = src + 64 * Gh + 32 * bj + 4 * fq; v0[u] = NT_IN ? __builtin_nontemporal_load((const f32x4*)sp) : *(const f32x4*)sp; v1[u] = NT_IN ? __builtin_nontemporal_load((const f32x4*)(sp + 16)) : *(const f32x4*)(sp + 16); }
                    else { v0[u] = NT_IN ? __builtin_nontemporal_load((const f32x4*)(src + 8 * c8)) : *(const f32x4*)(src + 8 * c8); v1[u] = NT_IN ? __builtin_nontemporal_load((const f32x4*)(src + 8 * c8 + 4)) : *(const f32x4*)(src + 8 * c8 + 4); } }
#pragma unroll
                for (int u = 0; u < 4; ++u) { const int ch = ch0 + u * NGW * 64;
                    u32x4 w; w.x = pk2(v0[u][0], v0[u][1]); w.y = pk2(v0[u][2], v0[u][3]); w.z = pk2(v1[u][0], v1[u][1]); w.w = pk2(v1[u][2], v1[u][3]);
                    st16(cache + (size_t)ch * 8, w); }
            }
        }
        {
            LAS unsigned char* ttile = lds + 65536 + wave * 9216;
#pragma unroll 1
            for (int sidx = gw; sidx < 5120; sidx += NGW) {
                CArgs A = args_ptr();
                const int l = DEPTH - 1 - sidx / 1280, i = l >> 1; int r = sidx % 1280;
                unsigned char* wl = A->ws + WS_W + (size_t)l * W_LAYER;
                if (r < 256) { transpose_item<false>(A->in[(l & 1) ? 24 : 15] + (size_t)i * 1024 * 1024, 1024, 1024, (bf16_t*)(wl + W_O), r, lane, ttile); continue; } r -= 256;
                transpose_item<false>(A->in[13] + (size_t)l * 4096 * 1024, 4096, 1024, (bf16_t*)(wl + W_2), r, lane, ttile);
            }
        }
    }
    SEAM(0);
    if (MK_SINGLE && IN(0) && IN(1)) {
        if (PTID() == 0) { CArgs A = args_ptr(); unsigned* bar0 = (unsigned*)(A->ws + WS_CTL) + CW_BAR; bool ok = xb_xcc_id() < 8u;
            unsigned cen_[8];
#pragma unroll
            for (unsigned j = 0; j < 8; ++j) cen_[j] = xb_ld(&bar0[XB_XCNT(j)]);
#pragma unroll
            for (unsigned j = 0; j < 8; ++j) ok = ok & (cen_[j] == 32u);
            if (XCC_MODE && ok) { MISC[14] = MISC[13]; MISC[15] = 1u; } }
        __syncthreads();
        if (PTID() == 0) { CArgs A = args_ptr(); unsigned* ctl = (unsigned*)(A->ws + WS_CTL); (void)xb_add(&(ctl + CW_BAR + (1 + STRM(PBX())) * XCD_BAR_WORDS)[XB_XCNT(xb_xcc_id())], 1u); }
    }
    if (EN_NORM && IN(1)) for (int dup_ = 0; dup_ < DUP_NORM; ++dup_) {
        {
            CArgs A = args_ptr(); const int ptid = PTID(); const int lane = ptid & 63; const int gwv = VCU(PBX()) * 8 + __builtin_amdgcn_readfirstlane(ptid >> 6);
            const float* gam = A->in[10]; const float* modl = (const float*)(A->ws + WS_MOD); bf16_t* XN = (bf16_t*)(A->ws + WS_XN); bf16_t* YB = (bf16_t*)(A->ws + WS_YB); float* ssq = (float*)(A->ws + WS_SSQ);
            for (int rb = gwv * 4; rb < M; rb += NGW * 4) {
                const float* xr = rb < MP ? A->in[0] + (size_t)rb * D : A->in[1] + (size_t)(rb - MP) * D;
                const float* sc = modl + (rb < MP ? 0 : 1 + ((rb - MP) >> 10)) * 6144 + 1024;
                f32x4 v[4][4];
#pragma unroll
                for (int q = 0; q < 4; ++q)
#pragma unroll
                    for (int j = 0; j < 4; ++j) v[q][j] = NT_IN ? __builtin_nontemporal_load((const f32x4*)(xr + (size_t)q * D + 4 * lane + 256 * j)) : *(const f32x4*)(xr + (size_t)q * D + 4 * lane + 256 * j);
                f32x4 gs[4];
#pragma unroll
                for (int j = 0; j < 4; ++j) { const int c = 4 * lane + 256 * j; gs[j] = *(const f32x4*)(gam + c) * (1.f + *(const f32x4*)(sc + c)); }
#pragma unroll
                for (int q = 0; q < 4; ++q) {
                    float ss = 0.f;
#pragma unroll
                    for (int j = 0; j < 4; ++j) ss += (v[q][j][0] * v[q][j][0] + v[q][j][1] * v[q][j][1]) + (v[q][j][2] * v[q][j][2] + v[q][j][3] * v[q][j][3]);
                    ss = wave_sum(ss);
#pragma unroll
                    for (int j = 0; j < 4; ++j) { const f32x4 h = v[q][j] * gs[j]; u32x2 w; w.x = pk2(h[0], h[1]); w.y = pk2(h[2], h[3]); st8(XN + (size_t)(rb + q) * D + 4 * lane + 256 * j, w);
                        u32x2 wy; wy.x = pk2(v[q][j][0], v[q][j][1]); wy.y = pk2(v[q][j][2], v[q][j][3]); st8(YB + (size_t)(rb + q) * D + 4 * lane + 256 * j, wy); }
                    if (lane < 32) st4f(ssq + (size_t)(rb + q) * 32 + lane, ss * (1.f / 32.f));
                }
            }
        }
        { const int bx = PBX(); const int gw = VCU(bx) * 8 + wave;
        {
            LAS unsigned char* ttile = lds + 65536 + wave * 9216;
            const int sidx = VCU(bx) * 2 + (wave >> 2), kq = wave & 3; const bool act = sidx < 448;
            const int l = DEPTH - 1 - (act ? sidx : 0) / 112, i = l >> 1, t = (act ? sidx : 0) % 112; const bool isq = t < 48; const int nb = isq ? t : t - 48;
            float acc[8][5];
#pragma unroll
            for (int i2 = 0; i2 < 8; ++i2)
#pragma unroll
                for (int c = 0; c < 5; ++c) acc[i2][c] = 0.f;
            if (act) {
                CArgs A = args_ptr(); unsigned char* wl = A->ws + WS_W + (size_t)l * W_LAYER;
                const float* shl = (const float*)(A->ws + WS_MOD) + (size_t)l * 5 * 6144 + (isq ? 0 : 3) * 1024;
                if (isq) {
#pragma unroll 1
                    for (int j = 0; j < 4; ++j) transpose_item_sw<true>(A->in[(l & 1) ? 23 : 14] + (size_t)i * 1024 * 3072, 1024, 3072, (bf16_t*)(wl + W_QKV), (4 * kq + j) * 48 + nb, lane, ttile, shl, acc);
                } else {
#pragma unroll 1
                    for (int j = 0; j < 4; ++j) transpose_item_sw<false>(A->in[12] + (size_t)l * 1024 * 4096, 1024, 4096, (bf16_t*)(wl + W_1), (4 * kq + j) * 64 + nb, lane, ttile, shl, acc);
                }
            }
            LAS float* red = (LAS float*)lds;
#pragma unroll
            for (int i2 = 0; i2 < 8; ++i2)
#pragma unroll
                for (int c = 0; c < 5; ++c) { float x = acc[i2][c]; x += __shfl_xor(x, 1); x += __shfl_xor(x, 2); x += __shfl_xor(x, 4); if ((lane & 7) == 0) red[((wave * 8 + i2) * 5 + c) * 8 + (lane >> 3)] = x; }
            __syncthreads();
            if (act && kq == 0) { CArgs A = args_ptr(); float* swt = (float*)(A->ws + WS_SW4) + (size_t)l * 5 * 7168;
                const int n = 64 * nb + lane; int nr = n;
                if (isq && n < 2048) { const int c = n & 255; nr = (n - c) + ((c & 63) >> 5) * 128 + (c >> 6) * 32 + (c & 31); }
                const int col = isq ? nr : 3072 + nr;
#pragma unroll
                for (int c = 0; c < 5; ++c) { float sum = 0.f;
#pragma unroll
                    for (int k4 = 0; k4 < 4; ++k4) sum += red[(((wave + k4) * 8 + (lane >> 3)) * 5 + c) * 8 + (lane & 7)];
                    swt[c * 7168 + col] = sum; } }
            __syncthreads();
        }
        }
    }
    if (MICRO_PAT && IN(1)) {
        CArgs A = args_ptr(); const int ptid = PTID(); const int lane = ptid & 63; const int gwv = VCU(PBX()) * 8 + __builtin_amdgcn_readfirstlane(ptid >> 6);
        unsigned char* base = A->ws + WS_H + (size_t)gwv * 32768;
        const u32x4 val = {1u, 2u, 3u, (unsigned)lane};
        for (int rep = 0; rep < MICRO_REP; ++rep)
#pragma unroll 8
            for (int it = 0; it < 32; ++it) {
                unsigned char* p;
                if (MICRO_PAT == 1) p = base + it * 1024 + lane * 16;
                else if (MICRO_PAT == 2) p = base + (it >> 1) * 2048 + lane * 32 + (it & 1) * 16;
                else if (MICRO_PAT == 3) p = base + (lane >> 2) * 2048 + (it) * 64 + (lane & 3) * 16;
                else p = base + lane * 512 + it * 16;
                *(u32x4*)p = val; }
    }
    SEAM(1);
    if (NS > 1 && STREAM_DELAY_US > 0 && IN(1) && IN(2)) { const int strm = STRM(blockIdx.x); const unsigned long long t0_ = __builtin_amdgcn_s_memrealtime(); while (__builtin_amdgcn_s_memrealtime() - t0_ < (unsigned long long)(strm * STREAM_DELAY_US * 100)) __builtin_amdgcn_s_sleep(32); }

    for (int l = 0; l < DEPTH; ++l) {
        const int pb = 2 + 5 * l, i = l >> 1; const bool diff = (l & 1) == 0;
        if (EN_QKV && IN(pb + 0)) for (int dup_ = 0; dup_ < DUP_QKV; ++dup_) {
            {
                CArgs A = args_ptr(); unsigned char* ws = A->ws; const int ptid = PTID(); const int pbx = PBX(); const bf16_t* wq = (const bf16_t*)(ws + WS_W + (size_t)l * W_LAYER + W_QKV);
                pg8::Gemm g{(const bf16_t*)(ws + WS_XN), wq, 1024, (unsigned long long*)(ws + 512)}; pg8::StaticOrder S; S.init(8, STRM(pbx), LBI(pbx));
                pg8::EpiQK E{ws, A->in[diff ? 16 : 25] + i * 64, A->in[diff ? 17 : 26] + i * 64, A->out + (diff ? OUT_DK : OUT_NK) + (size_t)i * 256 * 1024, l, diff, lds};
                pg8::gemm_phase<pg8::EpiQK, 2, true>(lds, g, S, E, ptid);
            }
            {
                CArgs A = args_ptr(); unsigned char* ws = A->ws; const int ptid = PTID(); const int pbx = PBX(); const bf16_t* wq = (const bf16_t*)(ws + WS_W + (size_t)l * W_LAYER + W_QKV);
                pg8::Gemm g{(const bf16_t*)(ws + WS_XN), wq + (size_t)2048 * 1024, 1024, (unsigned long long*)(ws + 512)}; pg8::StaticOrder S; S.init(8, STRM(pbx), LBI(pbx));
                pg8::EpiV E{(bf16_t*)(ws + WS_V), A->out + (diff ? OUT_DV : OUT_NV) + (size_t)i * 256 * 1024, (const float*)(ws + WS_SSQ), (const float*)(ws + WS_SW4) + (size_t)l * 5 * 7168, lds};
                pg8::gemm_phase_n1<pg8::EpiV, true>(lds, g, S, E, ptid);
            }
        }
        if (PF_ON && PF_BAR) { CArgs Aw_ = args_ptr(); const Warm wj_ = MAKE_WARM(Aw_->ws + WS_W + (size_t)l * W_LAYER + W_O, (W_LAYER - W_O) / 128); SEAMW_(pb + 0, wj_); }
        else SEAM(pb + 0);
        if (EN_ATT && IN(pb + 1)) {
            if (PF_ON && !PF_BAR) { CArgs A = args_ptr(); const int ptid = PTID(); warm_lines(lds, A->ws + WS_W + (size_t)l * W_LAYER + W_O, (unsigned)((W_LAYER - W_O) / 128), VCU(PBX()) * 8 + __builtin_amdgcn_readfirstlane(ptid >> 6), ptid & 63); }
            bool fastsm;
            fastsm = false;
            if (diff) { CArgs A = args_ptr(); const int ln_ = PTID() & 63;
              float bnd = 64.f * C2 * wave_max(fabsf(A->in[diff ? 16 : 25][i * 64 + ln_])) * wave_max(fabsf(A->in[diff ? 17 : 26][i * 64 + ln_]));
              fastsm = FASTSM && diff && __builtin_amdgcn_readfirstlane((int)(bnd <= 60.f)) != 0; }
            { const int abx = PBX(); const int v = LBI(abx), strm = STRM(abx); constexpr int HB = 16 / NS, LB = 4 / NS;
                if (diff) {

                    { auto body_ = [&](auto fsm_) { constexpr bool FSM_ = decltype(fsm_)::value;
                        CArgs A = args_ptr(); unsigned char* ws = A->ws; const int ptid = PTID(); const int pbx = PBX(); const bf16_t* Qb = (const bf16_t*)(ws + WS_Q); const bf16_t* Kb = (const bf16_t*)(ws + WS_K); const bf16_t* Vb = (const bf16_t*)(ws + WS_V); bf16_t* Ob = (bf16_t*)(ws + WS_O);
                        const float lam = ((const float*)(ws + WS_LAM))[i]; const float* subg = A->in[22] + i * 128;
                        const int pw = __builtin_amdgcn_readfirstlane(ptid >> 6), rg = pw & 3, mp = pw >> 2; const int b = strm * HB + (v >> 4), h = (v >> 1) & 7, qb = v & 1; const int q0 = b * 256 + qb * 128 + rg * 32;
                        att::Seg sg{Kb + (size_t)(b * 256) * D + h * 128, Vb + (size_t)(b * 256) * D + h * 128, 4, nullptr, nullptr, 0};
                        float* fo = A->out + (size_t)(b * 2 + i) * 256 * 1024 + h * 128;
                        att::attn_unit<true, false, FSM_>(ptid, lds, Qb + (size_t)q0 * D + h * 128 + mp * 64, sg, Ob + (size_t)q0 * D + h * 128, 0, 0, 0, nullptr, lam, l, subg, qb == 0 ? fo + OUT_DK : nullptr, qb == 1 ? fo + OUT_DV : nullptr);
                    }; if (fastsm) body_(std::true_type{}); else body_(std::false_type{}); }
                    { auto body_ = [&](auto fsm_) { constexpr bool FSM_ = decltype(fsm_)::value;
                        CArgs A = args_ptr(); unsigned char* ws = A->ws; const int ptid = PTID(); const int pbx = PBX(); const bf16_t* Qb = (const bf16_t*)(ws + WS_Q); const bf16_t* Kb = (const bf16_t*)(ws + WS_K); const bf16_t* Vb = (const bf16_t*)(ws + WS_V); bf16_t* Ob = (bf16_t*)(ws + WS_O);
                        const bf16_t* cache = (const bf16_t*)(ws + WS_CACHE);
                        const float lam = ((const float*)(ws + WS_LAM))[i]; const float* subg = A->in[22] + i * 128;
                        const int pw = __builtin_amdgcn_readfirstlane(ptid >> 6), rg = pw & 3, mp = pw >> 2; const int b = strm * LB + (v >> 6), h = (v >> 3) & 7, qb = v & 7; const int q0 = MP + b * 1024 + qb * 128 + rg * 32;
                        const bf16_t* ck = cache + ((size_t)(0 * 2 + i) * 4 + b) * 256 * 1024 + h * 128; const bf16_t* cv = cache + ((size_t)(1 * 2 + i) * 4 + b) * 256 * 1024 + h * 128;
                        att::Seg sg{Kb + (size_t)(MP + b * 1024) * D + h * 128, Vb + (size_t)(MP + b * 1024) * D + h * 128, 16, ck, cv, 4};
                        att::attn_unit<true, false, FSM_>(ptid, lds, Qb + (size_t)q0 * D + h * 128 + mp * 64, sg, Ob + (size_t)q0 * D + h * 128, 0, 0, 0, nullptr, lam, l, subg, nullptr, nullptr);
                    }; if (fastsm) body_(std::true_type{}); else body_(std::false_type{}); }
                } else {
                    { auto body_ = [&](auto fsm_) { constexpr bool FSM_ = decltype(fsm_)::value;
                        CArgs A = args_ptr(); unsigned char* ws = A->ws; const int ptid = PTID(); const int pbx = PBX(); const bf16_t* Qb = (const bf16_t*)(ws + WS_Q); const bf16_t* Kb = (const bf16_t*)(ws + WS_K); const bf16_t* Vb = (const bf16_t*)(ws + WS_V); bf16_t* Ob = (bf16_t*)(ws + WS_O);
                        const int pw = __builtin_amdgcn_readfirstlane(ptid >> 6); const int b = strm * HB + (v >> 4), h = v & 15; const int q0 = b * 256 + pw * 32;
                        att::Seg sg{Kb + (size_t)(b * 256) * D + h * 64, Vb + (size_t)(b * 256) * D + h * 64, 4, nullptr, nullptr, 0};
                        float* fo = A->out + (size_t)(b * 2 + i) * 256 * 1024 + h * 64;
                        att::attn_unit<false, false, FSM_>(ptid, lds, Qb + (size_t)q0 * D + h * 64, sg, Ob + (size_t)q0 * D + h * 64, 0, 0, 0, nullptr, 0.f, 0, nullptr, fo + OUT_NK, fo + OUT_NV);
                    }; body_(std::false_type{}); }
                    { auto body_ = [&](auto fsm_) { constexpr bool FSM_ = decltype(fsm_)::value;
                        CArgs A = args_ptr(); unsigned char* ws = A->ws; const int ptid = PTID(); const int pbx = PBX(); const bf16_t* Qb = (const bf16_t*)(ws + WS_Q); const bf16_t* Kb = (const bf16_t*)(ws + WS_K); const bf16_t* Vb = (const bf16_t*)(ws + WS_V); bf16_t* Ob = (bf16_t*)(ws + WS_O);
                        const bf16_t* cache = (const bf16_t*)(ws + WS_CACHE);
                        const int b = strm * LB + (v >> 6), h = (v >> 2) & 15, R = v & 3; const int pw = __builtin_amdgcn_readfirstlane(ptid >> 6); const int r_q = 4 * R + 2 * (pw >> 2), jj = pw & 3; const int q0 = MP + b * 1024 + r_q * 64 + jj * 16;
                        const int kr_lo = min(max(4 * R - 4, 0), 8), kr_hi = min(max(4 * R + 3 - 4, 0), 8) + 8;
                        const bf16_t* ck = cache + ((size_t)(2 * 2 + i) * 4 + b) * 256 * 1024 + h * 64; const bf16_t* cv = cache + ((size_t)(3 * 2 + i) * 4 + b) * 256 * 1024 + h * 64;
                        att::Seg sg{Kb + (size_t)(MP + b * 1024 + kr_lo * 64) * D + h * 64, Vb + (size_t)(MP + b * 1024 + kr_lo * 64) * D + h * 64, kr_hi - kr_lo, ck, cv, 4};
                        att::attn_unit<false, true, FSM_>(ptid, lds, Qb + (size_t)q0 * D + h * 64, sg, Ob + (size_t)q0 * D + h * 64, kr_lo, r_q, jj, A->in[27] + ((size_t)i * 16 + h) * 465, 0.f, 0, nullptr, nullptr, nullptr);
                    }; body_(std::false_type{}); }
                }
            }
        }
        SEAM(pb + 1);
        if (EN_O && IN(pb + 2)) {
            CArgs A = args_ptr(); unsigned char* ws = A->ws; const int ptid = PTID(); const int pbx = PBX();
            const float* modl = (const float*)(ws + WS_MOD) + (size_t)l * 5 * 6144;
            pg8::Gemm g{(const bf16_t*)(ws + WS_O), (const bf16_t*)(ws + WS_W + (size_t)l * W_LAYER + W_O), 1024, (unsigned long long*)(ws + 512)}; pg8::StaticOrder S; S.init(8, STRM(pbx), LBI(pbx));
            pg8::EpiResid E{(const bf16_t*)(ws + WS_YB), (bf16_t*)(ws + WS_YB), nullptr, modl + 2 * 1024,
                            A->in[11] + l * 1024, modl + 4 * 1024, (bf16_t*)(ws + WS_XN), (float*)(ws + WS_SSQ), lds};
            pg8::gemm_phase_n1<pg8::EpiResid, true>(lds, g, S, E, ptid);
        }
        SEAMX(pb + 2);
        if (EN_FC1 && IN(pb + 3)) for (int dup_ = 0; dup_ < DUP_FC1; ++dup_) {
            CArgs A = args_ptr(); unsigned char* ws = A->ws; const int ptid = PTID(); const int pbx = PBX();
            pg8::Gemm g{(const bf16_t*)(ws + WS_XN), (const bf16_t*)(ws + WS_W + (size_t)l * W_LAYER + W_1), 1024, (unsigned long long*)(ws + 512)}; pg8::StaticOrder S; S.init(16, STRM(pbx), LBI(pbx));
            pg8::EpiRelu2 E{(bf16_t*)(ws + WS_H), (const float*)(ws + WS_SSQ), (const float*)(ws + WS_SW4) + (size_t)l * 5 * 7168, lds};
            pg8::gemm_phase<pg8::EpiRelu2, 2, true>(lds, g, S, E, ptid);
        }
        if (PF_ON && PF_BAR && l + 1 < DEPTH) { CArgs Aw_ = args_ptr(); const Warm wj_ = MAKE_WARM(Aw_->ws + WS_W + (size_t)(l + 1) * W_LAYER + W_QKV, W_O / 128); SEAMXW_(pb + 3, wj_); }
        else SEAMX(pb + 3);
        if (EN_FC2 && IN(pb + 4)) {
            if (PF_ON && !PF_BAR && l + 1 < DEPTH) { CArgs A = args_ptr(); const int ptid = PTID(); warm_lines(lds, A->ws + WS_W + (size_t)(l + 1) * W_LAYER + W_QKV, (unsigned)(W_O / 128), VCU(PBX()) * 8 + __builtin_amdgcn_readfirstlane(ptid >> 6), ptid & 63); }
            CArgs A = args_ptr(); unsigned char* ws = A->ws; const int ptid = PTID(); const int pbx = PBX();
            const float* modl = (const float*)(ws + WS_MOD) + (size_t)l * 5 * 6144; const bool more = l + 1 < DEPTH;
            pg8::Gemm g{(const bf16_t*)(ws + WS_H), (const bf16_t*)(ws + WS_W + (size_t)l * W_LAYER + W_2), 4096, (unsigned long long*)(ws + 512), true}; pg8::StaticOrder S; S.init(8, STRM(pbx), LBI(pbx));
            pg8::EpiResid E{(const bf16_t*)(ws + WS_YB), (bf16_t*)(ws + WS_YB), more ? nullptr : A->out + OUT_Y, modl + 5 * 1024,
                            A->in[10] + (l + 1) * 1024, modl + 5 * 6144 + 1 * 1024, more ? (bf16_t*)(ws + WS_XN) : nullptr, (float*)(ws + WS_SSQ), lds};
            pg8::gemm_phase_n1<pg8::EpiResid, true>(lds, g, S, E, ptid);
        }
        SEAMX(pb + 4);
    }
    if (PROBE_PH >= 0) { if (PROBE_PH == 2 + 5 * DEPTH - 1 && PTID() == 0) pt1 = __builtin_amdgcn_s_memrealtime(); { MAKE_BAR(bq_, 0); xcd_barrier(bq_, PTID() == 0); }
        if (blockIdx.x == 0 && PTID() == 0) { CArgs A = args_ptr(); A->out[0] += (float)(pt1 - pt0) * 0.001f; } }
#undef IN
#undef SEAM
}

extern "C" void kernel_launch(void* const* d_in, const int* in_sizes, int n_in, void* d_out, int out_size, void* d_ws, size_t ws_size, hipStream_t stream) {
    static int grid = 0;
    if (grid == 0) {
        if (n_in != 28 || out_size != 41943040 || ws_size < WS_END) { fprintf(stderr, "kernel_launch: unexpected shapes (n_in %d, out %d, ws %zu); nothing launched\n", n_in, out_size, ws_size); grid = -1; return; }
        int dev = 0, cus = 0;
        if (hipGetDevice(&dev) != hipSuccess || hipDeviceGetAttribute(&cus, hipDeviceAttributeMultiprocessorCount, dev) != hipSuccess) { grid = -1; return; }
        if (hipFuncSetAttribute((const void*)fwd_kernel, hipFuncAttributeMaxDynamicSharedMemorySize, LDS_BYTES) != hipSuccess) { fprintf(stderr, "kernel_launch: hipFuncSetAttribute failed\n"); grid = -1; return; }
        int per_cu = 0;
        if (hipOccupancyMaxActiveBlocksPerMultiprocessor(&per_cu, (const void*)fwd_kernel, 512, LDS_BYTES) != hipSuccess || per_cu < 1) fprintf(stderr, "kernel_launch: occupancy query reports %d\n", per_cu);
        (void)hipGetLastError();
        grid = cus;
        if (grid != 256) { fprintf(stderr, "kernel_launch: built for a 256-CU device (stream geometry); found %d CUs; nothing launched\n", cus); grid = -1; return; }
    }
    if (grid < 0) return;
    Args a{};
    for (int i = 0; i < 28; ++i) a.in[i] = (const float*)d_in[i];
    const size_t ws_off = WS_TOP ? ((ws_size - WS_END) / (2 * MiB)) * (2 * MiB) : 0;
    a.out = (float*)d_out; a.ws = (unsigned char*)d_ws + ws_off;
    (void)hipMemsetAsync(a.ws + WS_CTL, 0, CTL_ZERO_BYTES, stream);
    constexpr int NPH = 2 + 5 * DEPTH;
#if MK_SINGLE
    a.ph_lo = 0; a.ph_hi = NPH;
    hipLaunchKernelGGL(fwd_kernel, dim3(grid), dim3(512), LDS_BYTES, stream, a);
#else
    for (int p = 0; p < NPH; ++p) { a.ph_lo = p; a.ph_hi = p + 1; hipLaunchKernelGGL(fwd_kernel, dim3(grid), dim3(512), LDS_BYTES, stream, a); }
#endif
}
```
